# Optimizing an MI355X kernel written in HIP

```python
import jax, jax.numpy as jnp
from jax import lax
import numpy as np


D_MODEL = 1024
BATCH = 4
SEQ = 4096
DEPTH = 2

GRID_W = 64
CTX_LEN = 256
EPS = 1e-6

N_HEADS = 8
N_KV_HEADS = 2
HEAD_DIM = 64
GQA_GROUP = N_HEADS // N_KV_HEADS
WINDOW = 128
ATTN_BLOCK = 128
ROPE_BASE = 10000.0
ROPE_PAIRS = HEAD_DIM // 4

CONV_CH = 512
CONV_K = 31
CONV_PAD = CONV_K // 2

POOL_WINDOWS = (2, 4, 8, 16)
POOL_GROUP = 128
POOL_CH = POOL_GROUP * len(POOL_WINDOWS)

N_EXPERTS = 16
CAPACITY_FACTOR = 2
D_EXPERT = 1024

Q_W = N_HEADS * HEAD_DIM
KV_W = N_KV_HEADS * HEAD_DIM
N_BRANCHES = 3
IN_OFFSETS = (Q_W, Q_W + KV_W, Q_W + 2 * KV_W, Q_W + 2 * KV_W + 2 * CONV_CH,
              Q_W + 2 * KV_W + 2 * CONV_CH + POOL_CH)
IN_W = IN_OFFSETS[-1] + N_BRANCHES * D_MODEL

kernel_name = 'hybrid_gated_branch_dit_block'

F32 = jnp.float32


def rmsnorm(x, g):
    xf = x.astype(F32)
    y = xf * lax.rsqrt(jnp.mean(xf * xf, axis=-1, keepdims=True) + EPS)
    return (y * g.astype(F32)).astype(x.dtype)


def layernorm(x, g, b):
    xf = x.astype(F32)
    mu = jnp.mean(xf, axis=-1, keepdims=True)
    var = jnp.mean(jnp.square(xf - mu), axis=-1, keepdims=True)
    return ((xf - mu) * lax.rsqrt(var + EPS) * g.astype(F32) + b.astype(F32)).astype(x.dtype)


def modulate(h, shift, scale):
    return h * (1 + scale) + shift


def rope_tables(n):
    rows = n // GRID_W
    row = jnp.broadcast_to(jnp.arange(rows)[:, None], (rows, GRID_W)).reshape(-1).astype(F32)
    col = jnp.broadcast_to(jnp.arange(GRID_W)[None, :], (rows, GRID_W)).reshape(-1).astype(F32)
    freqs = ROPE_BASE ** (-jnp.arange(ROPE_PAIRS, dtype=F32) / ROPE_PAIRS)
    ang_r = row[:, None] * freqs
    ang_c = col[:, None] * freqs
    return (jnp.cos(ang_r), jnp.sin(ang_r), jnp.cos(ang_c), jnp.sin(ang_c))


def _rotate(x1, x2, cos, sin):
    return x1 * cos - x2 * sin, x2 * cos + x1 * sin


def apply_axial_rope(x, tabs):
    cos_r, sin_r, cos_c, sin_c = [t[:, None, :].astype(x.dtype) for t in tabs]
    xr1, xr2, xc1, xc2 = jnp.split(x, 4, axis=-1)
    r1, r2 = _rotate(xr1, xr2, cos_r, sin_r)
    c1, c2 = _rotate(xc1, xc2, cos_c, sin_c)
    return jnp.concatenate([r1, r2, c1, c2], axis=-1)


def heads(z, n):
    return z.reshape(z.shape[0], z.shape[1], n, HEAD_DIM)


def window_attention(q, k, v, k_ctx, v_ctx, sink):
    B, S = q.shape[:2]
    L = k_ctx.shape[1]
    nb = S // ATTN_BLOCK
    qb = q.reshape(B, nb, ATTN_BLOCK, N_KV_HEADS, GQA_GROUP, HEAD_DIM) * (HEAD_DIM ** -0.5)
    pad = ((0, 0), (1, 1), (0, 0), (0, 0), (0, 0))
    kp = jnp.pad(k.reshape(B, nb, ATTN_BLOCK, N_KV_HEADS, HEAD_DIM), pad)
    vp = jnp.pad(v.reshape(B, nb, ATTN_BLOCK, N_KV_HEADS, HEAD_DIM), pad)
    kw = jnp.concatenate([kp[:, :-2], kp[:, 1:-1], kp[:, 2:]], axis=2)
    vw = jnp.concatenate([vp[:, :-2], vp[:, 1:-1], vp[:, 2:]], axis=2)
    s_win = jnp.einsum('bnqkgd,bnskd->bnkgqs', qb, kw).astype(F32)
    qi = jnp.arange(ATTN_BLOCK)[:, None]
    kj = jnp.arange(3 * ATTN_BLOCK)[None, :]
    band = jnp.abs(kj - ATTN_BLOCK - qi) <= WINDOW
    kpos = (jnp.arange(nb)[:, None, None] - 1) * ATTN_BLOCK + kj[None]
    mask = band[None] & (kpos >= 0) & (kpos < S)
    s_win = jnp.where(mask[None, :, None, None], s_win, -1e30)
    s_ctx = jnp.einsum('bnqkgd,blkd->bnkgql', qb, k_ctx).astype(F32)
    sink_col = jnp.broadcast_to(sink.reshape(N_KV_HEADS, GQA_GROUP, 1, 1).astype(F32),
                                (B, nb, N_KV_HEADS, GQA_GROUP, ATTN_BLOCK, 1))
    p = jax.nn.softmax(jnp.concatenate([s_win, s_ctx, sink_col], axis=-1), axis=-1)
    p_win = p[..., :3 * ATTN_BLOCK].astype(v.dtype)
    p_ctx = p[..., 3 * ATTN_BLOCK:3 * ATTN_BLOCK + L].astype(v.dtype)
    o = jnp.einsum('bnkgqs,bnskd->bnqkgd', p_win, vw) + jnp.einsum('bnkgql,blkd->bnqkgd', p_ctx, v_ctx)
    return o.reshape(B, S, Q_W)


def context_attention(q, k, v, sink):
    B, L = q.shape[:2]
    qg = q.reshape(B, L, N_KV_HEADS, GQA_GROUP, HEAD_DIM) * (HEAD_DIM ** -0.5)
    s = jnp.einsum('blkgd,bmkd->bkglm', qg, k).astype(F32)
    sink_col = jnp.broadcast_to(sink.reshape(N_KV_HEADS, GQA_GROUP, 1, 1).astype(F32),
                                (B, N_KV_HEADS, GQA_GROUP, L, 1))
    p = jax.nn.softmax(jnp.concatenate([s, sink_col], axis=-1), axis=-1)[..., :L].astype(v.dtype)
    o = jnp.einsum('bkglm,bmkd->blkgd', p, v)
    return o.reshape(B, L, Q_W)


def conformer_conv(z, w_dw, b_dw, ln_g, ln_b, w_o):
    a, gl = jnp.split(z, 2, axis=-1)
    u = a * jax.nn.sigmoid(gl)
    u = lax.conv_general_dilated(u, w_dw[:, None, :], window_strides=(1,),
                                 padding=((CONV_PAD, CONV_PAD),),
                                 dimension_numbers=('NWC', 'WIO', 'NWC'),
                                 feature_group_count=CONV_CH) + b_dw
    u = jax.nn.silu(layernorm(u, ln_g, ln_b))
    return u @ w_o


def multiscale_pool(z, w_pool, pool_scale):
    B, N, C = z.shape
    cs = jnp.concatenate([jnp.zeros((B, 1, C), F32), jnp.cumsum(z.astype(F32), axis=1)], axis=1)
    t = jnp.arange(N)
    outs = []
    for gi, w in enumerate(POOL_WINDOWS):
        sl = slice(gi * POOL_GROUP, (gi + 1) * POOL_GROUP)
        lo = jnp.clip(t - w // 2, 0, N)
        hi = jnp.clip(t + w - w // 2, 0, N)
        mean = (cs[:, hi, sl] - cs[:, lo, sl]) / (hi - lo).astype(F32)[None, :, None]
        outs.append((mean.astype(z.dtype) - z[..., sl]) @ w_pool[gi])
    return jnp.concatenate(outs, axis=-1) * pool_scale


def merge_branches(attn, conv_in, pool_in, gate_in, lp):
    y_a = attn @ lp['w_attn_o']
    y_b = conformer_conv(conv_in, lp['conv_dw'], lp['conv_dw_b'], lp['conv_ln_g'], lp['conv_ln_b'], lp['w_conv_o'])
    y_c = multiscale_pool(pool_in, lp['w_pool'], lp['pool_scale']) @ lp['w_pool_o']
    g_a, g_b, g_c = jnp.split(jax.nn.sigmoid(gate_in), N_BRANCHES, axis=-1)
    return (g_a * y_a + g_b * y_b + g_c * y_c) @ lp['w_out']


def expert_choice_ffn(h, w_router, w_gate, w_up, w_down):
    B, N, _ = h.shape
    cap = (CAPACITY_FACTOR * N) // N_EXPERTS
    aff = jax.nn.softmax(jnp.einsum('bnd,de->bne', h, w_router).astype(F32), axis=-1)
    g, idx = lax.top_k(jnp.transpose(aff, (0, 2, 1)), cap)
    bidx = jnp.arange(B)[:, None, None]
    xe = h[bidx, idx]
    a = jnp.einsum('becd,edf->becf', xe, w_gate)
    u = jnp.einsum('becd,edf->becf', xe, w_up)
    ye = jnp.einsum('becf,efd->becd', jax.nn.silu(a) * u, w_down) * g[..., None].astype(h.dtype)
    return jnp.zeros_like(h).at[bidx, idx].add(ye)


def split_in(p):
    return jnp.split(p, IN_OFFSETS, axis=-1)


def setup_inputs(seed: int = 0) -> dict:
    key = jax.random.key(seed)
    ks = jax.random.split(key, 25)

    def nrm(k, shape, scale):
        return jax.random.normal(k, shape, jnp.float32) * scale

    return {
        'x': nrm(ks[0], (BATCH, SEQ, D_MODEL), 1.0),
        'c': nrm(ks[1], (BATCH, D_MODEL), 1.0),
        'ctx': nrm(ks[2], (BATCH, CTX_LEN, D_MODEL), 1.0),
        'c_ctx': nrm(ks[3], (D_MODEL,), 1.0),
        'norm1_g': 1.0 + nrm(ks[4], (DEPTH, D_MODEL), 0.02),
        'norm2_g': 1.0 + nrm(ks[5], (DEPTH, D_MODEL), 0.02),
        'w_mod': nrm(ks[6], (DEPTH, D_MODEL, 6 * D_MODEL), 0.02),
        'b_mod': nrm(ks[7], (DEPTH, 6 * D_MODEL), 0.02),
        'w_in': nrm(ks[8], (DEPTH, D_MODEL, IN_W), D_MODEL ** -0.5),
        'attn_sink': nrm(ks[9], (DEPTH, N_HEADS), 1.0),
        'w_attn_o': nrm(ks[10], (DEPTH, Q_W, D_MODEL), Q_W ** -0.5),
        'conv_dw': nrm(ks[11], (DEPTH, CONV_K, CONV_CH), CONV_K ** -0.5),
        'conv_dw_b': nrm(ks[12], (DEPTH, CONV_CH), 0.02),
        'conv_ln_g': 1.0 + nrm(ks[13], (DEPTH, CONV_CH), 0.02),
        'conv_ln_b': nrm(ks[14], (DEPTH, CONV_CH), 0.02),
        'w_conv_o': nrm(ks[15], (DEPTH, CONV_CH, D_MODEL), CONV_CH ** -0.5),
        'w_pool': nrm(ks[16], (DEPTH, len(POOL_WINDOWS), POOL_GROUP, POOL_GROUP), POOL_GROUP ** -0.5),
        'pool_scale': 1.0 + nrm(ks[17], (DEPTH, POOL_CH), 0.1),
        'w_pool_o': nrm(ks[18], (DEPTH, POOL_CH, D_MODEL), POOL_CH ** -0.5),
        'w_out': nrm(ks[19], (DEPTH, D_MODEL, D_MODEL), D_MODEL ** -0.5),
        'w_router': nrm(ks[20], (DEPTH, D_MODEL, N_EXPERTS), D_MODEL ** -0.5),
        'w_e_gate': nrm(ks[21], (DEPTH, N_EXPERTS, D_MODEL, D_EXPERT), D_MODEL ** -0.5),
        'w_e_up': nrm(ks[22], (DEPTH, N_EXPERTS, D_MODEL, D_EXPERT), D_MODEL ** -0.5),
        'w_e_down': nrm(ks[23], (DEPTH, N_EXPERTS, D_EXPERT, D_MODEL), D_EXPERT ** -0.5),
        'final_norm_g': 1.0 + nrm(ks[24], (D_MODEL,), 0.02),
    }


def reference(x, c, ctx, c_ctx, norm1_g, norm2_g, w_mod, b_mod, w_in, attn_sink, w_attn_o,
              conv_dw, conv_dw_b, conv_ln_g, conv_ln_b, w_conv_o, w_pool, pool_scale, w_pool_o,
              w_out, w_router, w_e_gate, w_e_up, w_e_down, final_norm_g):
    S = x.shape[1]
    tabs = rope_tables(S)
    for l in range(DEPTH):
        last = l == DEPTH - 1
        lp = {'w_attn_o': w_attn_o[l], 'conv_dw': conv_dw[l], 'conv_dw_b': conv_dw_b[l],
              'conv_ln_g': conv_ln_g[l], 'conv_ln_b': conv_ln_b[l], 'w_conv_o': w_conv_o[l],
              'w_pool': w_pool[l], 'pool_scale': pool_scale[l], 'w_pool_o': w_pool_o[l], 'w_out': w_out[l]}
        mod_x = (jax.nn.silu(c) @ w_mod[l] + b_mod[l])[:, None, :]
        sh1, sc1, g1, sh2, sc2, g2 = jnp.split(mod_x, 6, axis=-1)
        mod_c = jax.nn.silu(c_ctx) @ w_mod[l] + b_mod[l]
        csh1, csc1, cg1, csh2, csc2, cg2 = jnp.split(mod_c, 6, axis=-1)

        p_x = modulate(rmsnorm(x, norm1_g[l]), sh1, sc1) @ w_in[l]
        p_c = modulate(rmsnorm(ctx, norm1_g[l]), csh1, csc1) @ w_in[l]
        qx, kx, vx, conv_x, pool_x, gate_x = split_in(p_x)
        qc, kc, vc, conv_c, pool_c, gate_c = split_in(p_c)
        kc = heads(kc, N_KV_HEADS)
        vc = heads(vc, N_KV_HEADS)
        attn_x = window_attention(apply_axial_rope(heads(qx, N_HEADS), tabs),
                                  apply_axial_rope(heads(kx, N_KV_HEADS), tabs),
                                  heads(vx, N_KV_HEADS), kc, vc, attn_sink[l])
        x = x + g1 * merge_branches(attn_x, conv_x, pool_x, gate_x, lp)
        if not last:
            attn_c = context_attention(heads(qc, N_HEADS), kc, vc, attn_sink[l])
            ctx = ctx + cg1 * merge_branches(attn_c, conv_c, pool_c, gate_c, lp)

        x = x + g2 * expert_choice_ffn(modulate(rmsnorm(x, norm2_g[l]), sh2, sc2),
                                       w_router[l], w_e_gate[l], w_e_up[l], w_e_down[l])
        if not last:
            ctx = ctx + cg2 * expert_choice_ffn(modulate(rmsnorm(ctx, norm2_g[l]), csh2, csc2),
                                                w_router[l], w_e_gate[l], w_e_up[l], w_e_down[l])
    return rmsnorm(x, final_norm_g)
```

```cpp
#include <hip/hip_runtime.h>
#include <hip/hip_cooperative_groups.h>
#include <cstdio>
#include <cstdint>
namespace cg = cooperative_groups;

#ifndef MK_PER_PHASE
#define MK_PER_PHASE 0
#endif

#define LAS __attribute__((address_space(3)))
#define DI __device__ __forceinline__
typedef unsigned short bf16_t;
typedef short bf16x8 __attribute__((ext_vector_type(8)));
typedef short s16x4 __attribute__((ext_vector_type(4)));
typedef float f32x4 __attribute__((ext_vector_type(4)));
typedef float f32x16 __attribute__((ext_vector_type(16)));
typedef unsigned u32x4 __attribute__((ext_vector_type(4)));
typedef unsigned u32x2 __attribute__((ext_vector_type(2)));

constexpr int DM = 1024, NBATCH = 4, SEQ = 4096, CTXL = 256;
constexpr int TL = NBATCH * SEQ, TC = NBATCH * CTXL, TT = TL + TC;
constexpr int INW = 5376;
constexpr int NE = 16, ESLOT = 2304;
constexpr float LOG2E = 1.4426950408889634f;
constexpr float QSC = 0.125f * LOG2E;
constexpr int NPHASE = 20;

constexpr size_t MiB = (size_t)1 << 20;
constexpr size_t WS_BAR = 0;
constexpr size_t WS_MOD = 1 * MiB, WS_ROPE = 1 * MiB + 512 * 1024;
constexpr size_t WS_AFF = 2 * MiB, WS_SLOTOF = 4 * MiB, WS_TOKOF = 6 * MiB;
constexpr size_t WS_WIN = 8 * MiB, WS_WMERGE = 29 * MiB, WS_WOUT = 35 * MiB, WS_WGU = 40 * MiB, WS_WDN = 104 * MiB;
constexpr size_t WS_X = 136 * MiB, WS_H = 204 * MiB;
constexpr size_t WS_Q = 238 * MiB, WS_K = 255 * MiB, WS_VT = 260 * MiB, WS_U = 265 * MiB, WS_Z = 282 * MiB, WS_G = 299 * MiB, WS_BR = 401 * MiB, WS_MERGED = 452 * MiB;
constexpr size_t WS_ACT = 238 * MiB, WS_Y = 310 * MiB;
constexpr size_t WS_END = 486 * MiB;

constexpr int LDS_BYTES = 147456;
constexpr int RING_BYTES = 131072;
constexpr int LDS_IDX_OFF = RING_BYTES;
constexpr int LDS_MISC_OFF = RING_BYTES + 8192;

struct Args { const float* in[25]; float* out; unsigned char* ws; int ph_lo, ph_hi; };
enum { I_X = 0, I_C, I_CTX, I_CCTX, I_N1G, I_N2G, I_WMOD, I_BMOD, I_WIN, I_SINK, I_WAO, I_CDW, I_CDWB, I_CLNG, I_CLNB, I_WCO, I_WPOOL, I_PSCALE, I_WPO, I_WOUT, I_WR, I_WEG, I_WEU, I_WED, I_FNG };

DI unsigned pk_bf16(float lo, float hi) {
    typedef float f2 __attribute__((ext_vector_type(2))); typedef __bf16 b2 __attribute__((ext_vector_type(2)));
    f2 v = {lo, hi}; b2 b = __builtin_convertvector(v, b2); return __builtin_bit_cast(unsigned, b);
}
DI bf16_t f2bf(float f) { return (bf16_t)(pk_bf16(f, 0.f) & 0xffffu); }
DI float bf_lo(unsigned u) { return __uint_as_float(u << 16); }
DI float bf_hi(unsigned u) { return __uint_as_float(u & 0xffff0000u); }
DI float bf2f(bf16_t b) { return __uint_as_float(((unsigned)b) << 16); }
DI float sigm(float x) { return 1.f / (1.f + __expf(-x)); }
DI float wave_sum(float v) {
#pragma unroll
    for (int o = 1; o < 64; o <<= 1) v += __shfl_xor(v, o);
    return v;
}
DI int crow(int r, int hi) { return (r & 3) + 8 * (r >> 2) + 4 * hi; }
#define LDS_WAIT() asm volatile("s_waitcnt lgkmcnt(0)" ::: "memory")

namespace pg8 {
constexpr int BM = 256, BK = 64, HALF = 128, HTB = HALF * BK * 2;
DI int lds_byte(int r, int c) { const int st = (r >> 4) * 2 + (c >> 5), rr = r & 15, cc = c & 31, ob = rr * 64 + cc * 2; return st * 1024 + (ob ^ (((ob >> 9) & 1) << 5)); }
DI void stage_rc(int b, int& R, int& C) { const int st = b / 1024, sb = b % 1024, swz = sb ^ (((sb >> 9) & 1) << 5); R = (st >> 1) * 16 + swz / 64; C = (st & 1) * 32 + (swz % 64) / 2; }

struct Unit { const char* a; const char* b; int i0, i1, i2, ui; };

DI void tile_order(int L, int nM, int nN, int& pm, int& pn) {
    const int nwg = nM * nN; int wgid = L;
    { const int q = nwg / 8, r = nwg % 8, xcd = wgid % 8, off = wgid / 8; wgid = (xcd < r ? xcd * (q + 1) : r * (q + 1) + (xcd - r) * q) + off; }
    const int nig = 8 * nN, gid = wgid / nig, fm = gid * 8, gsz = (nM - fm) < 8 ? (nM - fm) : 8;
    pm = fm + ((wgid % nig) % gsz); pn = (wgid % nig) / gsz;
}

template <class Epi, class Sched>
DI void gemm_phase(LAS unsigned char* lds, const Sched& S, const Epi& E) {
    const int tid = threadIdx.x, wid = __builtin_amdgcn_readfirstlane(tid >> 6), lane = tid & 63, wr = wid >> 2, wc = wid & 3, fr = lane & 15, fq = lane >> 4;
    const int nt = S.nt;
    int R0, C0, R1, C1; stage_rc(tid * 16, R0, C0); stage_rc(tid * 16 + 8192, R1, C1);
    unsigned voffB[2][2];
#pragma unroll
    for (int h = 0; h < 2; ++h) { voffB[h][0] = (unsigned)((h * HALF + R0) * S.ldb_b + C0 * 2); voffB[h][1] = (unsigned)((h * HALF + R1) * S.ldb_b + C1 * 2); }
    const size_t kstep = (size_t)(BK * 2);
    const unsigned ldsw = (unsigned)wid * 1024u;
    const int aoff = lds_byte(wr * 64 + fr, fq * 8), boff = lds_byte(wc * 32 + fr, fq * 8);
#define PG8_SA(b, h) (((b) * 2 + (h)) * HTB)
#define PG8_SB(b, h) ((4 + (b) * 2 + (h)) * HTB)
#define PG8_STAGE(bufoff, gbase, voff) do { _Pragma("unroll") for (int _i = 0; _i < 2; ++_i) \
        __builtin_amdgcn_global_load_lds((const unsigned*)((const char*)(gbase) + (voff)[_i]), (LAS unsigned*)(lds + (bufoff) + ldsw + _i * 8192), 16, 0, 0); } while (0)
#define PG8_LDA(dst, b, h) do { _Pragma("unroll") for (int m = 0; m < 4; ++m) _Pragma("unroll") for (int k = 0; k < 2; ++k) dst[m][k] = *(const LAS bf16x8*)(lds + PG8_SA(b, h) + aoff + m * 2048 + k * 1024); } while (0)
#define PG8_LDB(dst, b, h) do { _Pragma("unroll") for (int n = 0; n < 2; ++n) _Pragma("unroll") for (int k = 0; k < 2; ++k) dst[n][k] = *(const LAS bf16x8*)(lds + PG8_SB(b, h) + boff + n * 2048 + k * 1024); } while (0)
#define PG8_MMA(ai, bj, At, Bt) do { __builtin_amdgcn_s_setprio(1); _Pragma("unroll") for (int m = 0; m < 4; ++m) _Pragma("unroll") for (int n = 0; n < 2; ++n) _Pragma("unroll") for (int k = 0; k < 2; ++k) \
        acc[ai][bj][m][n] = __builtin_amdgcn_mfma_f32_16x16x32_bf16(Bt[n][k], At[m][k], acc[ai][bj][m][n], 0, 0, 0); __builtin_amdgcn_s_setprio(0); } while (0)
#define PG8_WAIT_V(n) asm volatile("s_waitcnt vmcnt(" #n ")" ::: "memory")
#define PG8_WAIT_L(n) asm volatile("s_waitcnt lgkmcnt(" #n ")" ::: "memory")
#define PG8_BAR __builtin_amdgcn_s_barrier()
#define PG8_SCHED __builtin_amdgcn_sched_barrier(0)
    Unit cur, nxt; int ui = 0;
    if (!S.next(0, cur)) return;
    f32x4 acc[2][2][4][2];
#pragma unroll
    for (int a = 0; a < 2; ++a)
#pragma unroll
        for (int b = 0; b < 2; ++b)
#pragma unroll
            for (int m = 0; m < 4; ++m)
#pragma unroll
                for (int n = 0; n < 2; ++n) acc[a][b][m][n] = (f32x4){0.f, 0.f, 0.f, 0.f};
    bf16x8 At[4][2], B0[2][2], B1[2][2];
    unsigned cvA[2][2], nvA[2][2];
    S.voff(cur, R0, C0, R1, C1, cvA);
    const char* cA = cur.a; const char* cB = cur.b;
    PG8_STAGE(PG8_SB(0, 0), cB, voffB[0]); PG8_STAGE(PG8_SB(0, 1), cB, voffB[1]); PG8_STAGE(PG8_SA(0, 0), cA, cvA[0]); PG8_STAGE(PG8_SA(0, 1), cA, cvA[1]);
    if (wr == 1) PG8_BAR;
    PG8_WAIT_V(2); PG8_BAR;
    PG8_STAGE(PG8_SB(1, 0), cB + kstep, voffB[0]); PG8_STAGE(PG8_SA(1, 0), cA + kstep, cvA[0]); PG8_STAGE(PG8_SB(1, 1), cB + kstep, voffB[1]);
    PG8_WAIT_V(6); PG8_BAR;
    for (;;) {
        const bool has_next = S.next(ui + 1, nxt);
        const char* nA = has_next ? nxt.a : cA; const char* nB = has_next ? nxt.b : cB;
        if (has_next) S.voff(nxt, R0, C0, R1, C1, nvA);
        else {
#pragma unroll
            for (int h = 0; h < 2; ++h) { nvA[h][0] = cvA[h][0]; nvA[h][1] = cvA[h][1]; }
        }
        for (int t = 0; t < nt; t += 2) {
            const bool last = (t == nt - 2);
            const char* a1 = cA + (size_t)(t + 1) * kstep;
            const char* a2 = last ? nA : cA + (size_t)(t + 2) * kstep; const char* b2 = last ? nB : cB + (size_t)(t + 2) * kstep;
            const char* a3 = a2 + kstep; const char* b3 = b2 + kstep;
            unsigned v2[2][2];
#pragma unroll
            for (int h = 0; h < 2; ++h) { v2[h][0] = last ? nvA[h][0] : cvA[h][0]; v2[h][1] = last ? nvA[h][1] : cvA[h][1]; }
            PG8_LDB(B0, 0, 0); PG8_LDB(B1, 0, 1); PG8_SCHED; PG8_LDA(At, 0, 0); PG8_STAGE(PG8_SA(1, 1), a1, cvA[1]);
            PG8_WAIT_V(8); PG8_WAIT_L(0); PG8_BAR; PG8_MMA(0, 0, At, B0); PG8_MMA(0, 1, At, B1); PG8_BAR; PG8_SCHED;
            PG8_LDA(At, 0, 1); PG8_STAGE(PG8_SB(0, 0), b2, voffB[0]); PG8_STAGE(PG8_SB(0, 1), b2, voffB[1]); PG8_STAGE(PG8_SA(0, 0), a2, v2[0]);
            PG8_WAIT_V(8); PG8_WAIT_L(0); PG8_BAR; PG8_MMA(1, 0, At, B0); PG8_MMA(1, 1, At, B1); PG8_BAR; PG8_SCHED;
            PG8_LDB(B0, 1, 0); PG8_LDB(B1, 1, 1); PG8_SCHED; PG8_LDA(At, 1, 0); PG8_STAGE(PG8_SA(0, 1), a2, v2[1]);
            PG8_WAIT_V(8); PG8_WAIT_L(0); PG8_BAR; PG8_MMA(0, 0, At, B0); PG8_MMA(0, 1, At, B1); PG8_BAR; PG8_SCHED;
            PG8_LDA(At, 1, 1); PG8_STAGE(PG8_SB(1, 0), b3, voffB[0]); PG8_STAGE(PG8_SB(1, 1), b3, voffB[1]); PG8_STAGE(PG8_SA(1, 0), a3, v2[0]);
            PG8_WAIT_V(8); PG8_WAIT_L(0); PG8_BAR; PG8_MMA(1, 0, At, B0); PG8_MMA(1, 1, At, B1); PG8_BAR; PG8_SCHED;
        }
        if (wr == 0) PG8_BAR;
        E(acc, cur, wr, wc, fr, fq);
        if (!has_next) break;
#pragma unroll
        for (int a = 0; a < 2; ++a)
#pragma unroll
            for (int b = 0; b < 2; ++b)
#pragma unroll
                for (int m = 0; m < 4; ++m)
#pragma unroll
                    for (int n = 0; n < 2; ++n) acc[a][b][m][n] = (f32x4){0.f, 0.f, 0.f, 0.f};
        cur = nxt; cA = nA; cB = nB; ++ui;
#pragma unroll
        for (int h = 0; h < 2; ++h) { cvA[h][0] = nvA[h][0]; cvA[h][1] = nvA[h][1]; }
        if (wr == 1) PG8_BAR;
    }
    PG8_WAIT_V(0);
    PG8_BAR;
#undef PG8_SA
#undef PG8_SB
#undef PG8_STAGE
#undef PG8_LDA
#undef PG8_LDB
#undef PG8_MMA
#undef PG8_WAIT_V
#undef PG8_WAIT_L
#undef PG8_BAR
#undef PG8_SCHED
}
}
using pg8::Unit;
typedef f32x4 Acc[2][2][4][2];

struct SchedBase {
    int nt, ldb_b, lda_b, G, c;
    DI void voff_contig(int R0, int C0, int R1, int C1, unsigned (&vo)[2][2]) const {
#pragma unroll
        for (int h = 0; h < 2; ++h) { vo[h][0] = (unsigned)((h * 128 + R0) * lda_b + C0 * 2); vo[h][1] = (unsigned)((h * 128 + R1) * lda_b + C1 * 2); }
    }
};
struct SchedInProj : SchedBase {
    const char* A; const char* B; int nM, nmain, nextra;
    DI bool next(int i, Unit& u) const {
        const int L = i * G + c; int pm, pn;
        if (L < nmain) pg8::tile_order(L, nM, 21, pm, pn); else if (L < nmain + nextra) { pm = 64 + (L - nmain); pn = 2; } else return false;
        u.a = A + (size_t)pm * 256 * 2048; u.b = B + (size_t)pn * 256 * 2048; u.i0 = pm; u.i1 = pn; u.i2 = 0; u.ui = i; return true;
    }
    DI void voff(const Unit&, int R0, int C0, int R1, int C1, unsigned (&vo)[2][2]) const { voff_contig(R0, C0, R1, C1, vo); }
};
struct SchedMerge : SchedBase {
    const char* A; const char* B; int nM;
    DI bool next(int i, Unit& u) const {
        const int ti = (i / 3) * G + c, br = i % 3; if (ti >= nM * 4) return false;
        int pm, pn; pg8::tile_order(ti, nM, 4, pm, pn);
        u.a = A + ((size_t)pm * 256 * 1536 + br * 512) * 2; u.b = B + ((size_t)pn * 256 * 1536 + br * 512) * 2; u.i0 = pm; u.i1 = pn; u.i2 = br; u.ui = i; return true;
    }
    DI void voff(const Unit&, int R0, int C0, int R1, int C1, unsigned (&vo)[2][2]) const { voff_contig(R0, C0, R1, C1, vo); }
};
struct SchedOut : SchedBase {
    const char* A; const char* B; int nM;
    DI bool next(int i, Unit& u) const {
        const int L = i * G + c; if (L >= nM * 4) return false;
        int pm, pn; pg8::tile_order(L, nM, 4, pm, pn);
        u.a = A + (size_t)pm * 256 * 2048; u.b = B + (size_t)pn * 256 * 2048; u.i0 = pm; u.i1 = pn; u.i2 = 0; u.ui = i; return true;
    }
    DI void voff(const Unit&, int R0, int C0, int R1, int C1, unsigned (&vo)[2][2]) const { voff_contig(R0, C0, R1, C1, vo); }
};
struct SchedGU : SchedBase {
    const char* A; const char* B; int nmt, ibase; const LAS int* idx;
    DI bool next(int i, Unit& u) const {
        if (i >= 8) return false;
        const int L = (ibase + i) * G + c; if (L >= NE * nmt * 8) return false;
        const int n8 = L % 8, mt = (L / 8) % nmt, e = L / (8 * nmt);
        u.a = A; u.b = B + ((size_t)e * 2048 + n8 * 256) * 2048; u.i0 = e; u.i1 = mt; u.i2 = n8; u.ui = i; return true;
    }
    DI void voff(const Unit& u, int R0, int C0, int R1, int C1, unsigned (&vo)[2][2]) const {
#pragma unroll
        for (int h = 0; h < 2; ++h) { vo[h][0] = (unsigned)(idx[u.ui * 256 + h * 128 + R0] * 2048 + C0 * 2); vo[h][1] = (unsigned)(idx[u.ui * 256 + h * 128 + R1] * 2048 + C1 * 2); }
    }
};
struct SchedDown : SchedBase {
    const char* A; const char* B; int nmt;
    DI bool next(int i, Unit& u) const {
        const int L = i * G + c; if (L >= NE * nmt * 4) return false;
        const int n4 = L % 4, mt = (L / 4) % nmt, e = L / (4 * nmt);
        u.a = A + ((size_t)e * ESLOT + mt * 256) * 2048; u.b = B + ((size_t)e * 1024 + n4 * 256) * 2048; u.i0 = e; u.i1 = mt; u.i2 = n4; u.ui = i; return true;
    }
    DI void voff(const Unit&, int R0, int C0, int R1, int C1, unsigned (&vo)[2][2]) const { voff_contig(R0, C0, R1, C1, vo); }
};

DI void st_bf4(bf16_t* p, f32x4 v) { u32x2 w; w.x = pk_bf16(v[0], v[1]); w.y = pk_bf16(v[2], v[3]); *(u32x2*)p = w; }
DI f32x4 sig4(f32x4 v) { return (f32x4){sigm(v[0]), sigm(v[1]), sigm(v[2]), sigm(v[3])}; }

struct EpiInProj {
    bf16_t *Q, *K, *VT, *U, *Z, *G; const float* rope;
    DI void operator()(const Acc& acc, const Unit& u, int wr, int wc, int fr, int fq) const {
        const int pm = u.i0, pn = u.i1;
#pragma unroll
        for (int bj = 0; bj < 2; ++bj) {
            const int gc = 256 * pn + 128 * bj + 32 * wc;
#pragma unroll
            for (int ai = 0; ai < 2; ++ai)
#pragma unroll
                for (int m = 0; m < 4; ++m) {
                    const int t = 256 * pm + 128 * ai + 64 * wr + 16 * m + fr;
                    const f32x4 v0 = acc[ai][bj][m][0], v1 = acc[ai][bj][m][1];
                    if (gc < 640) {
                        f32x4 o0 = v0, o1 = v1;
                        if (t < TL) {
                            const int s = t & (SEQ - 1); const int p = ((gc >> 5) & 1) ? (s & 63) : (s >> 6);
                            const f32x4 cs = *(const f32x4*)(rope + p * 16 + 4 * fq), sn = *(const f32x4*)(rope + 1024 + p * 16 + 4 * fq);
                            o0 = v0 * cs - v1 * sn; o1 = v1 * cs + v0 * sn;
                        }
                        bf16_t* dst;
                        if (gc < 512) { o0 = o0 * QSC; o1 = o1 * QSC; dst = Q + (size_t)t * 512 + gc + 4 * fq; } else dst = K + (size_t)t * 128 + (gc - 512) + 4 * fq;
                        st_bf4(dst, o0); st_bf4(dst + 16, o1);
                    } else if (gc < 768) {
                        const int c0 = gc - 640 + 4 * fq;
#pragma unroll
                        for (int j = 0; j < 4; ++j) { VT[(size_t)(c0 + j) * TT + t] = f2bf(v0[j]); VT[(size_t)(c0 + 16 + j) * TT + t] = f2bf(v1[j]); }
                    } else if (gc < 1792) {
                        const int ch = ((gc - 768) >> 1) + 4 * fq;
                        st_bf4(U + (size_t)t * 512 + ch, v0 * sig4(v1));
                    } else if (gc < 2304) {
                        bf16_t* dst = Z + (size_t)t * 512 + (gc - 1792) + 4 * fq; st_bf4(dst, v0); st_bf4(dst + 16, v1);
                    } else {
                        bf16_t* dst = G + (size_t)t * 3072 + (gc - 2304) + 4 * fq; st_bf4(dst, sig4(v0)); st_bf4(dst + 16, sig4(v1));
                    }
                }
        }
    }
};
struct EpiMerge {
    const bf16_t* G; bf16_t* M;
    DI void operator()(const Acc& acc, const Unit& u, int wr, int wc, int fr, int fq) const {
        const int pm = u.i0, pn = u.i1, br = u.i2;
#pragma unroll
        for (int ai = 0; ai < 2; ++ai)
#pragma unroll
            for (int m = 0; m < 4; ++m) {
                const int t = 256 * pm + 128 * ai + 64 * wr + 16 * m + fr;
#pragma unroll
                for (int bj = 0; bj < 2; ++bj)
#pragma unroll
                    for (int n = 0; n < 2; ++n) {
                        const int cc = 256 * pn + 128 * bj + 32 * wc + 16 * n + 4 * fq;
                        const u32x2 gw = *(const u32x2*)(G + (size_t)t * 3072 + br * 1024 + cc);
                        f32x4 v = acc[ai][bj][m][n] * (f32x4){bf_lo(gw.x), bf_hi(gw.x), bf_lo(gw.y), bf_hi(gw.y)};
                        bf16_t* mp = M + (size_t)t * 1024 + cc;
                        if (br > 0) { const unsigned long long pw = __hip_atomic_load((const unsigned long long*)mp, __ATOMIC_RELAXED, __HIP_MEMORY_SCOPE_AGENT);
                            const unsigned plo = (unsigned)pw, phi = (unsigned)(pw >> 32); v = v + (f32x4){bf_lo(plo), bf_hi(plo), bf_lo(phi), bf_hi(phi)}; }
                        st_bf4(mp, v);
                    }
            }
    }
};
struct EpiOut {
    const float* xin; const float* ctxin; float* X; const float* mod; int layer;
    DI void operator()(const Acc& acc, const Unit& u, int wr, int wc, int fr, int fq) const {
        const int pm = u.i0, pn = u.i1; const int row0 = 256 * pm;
        const int mr = row0 < TL ? (row0 >> 12) : 4;
        const float* src = layer == 0 ? (row0 < TL ? xin : ctxin - (size_t)TL * DM) : X;
        const float* g1 = mod + (size_t)(layer * 5 + mr) * 6144 + 2048;
#pragma unroll
        for (int bj = 0; bj < 2; ++bj)
#pragma unroll
            for (int n = 0; n < 2; ++n) {
                const int cc = 256 * pn + 128 * bj + 32 * wc + 16 * n + 4 * fq;
                const f32x4 gv = *(const f32x4*)(g1 + cc);
#pragma unroll
                for (int ai = 0; ai < 2; ++ai)
#pragma unroll
                    for (int m = 0; m < 4; ++m) {
                        const int t = row0 + 128 * ai + 64 * wr + 16 * m + fr;
                        const f32x4 xs = *(const f32x4*)(src + (size_t)t * DM + cc);
                        *(f32x4*)(X + (size_t)t * DM + cc) = xs + gv * acc[ai][bj][m][n];
                    }
            }
    }
};
struct EpiGU {
    bf16_t* ACT;
    DI void operator()(const Acc& acc, const Unit& u, int wr, int wc, int fr, int fq) const {
        const int e = u.i0, mt = u.i1, n8 = u.i2;
#pragma unroll
        for (int ai = 0; ai < 2; ++ai)
#pragma unroll
            for (int m = 0; m < 4; ++m) {
                const size_t slot = (size_t)e * ESLOT + mt * 256 + 128 * ai + 64 * wr + 16 * m + fr;
#pragma unroll
                for (int bj = 0; bj < 2; ++bj) {
                    const int col = ((256 * n8 + 128 * bj + 32 * wc) >> 1) + 4 * fq;
                    const f32x4 gt = acc[ai][bj][m][0], up = acc[ai][bj][m][1];
                    st_bf4(ACT + slot * 1024 + col, gt * sig4(gt) * up);
                }
            }
    }
};
struct EpiDown {
    bf16_t* Y;
    DI void operator()(const Acc& acc, const Unit& u, int wr, int wc, int fr, int fq) const {
        const int e = u.i0, mt = u.i1, n4 = u.i2;
#pragma unroll
        for (int ai = 0; ai < 2; ++ai)
#pragma unroll
            for (int m = 0; m < 4; ++m) {
                const size_t slot = (size_t)e * ESLOT + mt * 256 + 128 * ai + 64 * wr + 16 * m + fr;
#pragma unroll
                for (int bj = 0; bj < 2; ++bj)
#pragma unroll
                    for (int n = 0; n < 2; ++n) st_bf4(Y + slot * 1024 + 256 * n4 + 128 * bj + 32 * wc + 16 * n + 4 * fq, acc[ai][bj][m][n]);
            }
    }
};

DI int maprow(int mode, int n) {
    if (mode == 1) {
        if (n >= 768 && n < 1280) { const int ch = n - 768; return 768 + 32 * (ch >> 4) + (ch & 15); }
        if (n >= 1280 && n < 1792) { const int ch = n - 1280; return 768 + 32 * (ch >> 4) + 16 + (ch & 15); }
        return n;
    }
    if (mode == 2) return 32 * (n >> 4) + (n & 15);
    if (mode == 3) return 32 * (n >> 4) + 16 + (n & 15);
    return n;
}
DI void transpose_item(const float* W, int N, bf16_t* WT, int dpitch, int dcol0, int mode, LAS float* scr, int item, int lane) {
    const int nblk = N / 32, kb = item / nblk, nb = item % nblk, k0 = 64 * kb, n0 = 32 * nb;
#pragma unroll 8
    for (int i = 0; i < 32; ++i) { const int kk = 2 * i + (lane >> 5); scr[kk * 33 + (lane & 31)] = W[(size_t)(k0 + kk) * N + n0 + (lane & 31)]; }
    LDS_WAIT(); asm volatile("" ::: "memory");
    const int c = lane & 7;
#pragma unroll
    for (int j = 0; j < 4; ++j) { const int n = (lane >> 3) + 8 * j; const LAS float* s = scr + (8 * c) * 33 + n;
        u32x4 o; o.x = pk_bf16(s[0 * 33], s[1 * 33]); o.y = pk_bf16(s[2 * 33], s[3 * 33]); o.z = pk_bf16(s[4 * 33], s[5 * 33]); o.w = pk_bf16(s[6 * 33], s[7 * 33]);
        *(u32x4*)(WT + (size_t)maprow(mode, n0 + n) * dpitch + dcol0 + k0 + 8 * c) = o; }
    LDS_WAIT(); asm volatile("" ::: "memory");
}
DI void convert_small(const Args& a, LAS float* scr, int gw, int NGW, int lane) {
    unsigned char* ws = a.ws;
    constexpr int I_A = 16 * 168, I_B = 8 * 32, I_C = 8 * 32, I_D = 16 * 32, PER = I_A + I_B + I_C + I_D;
    for (int it = gw; it < 2 * PER; it += NGW) {
        const int l = it / PER; int r = it % PER;
        if (r < I_A) { transpose_item(a.in[I_WIN] + (size_t)l * 1024 * INW, INW, (bf16_t*)(ws + WS_WIN) + (size_t)l * INW * 1024, 1024, 0, 1, scr, r, lane); continue; } r -= I_A;
        if (r < I_B) { transpose_item(a.in[I_WAO] + (size_t)l * 512 * 1024, 1024, (bf16_t*)(ws + WS_WMERGE) + (size_t)l * 1024 * 1536, 1536, 0, 0, scr, r, lane); continue; } r -= I_B;
        if (r < I_C) { transpose_item(a.in[I_WCO] + (size_t)l * 512 * 1024, 1024, (bf16_t*)(ws + WS_WMERGE) + (size_t)l * 1024 * 1536, 1536, 512, 0, scr, r, lane); continue; } r -= I_C;
        transpose_item(a.in[I_WOUT] + (size_t)l * 1024 * 1024, 1024, (bf16_t*)(ws + WS_WOUT) + (size_t)l * 1024 * 1024, 1024, 0, 0, scr, r, lane);
    }
}
DI void convert_experts(const Args& a, int l, LAS float* scr, int gw, int NGW, int lane) {
    unsigned char* ws = a.ws;
    for (int it = gw; it < NE * 1536; it += NGW) {
        const int e = it / 1536; int r = it % 1536; const size_t wo = ((size_t)l * NE + e) * 1024 * 1024;
        if (r < 512) { transpose_item(a.in[I_WEG] + wo, 1024, (bf16_t*)(ws + WS_WGU) + (size_t)e * 2048 * 1024, 1024, 0, 2, scr, r, lane); continue; } r -= 512;
        if (r < 512) { transpose_item(a.in[I_WEU] + wo, 1024, (bf16_t*)(ws + WS_WGU) + (size_t)e * 2048 * 1024, 1024, 0, 3, scr, r, lane); continue; } r -= 512;
        transpose_item(a.in[I_WED] + wo, 1024, (bf16_t*)(ws + WS_WDN) + (size_t)e * 1024 * 1024, 1024, 0, 0, scr, r, lane);
    }
}
DI void mod_item(const Args& a, LAS unsigned char* lds, int item) {
    const int tid = threadIdx.x, l = item / 96, cb = item % 96;
    LAS float* sc = (LAS float*)lds; LAS float* red = (LAS float*)(lds + 20480);
    for (int idx = tid; idx < 5120; idx += 512) { const int r = idx >> 10, k = idx & 1023; const float v = r < 4 ? a.in[I_C][r * 1024 + k] : a.in[I_CCTX][k]; sc[idx] = v / (1.f + expf(-v)); }
    __syncthreads();
    const int col = tid & 63, kg = tid >> 6; const float* w = a.in[I_WMOD] + (size_t)l * 1024 * 6144 + cb * 64 + col;
    float acc[5] = {0.f, 0.f, 0.f, 0.f, 0.f};
#pragma unroll 8
    for (int k = kg * 128; k < kg * 128 + 128; ++k) { const float wv = w[(size_t)k * 6144];
#pragma unroll
        for (int r = 0; r < 5; ++r) acc[r] += sc[r * 1024 + k] * wv; }
#pragma unroll
    for (int r = 0; r < 5; ++r) red[(kg * 5 + r) * 64 + col] = acc[r];
    __syncthreads();
    if (tid < 320) { const int r = tid >> 6; float s = a.in[I_BMOD][l * 6144 + cb * 64 + col];
#pragma unroll
        for (int g = 0; g < 8; ++g) s += red[(g * 5 + r) * 64 + col];
        ((float*)(a.ws + WS_MOD))[(size_t)(l * 5 + r) * 6144 + cb * 64 + col] = s; }
    __syncthreads();
}
DI void rope_item(const Args& a) {
    float* rp = (float*)(a.ws + WS_ROPE);
    for (int idx = threadIdx.x; idx < 1024; idx += 512) { const int p = idx >> 4, i = idx & 15; const float fr = powf(10000.f, -(float)i / 16.f); const float ang = (float)p * fr; rp[idx] = cosf(ang); rp[1024 + idx] = sinf(ang); }
}
DI void fold_item(const Args& a, LAS unsigned char* lds, int item) {
    const int tid = threadIdx.x; const int nh = item & 1, kb = (item >> 1) & 15, gi = (item >> 5) & 3, l = item >> 7;
    LAS float* wp = (LAS float*)lds; LAS float* psv = (LAS float*)(lds + 4096);
    for (int idx = tid; idx < 1024; idx += 512) wp[idx] = a.in[I_WPOOL][(((size_t)l * 4 + gi) * 128 + kb * 8 + (idx >> 7)) * 128 + (idx & 127)];
    if (tid < 128) psv[tid] = a.in[I_PSCALE][l * 512 + gi * 128 + tid];
    __syncthreads();
    const int n = nh * 512 + tid; const float* wo = a.in[I_WPO] + ((size_t)l * 512 + gi * 128) * 1024 + n;
    float acc[8] = {0.f, 0.f, 0.f, 0.f, 0.f, 0.f, 0.f, 0.f};
#pragma unroll 4
    for (int j = 0; j < 128; ++j) { const float v = wo[(size_t)j * 1024] * psv[j];
#pragma unroll
        for (int kk = 0; kk < 8; ++kk) acc[kk] += wp[kk * 128 + j] * v; }
    u32x4 o; o.x = pk_bf16(acc[0], acc[1]); o.y = pk_bf16(acc[2], acc[3]); o.z = pk_bf16(acc[4], acc[5]); o.w = pk_bf16(acc[6], acc[7]);
    *(u32x4*)((bf16_t*)(a.ws + WS_WMERGE) + ((size_t)l * 1024 + n) * 1536 + 1024 + gi * 128 + kb * 8) = o;
    __syncthreads();
}
DI void phase_prep(const Args& a, LAS unsigned char* lds, int G, int c) {
    constexpr int NBI = 192 + 1 + 256;
    for (int it = c; it < NBI; it += G) { if (it < 192) mod_item(a, lds, it); else if (it == 192) rope_item(a); else fold_item(a, lds, it - 193); }
    __syncthreads();
    const int wid = __builtin_amdgcn_readfirstlane(threadIdx.x >> 6), lane = threadIdx.x & 63;
    LAS float* scr = (LAS float*)(lds + wid * 16384);
    convert_small(a, scr, c * 8 + wid, G * 8, lane);
    convert_experts(a, 0, scr, c * 8 + wid, G * 8, lane);
}

template <int MODE> DI void norm_phase(const Args& a, int l, LAS unsigned char* lds, int G, int c) {
    const int tid = threadIdx.x, wid = __builtin_amdgcn_readfirstlane(tid >> 6), lane = tid & 63;
    unsigned char* ws = a.ws;
    float* X = (float*)(ws + WS_X); bf16_t* H = (bf16_t*)(ws + WS_H); const float* MOD = (const float*)(ws + WS_MOD);
    float* AFF = (float*)(ws + WS_AFF); const int* SLOTOF = (const int*)(ws + WS_SLOTOF); const bf16_t* Y = (const bf16_t*)(ws + WS_Y);
    LAS float* wr_l = (LAS float*)lds;
    if (MODE == 2) { for (int idx = tid; idx < 16384; idx += 512) wr_l[idx] = a.in[I_WR][(size_t)l * 16384 + idx]; __syncthreads(); }
    const int nrows = (MODE == 3) ? TL : TT; const int rpb = (nrows + G - 1) / G; const int r0 = c * rpb; const int r1 = (r0 + rpb) < nrows ? (r0 + rpb) : nrows;
    for (int row = r0 + wid; row < r1; row += 8) {
        const int mr = row < TL ? (row >> 12) : 4;
        const float* src = (MODE == 0) ? (row < TL ? a.in[I_X] + (size_t)row * DM : a.in[I_CTX] + (size_t)(row - TL) * DM) : X + (size_t)row * DM;
        f32x4 v[4];
#pragma unroll
        for (int j = 0; j < 4; ++j) v[j] = *(const f32x4*)(src + 256 * j + 4 * lane);
        if (MODE == 1 || MODE == 3) {
            const int lp = (MODE == 1) ? 0 : 1;
            const int so = lane < 16 ? SLOTOF[(size_t)row * 16 + lane] : -1; const float af = lane < 16 ? AFF[(size_t)row * 16 + lane] : 0.f;
            f32x4 cacc[4];
#pragma unroll
            for (int j = 0; j < 4; ++j) cacc[j] = (f32x4){0.f, 0.f, 0.f, 0.f};
#pragma unroll
            for (int e = 0; e < 16; ++e) {
                const int s = __builtin_amdgcn_readlane(so, e);
                if (s >= 0) { const float w = __uint_as_float(__builtin_amdgcn_readlane(__float_as_uint(af), e)); const bf16_t* yr = Y + (size_t)s * 1024 + 4 * lane;
#pragma unroll
                    for (int j = 0; j < 4; ++j) { const u32x2 yw = *(const u32x2*)(yr + 256 * j); cacc[j] = cacc[j] + w * (f32x4){bf_lo(yw.x), bf_hi(yw.x), bf_lo(yw.y), bf_hi(yw.y)}; } }
            }
            const float* g2 = MOD + (size_t)(lp * 5 + mr) * 6144 + 5120;
#pragma unroll
            for (int j = 0; j < 4; ++j) v[j] = v[j] + *(const f32x4*)(g2 + 256 * j + 4 * lane) * cacc[j];
            if (MODE == 1) {
#pragma unroll
                for (int j = 0; j < 4; ++j) *(f32x4*)(X + (size_t)row * DM + 256 * j + 4 * lane) = v[j];
            }
        }
        float ss = 0.f;
#pragma unroll
        for (int j = 0; j < 4; ++j) ss += (v[j].x * v[j].x + v[j].y * v[j].y) + (v[j].z * v[j].z + v[j].w * v[j].w);
        const float rms = 1.0f / sqrtf(wave_sum(ss) * (1.f / DM) + 1e-6f);
        if (MODE == 3) {
#pragma unroll
            for (int j = 0; j < 4; ++j) *(f32x4*)(a.out + (size_t)row * DM + 256 * j + 4 * lane) = v[j] * rms * *(const f32x4*)(a.in[I_FNG] + 256 * j + 4 * lane);
        } else {
            const float* gv = (MODE == 2 ? a.in[I_N2G] : a.in[I_N1G]) + (size_t)l * DM;
            const float* mb = MOD + (size_t)(l * 5 + mr) * 6144 + (MODE == 2 ? 3072 : 0);
            f32x4 h[4];
#pragma unroll
            for (int j = 0; j < 4; ++j) { const int k = 256 * j + 4 * lane;
                h[j] = (v[j] * rms * *(const f32x4*)(gv + k)) * (1.f + *(const f32x4*)(mb + 1024 + k)) + *(const f32x4*)(mb + k);
                st_bf4(H + (size_t)row * DM + k, h[j]); }
            if (MODE == 2) {
                float lg[16];
#pragma unroll
                for (int e = 0; e < 16; ++e) lg[e] = 0.f;
#pragma unroll
                for (int j = 0; j < 4; ++j)
#pragma unroll
                    for (int i = 0; i < 4; ++i) { asm volatile("" ::: "memory"); const LAS f32x4* wp = (const LAS f32x4*)(wr_l + (256 * j + 4 * lane + i) * 16); const float hv = h[j][i];
#pragma unroll
                        for (int q = 0; q < 4; ++q) { const f32x4 w4 = wp[q]; lg[4 * q] += hv * w4.x; lg[4 * q + 1] += hv * w4.y; lg[4 * q + 2] += hv * w4.z; lg[4 * q + 3] += hv * w4.w; } }
#pragma unroll
                for (int e = 0; e < 16; ++e) lg[e] = wave_sum(lg[e]);
                float mx = lg[0];
#pragma unroll
                for (int e = 1; e < 16; ++e) mx = fmaxf(mx, lg[e]);
                float sum = 0.f;
#pragma unroll
                for (int e = 0; e < 16; ++e) { lg[e] = expf(lg[e] - mx); sum += lg[e]; }
                const float inv = 1.f / sum;
                if (lane == 0) {
#pragma unroll
                    for (int q = 0; q < 4; ++q) *(f32x4*)(AFF + (size_t)row * 16 + 4 * q) = (f32x4){lg[4 * q] * inv, lg[4 * q + 1] * inv, lg[4 * q + 2] * inv, lg[4 * q + 3] * inv};
                }
            }
        }
    }
    __syncthreads();
}

constexpr int KPITCH = 144, VPITCH = 272;
constexpr int ATT_K = 0, ATT_V = 128 * KPITCH, ATT_WS = ATT_V + 64 * VPITCH;

DI void attn_unit(const Args& a, int l, LAS unsigned char* lds, int kind, int b, int qb, int kh, int hh) {
    const int tid = threadIdx.x, lane = tid & 63, r32 = lane & 31, hi = lane >> 5; const int wid = __builtin_amdgcn_readfirstlane(tid >> 6);
    unsigned char* ws = a.ws;
    const bf16_t* Q = (const bf16_t*)(ws + WS_Q); const bf16_t* Kb = (const bf16_t*)(ws + WS_K); const bf16_t* VT = (const bf16_t*)(ws + WS_VT); bf16_t* BR = (bf16_t*)(ws + WS_BR);
    const int tq0 = kind == 0 ? b * SEQ + qb * 128 : TL + b * CTXL + qb * 128;
    const int ctx0 = TL + b * CTXL;
    const int h = kh * 4 + hh * 2 + (wid >> 2), qs = (wid & 3) * 32;
    const int qi = qs + r32;
    LAS float* wsf = (LAS float*)(lds + ATT_WS) + wid * 64;
    bf16x8 qf[4];
#pragma unroll
    for (int s = 0; s < 4; ++s) qf[s] = *(const bf16x8*)(Q + (size_t)(tq0 + qi) * 512 + h * 64 + s * 16 + hi * 8);
    float mrun = -1e30f, lrun = 0.f;
    f32x16 o[2];
#pragma unroll
    for (int d0 = 0; d0 < 2; ++d0)
#pragma unroll
        for (int r = 0; r < 16; ++r) o[d0][r] = 0.f;
    const int nseg = kind == 0 ? 5 : 2;
    for (int sg = 0; sg < nseg; ++sg) {
        int tok0; int lo_lim = -100000, hi_lim = 100000; bool valid = true;
        if (kind == 0) {
            if (sg == 0) tok0 = tq0;
            else if (sg == 1) { tok0 = tq0 - 128; lo_lim = qi; valid = qb > 0; }
            else if (sg == 2) { tok0 = tq0 + 128; hi_lim = qi; valid = qb < 31; }
            else tok0 = ctx0 + (sg - 3) * 128;
        } else tok0 = ctx0 + sg * 128;
        if (!valid) continue;
        asm volatile("" : "+v"(lo_lim), "+v"(hi_lim));
        __syncthreads();
#pragma unroll
        for (int i = 0; i < 2; ++i) { const int idx = tid + 512 * i; const int row = idx >> 3, ch = idx & 7;
            const u32x4 kv = *(const u32x4*)(Kb + (size_t)(tok0 + row) * 128 + kh * 64 + ch * 8); *(LAS u32x4*)(lds + ATT_K + row * KPITCH + ch * 16) = kv; }
#pragma unroll
        for (int i = 0; i < 2; ++i) { const int idx = tid + 512 * i; const int row = idx >> 4, ch = idx & 15;
            const u32x4 vv = *(const u32x4*)(VT + (size_t)(kh * 64 + row) * TT + tok0 + ch * 8); *(LAS u32x4*)(lds + ATT_V + row * VPITCH + ch * 16) = vv; }
        __syncthreads();
#pragma unroll 1
        for (int tk = 0; tk < 2; ++tk) {
            f32x16 s0, s1;
#pragma unroll
            for (int r = 0; r < 16; ++r) { s0[r] = 0.f; s1[r] = 0.f; }
            const LAS unsigned char* kp = lds + ATT_K + (tk * 64 + r32) * KPITCH + hi * 16;
#pragma unroll
            for (int s = 0; s < 4; ++s) {
                const bf16x8 k0 = *(const LAS bf16x8*)(kp + s * 32);
                const bf16x8 k1 = *(const LAS bf16x8*)(kp + 32 * KPITCH + s * 32);
                s0 = __builtin_amdgcn_mfma_f32_32x32x16_bf16(k0, qf[s], s0, 0, 0, 0);
                s1 = __builtin_amdgcn_mfma_f32_32x32x16_bf16(k1, qf[s], s1, 0, 0, 0);
            }
            const int kb0 = tk * 64 + 4 * hi;
#pragma unroll
            for (int r = 0; r < 16; ++r) { const int kj = kb0 + (r & 3) + 8 * (r >> 2);
                if (kj < lo_lim || kj > hi_lim) s0[r] = -1e30f;
                if (kj + 32 < lo_lim || kj + 32 > hi_lim) s1[r] = -1e30f; }
            float tm = fmaxf(s0[0], s1[0]);
#pragma unroll
            for (int r = 1; r < 16; ++r) tm = fmaxf(tm, fmaxf(s0[r], s1[r]));
            tm = fmaxf(tm, __shfl_xor(tm, 32));
            const float mnew = fmaxf(mrun, tm); const float alpha = __builtin_amdgcn_exp2f(mrun - mnew); mrun = mnew;
            float ls = 0.f;
#pragma unroll
            for (int r = 0; r < 16; ++r) { s0[r] = __builtin_amdgcn_exp2f(s0[r] - mnew); s1[r] = __builtin_amdgcn_exp2f(s1[r] - mnew); ls += s0[r] + s1[r]; }
            lrun = lrun * alpha + ls;
            if (hi == 0) wsf[r32] = alpha;
#pragma unroll
            for (int r = 0; r < 16; ++r) { const float f = wsf[crow(r, hi)]; o[0][r] *= f; o[1][r] *= f; }
            const LAS unsigned char* vp0 = lds + ATT_V + r32 * VPITCH + (tk * 64 + 4 * hi) * 2;
#pragma unroll
            for (int cc = 0; cc < 2; ++cc)
#pragma unroll
                for (int s = 0; s < 2; ++s) {
                    u32x4 pw;
                    if (cc == 0) { pw.x = pk_bf16(s0[8 * s], s0[8 * s + 1]); pw.y = pk_bf16(s0[8 * s + 2], s0[8 * s + 3]); pw.z = pk_bf16(s0[8 * s + 4], s0[8 * s + 5]); pw.w = pk_bf16(s0[8 * s + 6], s0[8 * s + 7]); }
                    else { pw.x = pk_bf16(s1[8 * s], s1[8 * s + 1]); pw.y = pk_bf16(s1[8 * s + 2], s1[8 * s + 3]); pw.z = pk_bf16(s1[8 * s + 4], s1[8 * s + 5]); pw.w = pk_bf16(s1[8 * s + 6], s1[8 * s + 7]); }
                    const bf16x8 pa = __builtin_bit_cast(bf16x8, pw);
#pragma unroll
                    for (int d0 = 0; d0 < 2; ++d0) {
                        const LAS unsigned char* vp = vp0 + d0 * 32 * VPITCH + (cc * 32 + s * 16) * 2;
                        const s16x4 lo = *(const LAS s16x4*)vp, hh2 = *(const LAS s16x4*)(vp + 16);
                        const bf16x8 vb = (bf16x8){lo[0], lo[1], lo[2], lo[3], hh2[0], hh2[1], hh2[2], hh2[3]};
                        o[d0] = __builtin_amdgcn_mfma_f32_32x32x16_bf16(pa, vb, o[d0], 0, 0, 0);
                    }
                }
        }
    }
    const float sk = a.in[I_SINK][l * 8 + h] * LOG2E;
    {
        const float lt = lrun + __shfl_xor(lrun, 32) + __builtin_amdgcn_exp2f(sk - mrun);
        if (hi == 0) wsf[r32] = 1.f / lt;
#pragma unroll
        for (int r = 0; r < 16; ++r) { const float f = wsf[crow(r, hi)]; bf16_t* op = BR + (size_t)(tq0 + qs + crow(r, hi)) * 1536 + h * 64 + r32;
            op[0] = f2bf(o[0][r] * f); op[32] = f2bf(o[1][r] * f); }
    }
    __syncthreads();
}

DI void seq_bounds(int t0, int& lo, int& hi) { if (t0 < TL) { lo = t0 & ~(SEQ - 1); hi = lo + SEQ; } else { lo = TL + ((t0 - TL) & ~(CTXL - 1)); hi = lo + CTXL; } }

DI void conv_unit(const Args& a, int l, LAS unsigned char* lds, int t0) {
    const int tid = threadIdx.x, lane = tid & 63; const int wid = __builtin_amdgcn_readfirstlane(tid >> 6);
    const bf16_t* U = (const bf16_t*)(a.ws + WS_U); bf16_t* BR = (bf16_t*)(a.ws + WS_BR);
    int slo, shi; seq_bounds(t0, slo, shi);
    for (int idx = tid; idx < 62 * 64; idx += 512) { const int row = idx >> 6, ch = idx & 63; const int tok = t0 - 15 + row; u32x4 v = (u32x4){0u, 0u, 0u, 0u};
        if (tok >= slo && tok < shi) v = *(const u32x4*)(U + (size_t)tok * 512 + ch * 8); *(LAS u32x4*)(lds + row * 1024 + ch * 16) = v; }
    __syncthreads();
    const int c = tid; float w[31];
#pragma unroll
    for (int k = 0; k < 31; ++k) w[k] = a.in[I_CDW][((size_t)l * 31 + k) * 512 + c];
    const float bias = a.in[I_CDWB][l * 512 + c];
    float xin[62];
#pragma unroll
    for (int i = 0; i < 62; ++i) xin[i] = bf2f(((const LAS bf16_t*)lds)[i * 512 + c]);
    LAS float* cs = (LAS float*)(lds + 65536);
#pragma unroll
    for (int t = 0; t < 32; ++t) { float acc = bias;
#pragma unroll
        for (int k = 0; k < 31; ++k) acc = fmaf(xin[t + k], w[k], acc);
        cs[t * 512 + c] = acc; }
    __syncthreads();
    const float* lg = a.in[I_CLNG] + l * 512; const float* lb = a.in[I_CLNB] + l * 512;
#pragma unroll
    for (int tt = 0; tt < 4; ++tt) { const int t = 4 * wid + tt; float v[8]; float s = 0.f;
#pragma unroll
        for (int i = 0; i < 8; ++i) { v[i] = cs[t * 512 + lane + 64 * i]; s += v[i]; }
        const float mean = wave_sum(s) * (1.f / 512.f); float q = 0.f;
#pragma unroll
        for (int i = 0; i < 8; ++i) { v[i] -= mean; q += v[i] * v[i]; }
        const float rstd = 1.0f / sqrtf(wave_sum(q) * (1.f / 512.f) + 1e-6f);
#pragma unroll
        for (int i = 0; i < 8; ++i) { const int c2 = lane + 64 * i; const float y = v[i] * rstd * lg[c2] + lb[c2]; BR[(size_t)(t0 + t) * 1536 + 512 + c2] = f2bf(y * sigm(y)); } }
    __syncthreads();
}
DI void pool_unit(const Args& a, LAS unsigned char* lds, int t0) {
    const int tid = threadIdx.x;
    const bf16_t* Z = (const bf16_t*)(a.ws + WS_Z); bf16_t* BR = (bf16_t*)(a.ws + WS_BR);
    int slo, shi; seq_bounds(t0, slo, shi);
    for (int idx = tid; idx < 48 * 64; idx += 512) { const int row = idx >> 6, ch = idx & 63; const int tok = t0 - 8 + row; u32x4 v = (u32x4){0u, 0u, 0u, 0u};
        if (tok >= slo && tok < shi) v = *(const u32x4*)(Z + (size_t)tok * 512 + ch * 8); *(LAS u32x4*)(lds + row * 1024 + ch * 16) = v; }
    __syncthreads();
    const int c = tid; const int half = 1 << (c >> 7); const LAS bf16_t* zs = (const LAS bf16_t*)lds;
    for (int t = 0; t < 32; ++t) { const int tt = t0 + t; const int lo = (tt - half) > slo ? (tt - half) : slo, hi = (tt + half) < shi ? (tt + half) : shi; float s = 0.f;
        for (int tok = lo; tok < hi; ++tok) s += bf2f(zs[(tok - t0 + 8) * 512 + c]);
        const float d = s / (float)(hi - lo) - bf2f(zs[(t + 8) * 512 + c]);
        BR[(size_t)tt * 1536 + 1024 + c] = f2bf(d); }
    __syncthreads();
}
DI void phase_mix(const Args& a, int l, LAS unsigned char* lds, int G, int c) {
    for (int u = c; u < 512; u += G) attn_unit(a, l, lds, 0, u >> 7, (u >> 2) & 31, (u >> 1) & 1, u & 1);
    const int nconv = l == 0 ? TT / 32 : TL / 32; const int nx = 2 * nconv + (l == 0 ? 32 : 0);
    for (int j = c; j < nx; j += G) {
        if (j < nconv) conv_unit(a, l, lds, j * 32);
        else if (j < 2 * nconv) pool_unit(a, lds, (j - nconv) * 32);
        else { const int x = j - 2 * nconv; attn_unit(a, l, lds, 1, x >> 3, (x >> 2) & 1, (x >> 1) & 1, x & 1); }
    }
}

DI void topk_unit(const Args& a, LAS unsigned char* lds, int set, int e) {
    const int tid = threadIdx.x; const bool lat = set < 4; const int b = set & 3;
    const int N = lat ? SEQ : CTXL, cap = N / 8, tok0 = lat ? b * SEQ : TL + b * CTXL, sbase = e * ESLOT + (lat ? b * 512 : 2048 + b * 32);
    const float* AFF = (const float*)(a.ws + WS_AFF); int* SLOTOF = (int*)(a.ws + WS_SLOTOF); int* TOKOF = (int*)(a.ws + WS_TOKOF);
    LAS unsigned long long* key = (LAS unsigned long long*)lds;
    for (int i = tid; i < N; i += 512) key[i] = ((unsigned long long)__float_as_uint(AFF[(size_t)(tok0 + i) * 16 + e]) << 32) | (unsigned long long)(0xFFFFFFFFu - (unsigned)i);
    __syncthreads();
    for (int k = 2; k <= N; k <<= 1)
        for (int j = k >> 1; j > 0; j >>= 1) {
            for (int i = tid; i < N / 2; i += 512) { const int lo = ((i & ~(j - 1)) << 1) | (i & (j - 1)), hi2 = lo | j; const bool up = (lo & k) == 0;
                const unsigned long long x = key[lo], y = key[hi2]; if ((x > y) == up) { key[lo] = y; key[hi2] = x; } }
            __syncthreads();
        }
    for (int p = tid; p < N; p += 512) { const unsigned long long kk = key[p]; const int i = (int)(0xFFFFFFFFu - (unsigned)kk); const int tok = tok0 + i;
        if (p >= N - cap) { const int slot = sbase + (N - 1 - p); SLOTOF[(size_t)tok * 16 + e] = slot; TOKOF[slot] = tok; } else SLOTOF[(size_t)tok * 16 + e] = -1; }
    if (set == 4 && tid < 128) TOKOF[e * ESLOT + 2176 + tid] = 0;
    __syncthreads();
}

#define XB_TMO      128
#define XB_XCNT(j)  (256  + 64 * (j))
#define XB_XSUB(j)  (1280 + 64 * (j))
#define XB_XGEN(j)  (2304 + 64 * (j))
#define XB_TOP      3328
#define XB_TOPGEN   3392
#define XCD_BAR_WORDS 3456
#define XB_SPIN_CAP (1u << 22)
DI unsigned xb_ld(unsigned* p) { return __hip_atomic_load(p, __ATOMIC_RELAXED, __HIP_MEMORY_SCOPE_AGENT); }
DI unsigned xb_add(unsigned* p, unsigned v) { return __hip_atomic_fetch_add(p, v, __ATOMIC_RELAXED, __HIP_MEMORY_SCOPE_AGENT); }
DI unsigned xb_xcc_id() { return (unsigned)__builtin_amdgcn_s_getreg((3 << 11) | 20) & 0xFu; }
#define XB_SPIN(cond, bar) do { unsigned _sp = 0; while (cond) { __builtin_amdgcn_s_sleep(1); \
    if ((++_sp & 255u) == 0u) { if (xb_ld(&(bar)[XB_TMO])) break; if (_sp > XB_SPIN_CAP) { atomicAdd(&(bar)[XB_TMO], 1u); break; } } } } while (0)
struct XcdBarrier { unsigned* bar; unsigned x; volatile LAS unsigned* st; };
DI XcdBarrier xcd_barrier_post(unsigned* bar, volatile LAS unsigned* st) {
    XcdBarrier b; b.bar = bar; b.x = xb_xcc_id(); b.st = st;
    if (threadIdx.x == 0) (void)xb_add(&bar[XB_XCNT(b.x)], 1u);
    return b;
}
DI void xcd_barrier_complete(unsigned* bar, unsigned x, unsigned& nloc, unsigned& nx) {
    const unsigned G = gridDim.x * gridDim.y * gridDim.z;
    unsigned sum, cnt, mine, sp = 0u;
    for (;;) {
        sum = 0u; cnt = 0u; mine = 0u;
#pragma unroll
        for (unsigned j = 0; j < 16; ++j) { const unsigned c = xb_ld(&bar[XB_XCNT(j)]); sum += c; cnt += (c > 0u) ? 1u : 0u; mine = (j == x) ? c : mine; }
        if (sum == G) break;
        __builtin_amdgcn_s_sleep(1);
        if ((++sp & 255u) == 0u) { if (xb_ld(&bar[XB_TMO])) break; if (sp > XB_SPIN_CAP) { atomicAdd(&bar[XB_TMO], 1u); break; } }
    }
    nloc = mine > 0u ? mine : 1u; nx = cnt > 0u ? cnt : 1u;
}
DI void xcd_barrier(const XcdBarrier& b) {
    asm volatile("s_waitcnt vmcnt(0)" ::: "memory");
    __syncthreads();
    if (threadIdx.x == 0) {
        unsigned* bar = b.bar;
        __builtin_amdgcn_s_waitcnt(0);
        unsigned nloc = b.st[0], nx = b.st[1];
        if (nloc == 0u) { xcd_barrier_complete(bar, b.x, nloc, nx); b.st[0] = nloc; b.st[1] = nx; }
        const unsigned old = xb_add(&bar[XB_XSUB(b.x)], 1u);
        const unsigned gen = old / nloc;
        if (old + 1u == (gen + 1u) * nloc) {
            __builtin_amdgcn_fence(__ATOMIC_RELEASE, "agent");
            asm volatile("s_waitcnt vmcnt(0)" ::: "memory");
            const unsigned og = xb_add(&bar[XB_TOP], 1u);
            const unsigned tg = og / nx;
            if (og + 1u == (tg + 1u) * nx) xb_add(&bar[XB_TOPGEN], 1u);
            else XB_SPIN(xb_ld(&bar[XB_TOPGEN]) == tg, bar);
            __builtin_amdgcn_fence(__ATOMIC_ACQUIRE, "agent");
            xb_add(&bar[XB_XGEN(b.x)], 1u);
            asm volatile("s_waitcnt vmcnt(0)" ::: "memory");
        } else {
            XB_SPIN(xb_ld(&bar[XB_XGEN(b.x)]) == gen, bar);
            __builtin_amdgcn_fence(__ATOMIC_ACQUIRE, "agent");
            asm volatile("s_waitcnt vmcnt(0)" ::: "memory");
        }
    }
    __syncthreads();
}

#if !MK_PER_PHASE
#define GRID_BAR() xcd_barrier(bar)
#else
#define GRID_BAR() do {} while (0)
#endif
#define IN(k) (lo <= (k) && (k) < hi)
#define SEAM(k) do { if (lo < (k) && (k) < hi) GRID_BAR(); } while (0)

template <int L> DI void run_layer(const Args& a, LAS unsigned char* lds, int G, int c, int lo, int hi, const XcdBarrier& bar) {
    unsigned char* ws = a.ws;
    constexpr int l = L, base = 1 + 9 * L, nM = L == 0 ? 68 : 64, nmt = L == 0 ? 9 : 8;
    const int tid = threadIdx.x;
    SEAM(base + 0);
    if (IN(base + 0)) { if (L == 0) norm_phase<0>(a, 0, lds, G, c); else norm_phase<1>(a, 1, lds, G, c); }
    SEAM(base + 1);
    if (IN(base + 1)) {
        SchedInProj S; S.nt = 16; S.ldb_b = 2048; S.lda_b = 2048; S.G = G; S.c = c; S.A = (const char*)(ws + WS_H); S.B = (const char*)(ws + WS_WIN) + (size_t)l * INW * 2048;
        S.nM = nM; S.nmain = nM * 21; S.nextra = l == 0 ? 0 : 4;
        EpiInProj E{(bf16_t*)(ws + WS_Q), (bf16_t*)(ws + WS_K), (bf16_t*)(ws + WS_VT), (bf16_t*)(ws + WS_U), (bf16_t*)(ws + WS_Z), (bf16_t*)(ws + WS_G), (const float*)(ws + WS_ROPE)};
        pg8::gemm_phase(lds, S, E);
    }
    SEAM(base + 2);
    if (IN(base + 2)) phase_mix(a, l, lds, G, c);
    SEAM(base + 3);
    if (IN(base + 3)) {
        SchedMerge S; S.nt = 8; S.ldb_b = 3072; S.lda_b = 3072; S.G = G; S.c = c; S.A = (const char*)(ws + WS_BR); S.B = (const char*)(ws + WS_WMERGE) + (size_t)l * 1024 * 3072; S.nM = nM;
        EpiMerge E{(const bf16_t*)(ws + WS_G), (bf16_t*)(ws + WS_MERGED)};
        pg8::gemm_phase(lds, S, E);
    }
    SEAM(base + 4);
    if (IN(base + 4)) {
        SchedOut S; S.nt = 16; S.ldb_b = 2048; S.lda_b = 2048; S.G = G; S.c = c; S.A = (const char*)(ws + WS_MERGED); S.B = (const char*)(ws + WS_WOUT) + (size_t)l * 1024 * 2048; S.nM = nM;
        EpiOut E{a.in[I_X], a.in[I_CTX], (float*)(ws + WS_X), (const float*)(ws + WS_MOD), l};
        pg8::gemm_phase(lds, S, E);
    }
    SEAM(base + 5);
    if (IN(base + 5)) norm_phase<2>(a, l, lds, G, c);
    SEAM(base + 6);
    if (IN(base + 6)) {
        const int nu = l == 0 ? 128 : 64;
        for (int u = c; u < nu; u += G) topk_unit(a, lds, u >> 4, u & 15);
        if (l == 1) {
            __syncthreads();
            const int wid = __builtin_amdgcn_readfirstlane(tid >> 6);
            convert_experts(a, 1, (LAS float*)(lds + wid * 16384), c * 8 + wid, G * 8, tid & 63);
        }
    }
    SEAM(base + 7);
    if (IN(base + 7)) {
        const int* TOKOF = (const int*)(ws + WS_TOKOF); LAS int* idx = (LAS int*)(lds + LDS_IDX_OFF);
        const int nunits = NE * nmt * 8;
        for (int ibase = 0; ibase * G + c < nunits; ibase += 8) {
            __syncthreads();
            for (int q = tid; q < 8 * 256; q += 512) { const int i = q >> 8; const int Lu = (ibase + i) * G + c;
                if (Lu < nunits) { const int mt = (Lu / 8) % nmt, e = Lu / (8 * nmt); idx[q] = TOKOF[e * ESLOT + mt * 256 + (q & 255)]; } }
            __syncthreads();
            SchedGU S; S.nt = 16; S.ldb_b = 2048; S.lda_b = 2048; S.G = G; S.c = c; S.A = (const char*)(ws + WS_H); S.B = (const char*)(ws + WS_WGU); S.nmt = nmt; S.ibase = ibase; S.idx = idx;
            EpiGU E{(bf16_t*)(ws + WS_ACT)};
            pg8::gemm_phase(lds, S, E);
        }
    }
    SEAM(base + 8);
    if (IN(base + 8)) {
        SchedDown S; S.nt = 16; S.ldb_b = 2048; S.lda_b = 2048; S.G = G; S.c = c; S.A = (const char*)(ws + WS_ACT); S.B = (const char*)(ws + WS_WDN); S.nmt = nmt;
        EpiDown E{(bf16_t*)(ws + WS_Y)};
        pg8::gemm_phase(lds, S, E);
    }
}

__global__ void __launch_bounds__(512, 2) fwd_kernel(Args a) {
    extern __shared__ __attribute__((aligned(16))) unsigned char lds_raw[];
    LAS unsigned char* lds = (LAS unsigned char*)lds_raw;
    const int tid = threadIdx.x; const int G = gridDim.x, c = blockIdx.x;
    volatile LAS unsigned* MISC = (volatile LAS unsigned*)(lds + LDS_MISC_OFF);
    if (tid < 32) MISC[tid] = 0u;
    __syncthreads();
#if !MK_PER_PHASE
    XcdBarrier bar = xcd_barrier_post((unsigned*)(a.ws + WS_BAR), MISC + 8);
#else
    XcdBarrier bar; bar.bar = nullptr; bar.x = 0; bar.st = MISC + 8;
#endif
    const int lo = a.ph_lo, hi = a.ph_hi;
    if (IN(0)) phase_prep(a, lds, G, c);
    run_layer<0>(a, lds, G, c, lo, hi, bar);
    run_layer<1>(a, lds, G, c, lo, hi, bar);
    SEAM(NPHASE - 1);
    if (IN(NPHASE - 1)) norm_phase<3>(a, 1, lds, G, c);
}

extern "C" void kernel_launch(void* const* d_in, const int* in_sizes, int n_in, void* d_out, int out_size, void* d_ws, size_t ws_size, hipStream_t stream) {
    static int grid = 0;
    if (grid == 0) {
        if (n_in != 25 || out_size != TL * DM || ws_size < WS_END) { fprintf(stderr, "kernel_launch: unexpected shapes (n_in %d out %d ws %zu)\n", n_in, out_size, ws_size); grid = -1; return; }
        int dev = 0, cus = 0, per_cu = 0;
        if (hipGetDevice(&dev) != hipSuccess || hipDeviceGetAttribute(&cus, hipDeviceAttributeMultiprocessorCount, dev) != hipSuccess) { grid = -1; return; }
        if (hipFuncSetAttribute((const void*)fwd_kernel, hipFuncAttributeMaxDynamicSharedMemorySize, LDS_BYTES) != hipSuccess) { fprintf(stderr, "kernel_launch: hipFuncSetAttribute failed\n"); grid = -1; return; }
        if (hipOccupancyMaxActiveBlocksPerMultiprocessor(&per_cu, (const void*)fwd_kernel, 512, LDS_BYTES) != hipSuccess || per_cu < 1) { fprintf(stderr, "kernel_launch: occupancy query says %d blocks per CU\n", per_cu); (void)hipGetLastError(); grid = -1; return; }
        grid = cus;
    }
    if (grid < 0) return;
    (void)hipMemsetAsync((char*)d_ws + WS_BAR, 0, 65536, stream);
    Args a{};
    for (int i = 0; i < 25; ++i) a.in[i] = (const float*)d_in[i];
    a.out = (float*)d_out; a.ws = (unsigned char*)d_ws;
#if MK_PER_PHASE
    for (int ph = 0; ph < NPHASE; ++ph) { a.ph_lo = ph; a.ph_hi = ph + 1; hipLaunchKernelGGL(fwd_kernel, dim3(grid), dim3(512), LDS_BYTES, stream, a); }
#else
    a.ph_lo = 0; a.ph_hi = NPHASE;
    hipLaunchKernelGGL(fwd_kernel, dim3(grid), dim3(512), LDS_BYTES, stream, a);
#endif
}
```

```cpp
#include <hip/hip_runtime.h>
#include <hip/hip_cooperative_groups.h>
#include <cstdio>
#include <cstdint>
namespace cg = cooperative_groups;

#ifndef MK_PER_PHASE
#define MK_PER_PHASE 0
#endif

#define LAS __attribute__((address_space(3)))
#define DI __device__ __forceinline__
typedef unsigned short bf16_t;
typedef short bf16x8 __attribute__((ext_vector_type(8)));
typedef short s16x4 __attribute__((ext_vector_type(4)));
typedef float f32x4 __attribute__((ext_vector_type(4)));
typedef float f32x16 __attribute__((ext_vector_type(16)));
typedef unsigned u32x4 __attribute__((ext_vector_type(4)));
typedef unsigned u32x2 __attribute__((ext_vector_type(2)));

constexpr int DM = 1024, NBATCH = 4, SEQ = 4096, CTXL = 256;
constexpr int TL = NBATCH * SEQ, TC = NBATCH * CTXL, TT = TL + TC;
constexpr int INW = 5376;
constexpr int NE = 16, ESLOT = 2304;
constexpr float LOG2E = 1.4426950408889634f;
constexpr float QSC = 0.125f * LOG2E;
constexpr int NPHASE = 20;

constexpr size_t MiB = (size_t)1 << 20;
constexpr size_t WS_BAR = 0;
constexpr size_t WS_MOD = 1 * MiB, WS_ROPE = 1 * MiB + 512 * 1024;
constexpr size_t WS_AFF = 2 * MiB, WS_SLOTOF = 4 * MiB, WS_TOKOF = 6 * MiB;
constexpr size_t WS_WIN = 8 * MiB, WS_WMERGE = 29 * MiB, WS_WOUT = 35 * MiB, WS_WGU = 40 * MiB, WS_WDN = 104 * MiB;
constexpr size_t WS_X = 136 * MiB, WS_H = 204 * MiB;
constexpr size_t WS_Q = 238 * MiB, WS_K = 255 * MiB, WS_VT = 260 * MiB, WS_U = 265 * MiB, WS_Z = 282 * MiB, WS_G = 299 * MiB, WS_BR = 401 * MiB, WS_MERGED = 452 * MiB;
constexpr size_t WS_ACT = 238 * MiB, WS_Y = 310 * MiB;
constexpr size_t WS_END = 486 * MiB;

constexpr int LDS_BYTES = 147456;
constexpr int RING_BYTES = 131072;
constexpr int LDS_IDX_OFF = RING_BYTES;
constexpr int LDS_MISC_OFF = RING_BYTES + 8192;

struct Args { const float* in[25]; float* out; unsigned char* ws; int ph_lo, ph_hi; };
enum { I_X = 0, I_C, I_CTX, I_CCTX, I_N1G, I_N2G, I_WMOD, I_BMOD, I_WIN, I_SINK, I_WAO, I_CDW, I_CDWB, I_CLNG, I_CLNB, I_WCO, I_WPOOL, I_PSCALE, I_WPO, I_WOUT, I_WR, I_WEG, I_WEU, I_WED, I_FNG };

DI unsigned pk_bf16(float lo, float hi) {
    typedef float f2 __attribute__((ext_vector_type(2))); typedef __bf16 b2 __attribute__((ext_vector_type(2)));
    f2 v = {lo, hi}; b2 b = __builtin_convertvector(v, b2); return __builtin_bit_cast(unsigned, b);
}
DI bf16_t f2bf(float f) { return (bf16_t)(pk_bf16(f, 0.f) & 0xffffu); }
DI float bf_lo(unsigned u) { return __uint_as_float(u << 16); }
DI float bf_hi(unsigned u) { return __uint_as_float(u & 0xffff0000u); }
DI float bf2f(bf16_t b) { return __uint_as_float(((unsigned)b) << 16); }
DI float sigm(float x) { return 1.f / (1.f + __expf(-x)); }
DI float wave_sum(float v) {
#pragma unroll
    for (int o = 1; o < 64; o <<= 1) v += __shfl_xor(v, o);
    return v;
}
DI int crow(int r, int hi) { return (r & 3) + 8 * (r >> 2) + 4 * hi; }
#define LDS_WAIT() asm volatile("s_waitcnt lgkmcnt(0)" ::: "memory")

namespace pg8 {
constexpr int BM = 256, BK = 64, HALF = 128, HTB = HALF * BK * 2;
DI int lds_byte(int r, int c) { const int st = (r >> 4) * 2 + (c >> 5), rr = r & 15, cc = c & 31, ob = rr * 64 + cc * 2; return st * 1024 + (ob ^ (((ob >> 9) & 1) << 5)); }
DI void stage_rc(int b, int& R, int& C) { const int st = b / 1024, sb = b % 1024, swz = sb ^ (((sb >> 9) & 1) << 5); R = (st >> 1) * 16 + swz / 64; C = (st & 1) * 32 + (swz % 64) / 2; }

struct Unit { const char* a; const char* b; int i0, i1, i2, ui; };

DI void tile_order(int L, int nM, int nN, int& pm, int& pn) {
    const int nwg = nM * nN; int wgid = L;
    { const int q = nwg / 8, r = nwg % 8, xcd = wgid % 8, off = wgid / 8; wgid = (xcd < r ? xcd * (q + 1) : r * (q + 1) + (xcd - r) * q) + off; }
    const int nig = 8 * nN, gid = wgid / nig, fm = gid * 8, gsz = (nM - fm) < 8 ? (nM - fm) : 8;
    pm = fm + ((wgid % nig) % gsz); pn = (wgid % nig) / gsz;
}

template <class Epi, class Sched>
DI void gemm_phase(LAS unsigned char* lds, const Sched& S, const Epi& E) {
    const int tid = threadIdx.x, wid = __builtin_amdgcn_readfirstlane(tid >> 6), lane = tid & 63, wr = wid >> 2, wc = wid & 3, fr = lane & 15, fq = lane >> 4;
    const int nt = S.nt;
    int R0, C0, R1, C1; stage_rc(tid * 16, R0, C0); stage_rc(tid * 16 + 8192, R1, C1);
    unsigned voffB[2][2];
#pragma unroll
    for (int h = 0; h < 2; ++h) { voffB[h][0] = (unsigned)((h * HALF + R0) * S.ldb_b + C0 * 2); voffB[h][1] = (unsigned)((h * HALF + R1) * S.ldb_b + C1 * 2); }
    const size_t kstep = (size_t)(BK * 2);
    const unsigned ldsw = (unsigned)wid * 1024u;
    const int aoff = lds_byte(wr * 64 + fr, fq * 8), boff = lds_byte(wc * 32 + fr, fq * 8);
#define PG8_SA(b, h) (((b) * 2 + (h)) * HTB)
#define PG8_SB(b, h) ((4 + (b) * 2 + (h)) * HTB)
#define PG8_STAGE(bufoff, gbase, voff) do { _Pragma("unroll") for (int _i = 0; _i < 2; ++_i) \
        __builtin_amdgcn_global_load_lds((const unsigned*)((const char*)(gbase) + (voff)[_i]), (LAS unsigned*)(lds + (bufoff) + ldsw + _i * 8192), 16, 0, 0); } while (0)
#define PG8_LDA(dst, b, h) do { _Pragma("unroll") for (int m = 0; m < 4; ++m) _Pragma("unroll") for (int k = 0; k < 2; ++k) dst[m][k] = *(const LAS bf16x8*)(lds + PG8_SA(b, h) + aoff + m * 2048 + k * 1024); } while (0)
#define PG8_LDB(dst, b, h) do { _Pragma("unroll") for (int n = 0; n < 2; ++n) _Pragma("unroll") for (int k = 0; k < 2; ++k) dst[n][k] = *(const LAS bf16x8*)(lds + PG8_SB(b, h) + boff + n * 2048 + k * 1024); } while (0)
#define PG8_MMA(ai, bj, At, Bt) do { __builtin_amdgcn_s_setprio(1); _Pragma("unroll") for (int m = 0; m < 4; ++m) _Pragma("unroll") for (int n = 0; n < 2; ++n) _Pragma("unroll") for (int k = 0; k < 2; ++k) \
        acc[ai][bj][m][n] = __builtin_amdgcn_mfma_f32_16x16x32_bf16(Bt[n][k], At[m][k], acc[ai][bj][m][n], 0, 0, 0); __builtin_amdgcn_s_setprio(0); } while (0)
#define PG8_WAIT_V(n) asm volatile("s_waitcnt vmcnt(" #n ")" ::: "memory")
#define PG8_WAIT_L(n) asm volatile("s_waitcnt lgkmcnt(" #n ")" ::: "memory")
#define PG8_BAR __builtin_amdgcn_s_barrier()
#define PG8_SCHED __builtin_amdgcn_sched_barrier(0)
    Unit cur, nxt; int ui = 0;
    if (!S.next(0, cur)) return;
    f32x4 acc[2][2][4][2];
#pragma unroll
    for (int a = 0; a < 2; ++a)
#pragma unroll
        for (int b = 0; b < 2; ++b)
#pragma unroll
            for (int m = 0; m < 4; ++m)
#pragma unroll
                for (int n = 0; n < 2; ++n) acc[a][b][m][n] = (f32x4){0.f, 0.f, 0.f, 0.f};
    bf16x8 At[4][2], B0[2][2], B1[2][2];
    unsigned cvA[2][2], nvA[2][2];
    S.voff(cur, R0, C0, R1, C1, cvA);
    const char* cA = cur.a; const char* cB = cur.b;
    PG8_STAGE(PG8_SB(0, 0), cB, voffB[0]); PG8_STAGE(PG8_SB(0, 1), cB, voffB[1]); PG8_STAGE(PG8_SA(0, 0), cA, cvA[0]); PG8_STAGE(PG8_SA(0, 1), cA, cvA[1]);
    if (wr == 1) PG8_BAR;
    PG8_WAIT_V(2); PG8_BAR;
    PG8_STAGE(PG8_SB(1, 0), cB + kstep, voffB[0]); PG8_STAGE(PG8_SA(1, 0), cA + kstep, cvA[0]); PG8_STAGE(PG8_SB(1, 1), cB + kstep, voffB[1]);
    PG8_WAIT_V(6); PG8_BAR;
    for (;;) {
        const bool has_next = S.next(ui + 1, nxt);
        const char* nA = has_next ? nxt.a : cA; const char* nB = has_next ? nxt.b : cB;
        if (has_next) S.voff(nxt, R0, C0, R1, C1, nvA);
        else {
#pragma unroll
            for (int h = 0; h < 2; ++h) { nvA[h][0] = cvA[h][0]; nvA[h][1] = cvA[h][1]; }
        }
        for (int t = 0; t < nt; t += 2) {
            const bool last = (t == nt - 2);
            const char* a1 = cA + (size_t)(t + 1) * kstep;
            const char* a2 = last ? nA : cA + (size_t)(t + 2) * kstep; const char* b2 = last ? nB : cB + (size_t)(t + 2) * kstep;
            const char* a3 = a2 + kstep; const char* b3 = b2 + kstep;
            unsigned v2[2][2];
#pragma unroll
            for (int h = 0; h < 2; ++h) { v2[h][0] = last ? nvA[h][0] : cvA[h][0]; v2[h][1] = last ? nvA[h][1] : cvA[h][1]; }
            PG8_LDB(B0, 0, 0); PG8_LDB(B1, 0, 1); PG8_SCHED; PG8_LDA(At, 0, 0); PG8_STAGE(PG8_SA(1, 1), a1, cvA[1]);
            PG8_WAIT_V(8); PG8_WAIT_L(0); PG8_BAR; PG8_MMA(0, 0, At, B0); PG8_MMA(0, 1, At, B1); PG8_BAR; PG8_SCHED;
            PG8_LDA(At, 0, 1); PG8_STAGE(PG8_SB(0, 0), b2, voffB[0]); PG8_STAGE(PG8_SB(0, 1), b2, voffB[1]); PG8_STAGE(PG8_SA(0, 0), a2, v2[0]);
            PG8_WAIT_V(8); PG8_WAIT_L(0); PG8_BAR; PG8_MMA(1, 0, At, B0); PG8_MMA(1, 1, At, B1); PG8_BAR; PG8_SCHED;
            PG8_LDB(B0, 1, 0); PG8_LDB(B1, 1, 1); PG8_SCHED; PG8_LDA(At, 1, 0); PG8_STAGE(PG8_SA(0, 1), a2, v2[1]);
            PG8_WAIT_V(8); PG8_WAIT_L(0); PG8_BAR; PG8_MMA(0, 0, At, B0); PG8_MMA(0, 1, At, B1); PG8_BAR; PG8_SCHED;
            PG8_LDA(At, 1, 1); PG8_STAGE(PG8_SB(1, 0), b3, voffB[0]); PG8_STAGE(PG8_SB(1, 1), b3, voffB[1]); PG8_STAGE(PG8_SA(1, 0), a3, v2[0]);
            PG8_WAIT_V(8); PG8_WAIT_L(0); PG8_BAR; PG8_MMA(1, 0, At, B0); PG8_MMA(1, 1, At, B1); PG8_BAR; PG8_SCHED;
        }
        if (wr == 0) PG8_BAR;
        E(acc, cur, wr, wc, fr, fq);
        if (!has_next) break;
#pragma unroll
        for (int a = 0; a < 2; ++a)
#pragma unroll
            for (int b = 0; b < 2; ++b)
#pragma unroll
                for (int m = 0; m < 4; ++m)
#pragma unroll
                    for (int n = 0; n < 2; ++n) acc[a][b][m][n] = (f32x4){0.f, 0.f, 0.f, 0.f};
        cur = nxt; cA = nA; cB = nB; ++ui;
#pragma unroll
        for (int h = 0; h < 2; ++h) { cvA[h][0] = nvA[h][0]; cvA[h][1] = nvA[h][1]; }
        if (wr == 1) PG8_BAR;
    }
    PG8_WAIT_V(0);
    PG8_BAR;
#undef PG8_SA
#undef PG8_SB
#undef PG8_STAGE
#undef PG8_LDA
#undef PG8_LDB
#undef PG8_MMA
#undef PG8_WAIT_V
#undef PG8_WAIT_L
#undef PG8_BAR
#undef PG8_SCHED
}
}
using pg8::Unit;
typedef f32x4 Acc[2][2][4][2];

struct SchedBase {
    int nt, ldb_b, lda_b, G, c;
    DI void voff_contig(int R0, int C0, int R1, int C1, unsigned (&vo)[2][2]) const {
#pragma unroll
        for (int h = 0; h < 2; ++h) { vo[h][0] = (unsigned)((h * 128 + R0) * lda_b + C0 * 2); vo[h][1] = (unsigned)((h * 128 + R1) * lda_b + C1 * 2); }
    }
};
struct SchedInProj : SchedBase {
    const char* A; const char* B; int nM, nmain, nextra;
    DI bool next(int i, Unit& u) const {
        const int L = i * G + c; int pm, pn;
        if (L < nmain) pg8::tile_order(L, nM, 21, pm, pn); else if (L < nmain + nextra) { pm = 64 + (L - nmain); pn = 2; } else return false;
        u.a = A + (size_t)pm * 256 * 2048; u.b = B + (size_t)pn * 256 * 2048; u.i0 = pm; u.i1 = pn; u.i2 = 0; u.ui = i; return true;
    }
    DI void voff(const Unit&, int R0, int C0, int R1, int C1, unsigned (&vo)[2][2]) const { voff_contig(R0, C0, R1, C1, vo); }
};
struct SchedMerge : SchedBase {
    const char* A; const char* B; int nM;
    DI bool next(int i, Unit& u) const {
        const int ti = (i / 3) * G + c, br = i % 3; if (ti >= nM * 4) return false;
        int pm, pn; pg8::tile_order(ti, nM, 4, pm, pn);
        u.a = A + ((size_t)pm * 256 * 1536 + br * 512) * 2; u.b = B + ((size_t)pn * 256 * 1536 + br * 512) * 2; u.i0 = pm; u.i1 = pn; u.i2 = br; u.ui = i; return true;
    }
    DI void voff(const Unit&, int R0, int C0, int R1, int C1, unsigned (&vo)[2][2]) const { voff_contig(R0, C0, R1, C1, vo); }
};
struct SchedOut : SchedBase {
    const char* A; const char* B; int nM;
    DI bool next(int i, Unit& u) const {
        const int L = i * G + c; if (L >= nM * 4) return false;
        int pm, pn; pg8::tile_order(L, nM, 4, pm, pn);
        u.a = A + (size_t)pm * 256 * 2048; u.b = B + (size_t)pn * 256 * 2048; u.i0 = pm; u.i1 = pn; u.i2 = 0; u.ui = i; return true;
    }
    DI void voff(const Unit&, int R0, int C0, int R1, int C1, unsigned (&vo)[2][2]) const { voff_contig(R0, C0, R1, C1, vo); }
};
struct SchedGU : SchedBase {
    const char* A; const char* B; int nmt, ibase; const LAS int* idx;
    DI bool next(int i, Unit& u) const {
        if (i >= 8) return false;
        const int L = (ibase + i) * G + c; if (L >= NE * nmt * 8) return false;
        const int n8 = L % 8, mt = (L / 8) % nmt, e = L / (8 * nmt);
        u.a = A; u.b = B + ((size_t)e * 2048 + n8 * 256) * 2048; u.i0 = e; u.i1 = mt; u.i2 = n8; u.ui = i; return true;
    }
    DI void voff(const Unit& u, int R0, int C0, int R1, int C1, unsigned (&vo)[2][2]) const {
#pragma unroll
        for (int h = 0; h < 2; ++h) { vo[h][0] = (unsigned)(idx[u.ui * 256 + h * 128 + R0] * 2048 + C0 * 2); vo[h][1] = (unsigned)(idx[u.ui * 256 + h * 128 + R1] * 2048 + C1 * 2); }
    }
};
struct SchedDown : SchedBase {
    const char* A; const char* B; int nmt;
    DI bool next(int i, Unit& u) const {
        const int L = i * G + c; if (L >= NE * nmt * 4) return false;
        const int n4 = L % 4, mt = (L / 4) % nmt, e = L / (4 * nmt);
        u.a = A + ((size_t)e * ESLOT + mt * 256) * 2048; u.b = B + ((size_t)e * 1024 + n4 * 256) * 2048; u.i0 = e; u.i1 = mt; u.i2 = n4; u.ui = i; return true;
    }
    DI void voff(const Unit&, int R0, int C0, int R1, int C1, unsigned (&vo)[2][2]) const { voff_contig(R0, C0, R1, C1, vo); }
};

DI void st_bf4(bf16_t* p, f32x4 v) { u32x2 w; w.x = pk_bf16(v[0], v[1]); w.y = pk_bf16(v[2], v[3]); *(u32x2*)p = w; }
DI f32x4 sig4(f32x4 v) { return (f32x4){sigm(v[0]), sigm(v[1]), sigm(v[2]), sigm(v[3])}; }

struct EpiInProj {
    bf16_t *Q, *K, *VT, *U, *Z, *G; const float* rope;
    DI void operator()(const Acc& acc, const Unit& u, int wr, int wc, int fr, int fq) const {
        const int pm = u.i0, pn = u.i1;
#pragma unroll
        for (int bj = 0; bj < 2; ++bj) {
            const int gc = 256 * pn + 128 * bj + 32 * wc;
#pragma unroll
            for (int ai = 0; ai < 2; ++ai)
#pragma unroll
                for (int m = 0; m < 4; ++m) {
                    const int t = 256 * pm + 128 * ai + 64 * wr + 16 * m + fr;
                    const f32x4 v0 = acc[ai][bj][m][0], v1 = acc[ai][bj][m][1];
                    if (gc < 640) {
                        f32x4 o0 = v0, o1 = v1;
                        if (t < TL) {
                            const int s = t & (SEQ - 1); const int p = ((gc >> 5) & 1) ? (s & 63) : (s >> 6);
                            const f32x4 cs = *(const f32x4*)(rope + p * 16 + 4 * fq), sn = *(const f32x4*)(rope + 1024 + p * 16 + 4 * fq);
                            o0 = v0 * cs - v1 * sn; o1 = v1 * cs + v0 * sn;
                        }
                        bf16_t* dst;
                        if (gc < 512) { o0 = o0 * QSC; o1 = o1 * QSC; dst = Q + (size_t)t * 512 + gc + 4 * fq; } else dst = K + (size_t)t * 128 + (gc - 512) + 4 * fq;
                        st_bf4(dst, o0); st_bf4(dst + 16, o1);
                    } else if (gc < 768) {
                        const int c0 = gc - 640 + 4 * fq;
#pragma unroll
                        for (int j = 0; j < 4; ++j) { VT[(size_t)(c0 + j) * TT + t] = f2bf(v0[j]); VT[(size_t)(c0 + 16 + j) * TT + t] = f2bf(v1[j]); }
                    } else if (gc < 1792) {
                        const int ch = ((gc - 768) >> 1) + 4 * fq;
                        st_bf4(U + (size_t)t * 512 + ch, v0 * sig4(v1));
                    } else if (gc < 2304) {
                        bf16_t* dst = Z + (size_t)t * 512 + (gc - 1792) + 4 * fq; st_bf4(dst, v0); st_bf4(dst + 16, v1);
                    } else {
                        bf16_t* dst = G + (size_t)t * 3072 + (gc - 2304) + 4 * fq; st_bf4(dst, sig4(v0)); st_bf4(dst + 16, sig4(v1));
                    }
                }
        }
    }
};
struct EpiMerge {
    const bf16_t* G; bf16_t* M;
    DI void operator()(const Acc& acc, const Unit& u, int wr, int wc, int fr, int fq) const {
        const int pm = u.i0, pn = u.i1, br = u.i2;
#pragma unroll
        for (int ai = 0; ai < 2; ++ai)
#pragma unroll
            for (int m = 0; m < 4; ++m) {
                const int t = 256 * pm + 128 * ai + 64 * wr + 16 * m + fr;
#pragma unroll
                for (int bj = 0; bj < 2; ++bj)
#pragma unroll
                    for (int n = 0; n < 2; ++n) {
                        const int cc = 256 * pn + 128 * bj + 32 * wc + 16 * n + 4 * fq;
                        const u32x2 gw = *(const u32x2*)(G + (size_t)t * 3072 + br * 1024 + cc);
                        f32x4 v = acc[ai][bj][m][n] * (f32x4){bf_lo(gw.x), bf_hi(gw.x), bf_lo(gw.y), bf_hi(gw.y)};
                        bf16_t* mp = M + (size_t)t * 1024 + cc;
                        if (br > 0) { const unsigned long long pw = __hip_atomic_load((const unsigned long long*)mp, __ATOMIC_RELAXED, __HIP_MEMORY_SCOPE_AGENT);
                            const unsigned plo = (unsigned)pw, phi = (unsigned)(pw >> 32); v = v + (f32x4){bf_lo(plo), bf_hi(plo), bf_lo(phi), bf_hi(phi)}; }
                        st_bf4(mp, v);
                    }
            }
    }
};
struct EpiOut {
    const float* xin; const float* ctxin; float* X; const float* mod; int layer;
    DI void operator()(const Acc& acc, const Unit& u, int wr, int wc, int fr, int fq) const {
        const int pm = u.i0, pn = u.i1; const int row0 = 256 * pm;
        const int mr = row0 < TL ? (row0 >> 12) : 4;
        const float* src = layer == 0 ? (row0 < TL ? xin : ctxin - (size_t)TL * DM) : X;
        const float* g1 = mod + (size_t)(layer * 5 + mr) * 6144 + 2048;
#pragma unroll
        for (int bj = 0; bj < 2; ++bj)
#pragma unroll
            for (int n = 0; n < 2; ++n) {
                const int cc = 256 * pn + 128 * bj + 32 * wc + 16 * n + 4 * fq;
                const f32x4 gv = *(const f32x4*)(g1 + cc);
#pragma unroll
                for (int ai = 0; ai < 2; ++ai)
#pragma unroll
                    for (int m = 0; m < 4; ++m) {
                        const int t = row0 + 128 * ai + 64 * wr + 16 * m + fr;
                        const f32x4 xs = *(const f32x4*)(src + (size_t)t * DM + cc);
                        *(f32x4*)(X + (size_t)t * DM + cc) = xs + gv * acc[ai][bj][m][n];
                    }
            }
    }
};
struct EpiGU {
    bf16_t* ACT;
    DI void operator()(const Acc& acc, const Unit& u, int wr, int wc, int fr, int fq) const {
        const int e = u.i0, mt = u.i1, n8 = u.i2;
#pragma unroll
        for (int ai = 0; ai < 2; ++ai)
#pragma unroll
            for (int m = 0; m < 4; ++m) {
                const size_t slot = (size_t)e * ESLOT + mt * 256 + 128 * ai + 64 * wr + 16 * m + fr;
#pragma unroll
                for (int bj = 0; bj < 2; ++bj) {
                    const int col = ((256 * n8 + 128 * bj + 32 * wc) >> 1) + 4 * fq;
                    const f32x4 gt = acc[ai][bj][m][0], up = acc[ai][bj][m][1];
                    st_bf4(ACT + slot * 1024 + col, gt * sig4(gt) * up);
                }
            }
    }
};
struct EpiDown {
    bf16_t* Y;
    DI void operator()(const Acc& acc, const Unit& u, int wr, int wc, int fr, int fq) const {
        const int e = u.i0, mt = u.i1, n4 = u.i2;
#pragma unroll
        for (int ai = 0; ai < 2; ++ai)
#pragma unroll
            for (int m = 0; m < 4; ++m) {
                const size_t slot = (size_t)e * ESLOT + mt * 256 + 128 * ai + 64 * wr + 16 * m + fr;
#pragma unroll
                for (int bj = 0; bj < 2; ++bj)
#pragma unroll
                    for (int n = 0; n < 2; ++n) st_bf4(Y + slot * 1024 + 256 * n4 + 128 * bj + 32 * wc + 16 * n + 4 * fq, acc[ai][bj][m][n]);
            }
    }
};

DI int maprow(int mode, int n) {
    if (mode == 1) {
        if (n >= 768 && n < 1280) { const int ch = n - 768; return 768 + 32 * (ch >> 4) + (ch & 15); }
        if (n >= 1280 && n < 1792) { const int ch = n - 1280; return 768 + 32 * (ch >> 4) + 16 + (ch & 15); }
        return n;
    }
    if (mode == 2) return 32 * (n >> 4) + (n & 15);
    if (mode == 3) return 32 * (n >> 4) + 16 + (n & 15);
    return n;
}
DI void transpose_item(const float* W, int N, bf16_t* WT, int dpitch, int dcol0, int mode, LAS float* scr, int item, int lane) {
    const int nblk = N / 32, kb = item / nblk, nb = item % nblk, k0 = 64 * kb, n0 = 32 * nb;
#pragma unroll 8
    for (int i = 0; i < 32; ++i) { const int kk = 2 * i + (lane >> 5); scr[kk * 33 + (lane & 31)] = W[(size_t)(k0 + kk) * N + n0 + (lane & 31)]; }
    LDS_WAIT(); asm volatile("" ::: "memory");
    const int c = lane & 7;
#pragma unroll
    for (int j = 0; j < 4; ++j) { const int n = (lane >> 3) + 8 * j; const LAS float* s = scr + (8 * c) * 33 + n;
        u32x4 o; o.x = pk_bf16(s[0 * 33], s[1 * 33]); o.y = pk_bf16(s[2 * 33], s[3 * 33]); o.z = pk_bf16(s[4 * 33], s[5 * 33]); o.w = pk_bf16(s[6 * 33], s[7 * 33]);
        *(u32x4*)(WT + (size_t)maprow(mode, n0 + n) * dpitch + dcol0 + k0 + 8 * c) = o; }
    LDS_WAIT(); asm volatile("" ::: "memory");
}
DI void convert_small(const Args& a, LAS float* scr, int gw, int NGW, int lane) {
    unsigned char* ws = a.ws;
    constexpr int I_A = 16 * 168, I_B = 8 * 32, I_C = 8 * 32, I_D = 16 * 32, PER = I_A + I_B + I_C + I_D;
    for (int it = gw; it < 2 * PER; it += NGW) {
        const int l = it / PER; int r = it % PER;
        if (r < I_A) { transpose_item(a.in[I_WIN] + (size_t)l * 1024 * INW, INW, (bf16_t*)(ws + WS_WIN) + (size_t)l * INW * 1024, 1024, 0, 1, scr, r, lane); continue; } r -= I_A;
        if (r < I_B) { transpose_item(a.in[I_WAO] + (size_t)l * 512 * 1024, 1024, (bf16_t*)(ws + WS_WMERGE) + (size_t)l * 1024 * 1536, 1536, 0, 0, scr, r, lane); continue; } r -= I_B;
        if (r < I_C) { transpose_item(a.in[I_WCO] + (size_t)l * 512 * 1024, 1024, (bf16_t*)(ws + WS_WMERGE) + (size_t)l * 1024 * 1536, 1536, 512, 0, scr, r, lane); continue; } r -= I_C;
        transpose_item(a.in[I_WOUT] + (size_t)l * 1024 * 1024, 1024, (bf16_t*)(ws + WS_WOUT) + (size_t)l * 1024 * 1024, 1024, 0, 0, scr, r, lane);
    }
}
DI void convert_experts(const Args& a, int l, LAS float* scr, int gw, int NGW, int lane) {
    unsigned char* ws = a.ws;
    for (int it = gw; it < NE * 1536; it += NGW) {
        const int e = it / 1536; int r = it % 1536; const size_t wo = ((size_t)l * NE + e) * 1024 * 1024;
        if (r < 512) { transpose_item(a.in[I_WEG] + wo, 1024, (bf16_t*)(ws + WS_WGU) + (size_t)e * 2048 * 1024, 1024, 0, 2, scr, r, lane); continue; } r -= 512;
        if (r < 512) { transpose_item(a.in[I_WEU] + wo, 1024, (bf16_t*)(ws + WS_WGU) + (size_t)e * 2048 * 1024, 1024, 0, 3, scr, r, lane); continue; } r -= 512;
        transpose_item(a.in[I_WED] + wo, 1024, (bf16_t*)(ws + WS_WDN) + (size_t)e * 1024 * 1024, 1024, 0, 0, scr, r, lane);
    }
}
DI void mod_item(const Args& a, LAS unsigned char* lds, int item) {
    const int tid = threadIdx.x, l = item / 96, cb = item % 96;
    LAS float* sc = (LAS float*)lds; LAS float* red = (LAS float*)(lds + 20480);
    for (int idx = tid; idx < 5120; idx += 512) { const int r = idx >> 10, k = idx & 1023; const float v = r < 4 ? a.in[I_C][r * 1024 + k] : a.in[I_CCTX][k]; sc[idx] = v / (1.f + expf(-v)); }
    __syncthreads();
    const int col = tid & 63, kg = tid >> 6; const float* w = a.in[I_WMOD] + (size_t)l * 1024 * 6144 + cb * 64 + col;
    float acc[5] = {0.f, 0.f, 0.f, 0.f, 0.f};
#pragma unroll 8
    for (int k = kg * 128; k < kg * 128 + 128; ++k) { const float wv = w[(size_t)k * 6144];
#pragma unroll
        for (int r = 0; r < 5; ++r) acc[r] += sc[r * 1024 + k] * wv; }
#pragma unroll
    for (int r = 0; r < 5; ++r) red[(kg * 5 + r) * 64 + col] = acc[r];
    __syncthreads();
    if (tid < 320) { const int r = tid >> 6; float s = a.in[I_BMOD][l * 6144 + cb * 64 + col];
#pragma unroll
        for (int g = 0; g < 8; ++g) s += red[(g * 5 + r) * 64 + col];
        ((float*)(a.ws + WS_MOD))[(size_t)(l * 5 + r) * 6144 + cb * 64 + col] = s; }
    __syncthreads();
}
DI void rope_item(const Args& a) {
    float* rp = (float*)(a.ws + WS_ROPE);
    for (int idx = threadIdx.x; idx < 1024; idx += 512) { const int p = idx >> 4, i = idx & 15; const float fr = powf(10000.f, -(float)i / 16.f); const float ang = (float)p * fr; rp[idx] = cosf(ang); rp[1024 + idx] = sinf(ang); }
}
DI void fold_item(const Args& a, LAS unsigned char* lds, int item) {
    const int tid = threadIdx.x; const int nh = item & 1, kb = (item >> 1) & 15, gi = (item >> 5) & 3, l = item >> 7;
    LAS float* wp = (LAS float*)lds; LAS float* psv = (LAS float*)(lds + 4096);
    for (int idx = tid; idx < 1024; idx += 512) wp[idx] = a.in[I_WPOOL][(((size_t)l * 4 + gi) * 128 + kb * 8 + (idx >> 7)) * 128 + (idx & 127)];
    if (tid < 128) psv[tid] = a.in[I_PSCALE][l * 512 + gi * 128 + tid];
    __syncthreads();
    const int n = nh * 512 + tid; const float* wo = a.in[I_WPO] + ((size_t)l * 512 + gi * 128) * 1024 + n;
    float acc[8] = {0.f, 0.f, 0.f, 0.f, 0.f, 0.f, 0.f, 0.f};
#pragma unroll 4
    for (int j = 0; j < 128; ++j) { const float v = wo[(size_t)j * 1024] * psv[j];
#pragma unroll
        for (int kk = 0; kk < 8; ++kk) acc[kk] += wp[kk * 128 + j] * v; }
    u32x4 o; o.x = pk_bf16(acc[0], acc[1]); o.y = pk_bf16(acc[2], acc[3]); o.z = pk_bf16(acc[4], acc[5]); o.w = pk_bf16(acc[6], acc[7]);
    *(u32x4*)((bf16_t*)(a.ws + WS_WMERGE) + ((size_t)l * 1024 + n) * 1536 + 1024 + gi * 128 + kb * 8) = o;
    __syncthreads();
}
DI void phase_prep(const Args& a, LAS unsigned char* lds, int G, int c) {
    constexpr int NBI = 192 + 1 + 256;
    for (int it = c; it < NBI; it += G) { if (it < 192) mod_item(a, lds, it); else if (it == 192) rope_item(a); else fold_item(a, lds, it - 193); }
    __syncthreads();
    const int wid = __builtin_amdgcn_readfirstlane(threadIdx.x >> 6), lane = threadIdx.x & 63;
    LAS float* scr = (LAS float*)(lds + wid * 16384);
    convert_small(a, scr, c * 8 + wid, G * 8, lane);
    convert_experts(a, 0, scr, c * 8 + wid, G * 8, lane);
}

template <int MODE> DI void norm_phase(const Args& a, int l, LAS unsigned char* lds, int G, int c) {
    const int tid = threadIdx.x, wid = __builtin_amdgcn_readfirstlane(tid >> 6), lane = tid & 63;
    unsigned char* ws = a.ws;
    float* X = (float*)(ws + WS_X); bf16_t* H = (bf16_t*)(ws + WS_H); const float* MOD = (const float*)(ws + WS_MOD);
    float* AFF = (float*)(ws + WS_AFF); const int* SLOTOF = (const int*)(ws + WS_SLOTOF); const bf16_t* Y = (const bf16_t*)(ws + WS_Y);
    LAS float* wr_l = (LAS float*)lds;
    constexpr int WRP = 1028;
    if (MODE == 2) { for (int idx = tid; idx < 16384; idx += 512) wr_l[(idx & 15) * WRP + (idx >> 4)] = a.in[I_WR][(size_t)l * 16384 + idx]; __syncthreads(); }
    const int nrows = (MODE == 3) ? TL : TT; const int rpb = (nrows + G - 1) / G; const int r0 = c * rpb; const int r1 = (r0 + rpb) < nrows ? (r0 + rpb) : nrows;
    for (int row = r0 + wid; row < r1; row += 8) {
        const int mr = row < TL ? (row >> 12) : 4;
        const float* src = (MODE == 0) ? (row < TL ? a.in[I_X] + (size_t)row * DM : a.in[I_CTX] + (size_t)(row - TL) * DM) : X + (size_t)row * DM;
        f32x4 v[4];
#pragma unroll
        for (int j = 0; j < 4; ++j) v[j] = *(const f32x4*)(src + 256 * j + 4 * lane);
        if (MODE == 1 || MODE == 3) {
            const int lp = (MODE == 1) ? 0 : 1;
            const int so = lane < 16 ? SLOTOF[(size_t)row * 16 + lane] : -1; const float af = lane < 16 ? AFF[(size_t)row * 16 + lane] : 0.f;
            f32x4 cacc[4];
#pragma unroll
            for (int j = 0; j < 4; ++j) cacc[j] = (f32x4){0.f, 0.f, 0.f, 0.f};
#pragma unroll
            for (int e = 0; e < 16; ++e) {
                const int s = __builtin_amdgcn_readlane(so, e);
                if (s >= 0) { const float w = __uint_as_float(__builtin_amdgcn_readlane(__float_as_uint(af), e)); const bf16_t* yr = Y + (size_t)s * 1024 + 4 * lane;
#pragma unroll
                    for (int j = 0; j < 4; ++j) { const u32x2 yw = *(const u32x2*)(yr + 256 * j); cacc[j] = cacc[j] + w * (f32x4){bf_lo(yw.x), bf_hi(yw.x), bf_lo(yw.y), bf_hi(yw.y)}; } }
            }
            const float* g2 = MOD + (size_t)(lp * 5 + mr) * 6144 + 5120;
#pragma unroll
            for (int j = 0; j < 4; ++j) v[j] = v[j] + *(const f32x4*)(g2 + 256 * j + 4 * lane) * cacc[j];
            if (MODE == 1) {
#pragma unroll
                for (int j = 0; j < 4; ++j) *(f32x4*)(X + (size_t)row * DM + 256 * j + 4 * lane) = v[j];
            }
        }
        float ss = 0.f;
#pragma unroll
        for (int j = 0; j < 4; ++j) ss += (v[j].x * v[j].x + v[j].y * v[j].y) + (v[j].z * v[j].z + v[j].w * v[j].w);
        const float rms = 1.0f / sqrtf(wave_sum(ss) * (1.f / DM) + 1e-6f);
        if (MODE == 3) {
#pragma unroll
            for (int j = 0; j < 4; ++j) *(f32x4*)(a.out + (size_t)row * DM + 256 * j + 4 * lane) = v[j] * rms * *(const f32x4*)(a.in[I_FNG] + 256 * j + 4 * lane);
        } else {
            const float* gv = (MODE == 2 ? a.in[I_N2G] : a.in[I_N1G]) + (size_t)l * DM;
            const float* mb = MOD + (size_t)(l * 5 + mr) * 6144 + (MODE == 2 ? 3072 : 0);
            f32x4 h[4];
#pragma unroll
            for (int j = 0; j < 4; ++j) { const int k = 256 * j + 4 * lane;
                h[j] = (v[j] * rms * *(const f32x4*)(gv + k)) * (1.f + *(const f32x4*)(mb + 1024 + k)) + *(const f32x4*)(mb + k);
                st_bf4(H + (size_t)row * DM + k, h[j]); }
            if (MODE == 2) {
                float lg[16];
#pragma unroll
                for (int e = 0; e < 16; ++e) { float s = 0.f; if ((e & 3) == 0) asm volatile("" ::: "memory");
#pragma unroll
                    for (int j = 0; j < 4; ++j) { const f32x4 w4 = *(const LAS f32x4*)(wr_l + e * WRP + 256 * j + 4 * lane); s += (h[j].x * w4.x + h[j].y * w4.y) + (h[j].z * w4.z + h[j].w * w4.w); }
                    lg[e] = s; }
#pragma unroll
                for (int e = 0; e < 16; ++e) lg[e] = wave_sum(lg[e]);
                float mx = lg[0];
#pragma unroll
                for (int e = 1; e < 16; ++e) mx = fmaxf(mx, lg[e]);
                float sum = 0.f;
#pragma unroll
                for (int e = 0; e < 16; ++e) { lg[e] = expf(lg[e] - mx); sum += lg[e]; }
                const float inv = 1.f / sum;
                if (lane == 0) {
#pragma unroll
                    for (int q = 0; q < 4; ++q) *(f32x4*)(AFF + (size_t)row * 16 + 4 * q) = (f32x4){lg[4 * q] * inv, lg[4 * q + 1] * inv, lg[4 * q + 2] * inv, lg[4 * q + 3] * inv};
                }
            }
        }
    }
    __syncthreads();
}

constexpr int KPITCH = 144, VPITCH = 272;
constexpr int ATT_K = 0, ATT_V = 128 * KPITCH, ATT_WS = ATT_V + 64 * VPITCH;

DI void attn_unit(const Args& a, int l, LAS unsigned char* lds, int kind, int b, int qb, int kh, int hh) {
    const int tid = threadIdx.x, lane = tid & 63, r32 = lane & 31, hi = lane >> 5; const int wid = __builtin_amdgcn_readfirstlane(tid >> 6);
    unsigned char* ws = a.ws;
    const bf16_t* Q = (const bf16_t*)(ws + WS_Q); const bf16_t* Kb = (const bf16_t*)(ws + WS_K); const bf16_t* VT = (const bf16_t*)(ws + WS_VT); bf16_t* BR = (bf16_t*)(ws + WS_BR);
    const int tq0 = kind == 0 ? b * SEQ + qb * 128 : TL + b * CTXL + qb * 128;
    const int ctx0 = TL + b * CTXL;
    const int h = kh * 4 + hh * 2 + (wid >> 2), qs = (wid & 3) * 32;
    const int qi = qs + r32;
    LAS float* wsf = (LAS float*)(lds + ATT_WS) + wid * 64;
    bf16x8 qf[4];
#pragma unroll
    for (int s = 0; s < 4; ++s) qf[s] = *(const bf16x8*)(Q + (size_t)(tq0 + qi) * 512 + h * 64 + s * 16 + hi * 8);
    float mrun = -1e30f, lrun = 0.f;
    f32x16 o[2];
#pragma unroll
    for (int d0 = 0; d0 < 2; ++d0)
#pragma unroll
        for (int r = 0; r < 16; ++r) o[d0][r] = 0.f;
    const int nseg = kind == 0 ? 5 : 2;
    for (int sg = 0; sg < nseg; ++sg) {
        int tok0; int lo_lim = -100000, hi_lim = 100000; bool valid = true;
        if (kind == 0) {
            if (sg == 0) tok0 = tq0;
            else if (sg == 1) { tok0 = tq0 - 128; lo_lim = qi; valid = qb > 0; }
            else if (sg == 2) { tok0 = tq0 + 128; hi_lim = qi; valid = qb < 31; }
            else tok0 = ctx0 + (sg - 3) * 128;
        } else tok0 = ctx0 + sg * 128;
        if (!valid) continue;
        asm volatile("" : "+v"(lo_lim), "+v"(hi_lim));
        __syncthreads();
#pragma unroll
        for (int i = 0; i < 2; ++i) { const int idx = tid + 512 * i; const int row = idx >> 3, ch = idx & 7;
            const u32x4 kv = *(const u32x4*)(Kb + (size_t)(tok0 + row) * 128 + kh * 64 + ch * 8); *(LAS u32x4*)(lds + ATT_K + row * KPITCH + ch * 16) = kv; }
#pragma unroll
        for (int i = 0; i < 2; ++i) { const int idx = tid + 512 * i; const int row = idx >> 4, ch = idx & 15;
            const u32x4 vv = *(const u32x4*)(VT + (size_t)(kh * 64 + row) * TT + tok0 + ch * 8); *(LAS u32x4*)(lds + ATT_V + row * VPITCH + ch * 16) = vv; }
        __syncthreads();
#pragma unroll 1
        for (int tk = 0; tk < 2; ++tk) {
            f32x16 s0, s1;
#pragma unroll
            for (int r = 0; r < 16; ++r) { s0[r] = 0.f; s1[r] = 0.f; }
            const LAS unsigned char* kp = lds + ATT_K + (tk * 64 + r32) * KPITCH + hi * 16;
#pragma unroll
            for (int s = 0; s < 4; ++s) {
                const bf16x8 k0 = *(const LAS bf16x8*)(kp + s * 32);
                const bf16x8 k1 = *(const LAS bf16x8*)(kp + 32 * KPITCH + s * 32);
                s0 = __builtin_amdgcn_mfma_f32_32x32x16_bf16(k0, qf[s], s0, 0, 0, 0);
                s1 = __builtin_amdgcn_mfma_f32_32x32x16_bf16(k1, qf[s], s1, 0, 0, 0);
            }
            const int kb0 = tk * 64 + 4 * hi;
#pragma unroll
            for (int r = 0; r < 16; ++r) { const int kj = kb0 + (r & 3) + 8 * (r >> 2);
                if (kj < lo_lim || kj > hi_lim) s0[r] = -1e30f;
                if (kj + 32 < lo_lim || kj + 32 > hi_lim) s1[r] = -1e30f; }
            float tm = fmaxf(s0[0], s1[0]);
#pragma unroll
            for (int r = 1; r < 16; ++r) tm = fmaxf(tm, fmaxf(s0[r], s1[r]));
            tm = fmaxf(tm, __shfl_xor(tm, 32));
            const float mnew = fmaxf(mrun, tm); const float alpha = __builtin_amdgcn_exp2f(mrun - mnew); mrun = mnew;
            float ls = 0.f;
#pragma unroll
            for (int r = 0; r < 16; ++r) { s0[r] = __builtin_amdgcn_exp2f(s0[r] - mnew); s1[r] = __builtin_amdgcn_exp2f(s1[r] - mnew); ls += s0[r] + s1[r]; }
            lrun = lrun * alpha + ls;
            if (hi == 0) wsf[r32] = alpha;
#pragma unroll
            for (int r = 0; r < 16; ++r) { const float f = wsf[crow(r, hi)]; o[0][r] *= f; o[1][r] *= f; }
            const LAS unsigned char* vp0 = lds + ATT_V + r32 * VPITCH + (tk * 64 + 4 * hi) * 2;
#pragma unroll
            for (int cc = 0; cc < 2; ++cc)
#pragma unroll
                for (int s = 0; s < 2; ++s) {
                    u32x4 pw;
                    if (cc == 0) { pw.x = pk_bf16(s0[8 * s], s0[8 * s + 1]); pw.y = pk_bf16(s0[8 * s + 2], s0[8 * s + 3]); pw.z = pk_bf16(s0[8 * s + 4], s0[8 * s + 5]); pw.w = pk_bf16(s0[8 * s + 6], s0[8 * s + 7]); }
                    else { pw.x = pk_bf16(s1[8 * s], s1[8 * s + 1]); pw.y = pk_bf16(s1[8 * s + 2], s1[8 * s + 3]); pw.z = pk_bf16(s1[8 * s + 4], s1[8 * s + 5]); pw.w = pk_bf16(s1[8 * s + 6], s1[8 * s + 7]); }
                    const bf16x8 pa = __builtin_bit_cast(bf16x8, pw);
#pragma unroll
                    for (int d0 = 0; d0 < 2; ++d0) {
                        const LAS unsigned char* vp = vp0 + d0 * 32 * VPITCH + (cc * 32 + s * 16) * 2;
                        const s16x4 lo = *(const LAS s16x4*)vp, hh2 = *(const LAS s16x4*)(vp + 16);
                        const bf16x8 vb = (bf16x8){lo[0], lo[1], lo[2], lo[3], hh2[0], hh2[1], hh2[2], hh2[3]};
                        o[d0] = __builtin_amdgcn_mfma_f32_32x32x16_bf16(pa, vb, o[d0], 0, 0, 0);
                    }
                }
        }
    }
    const float sk = a.in[I_SINK][l * 8 + h] * LOG2E;
    {
        const float lt = lrun + __shfl_xor(lrun, 32) + __builtin_amdgcn_exp2f(sk - mrun);
        if (hi == 0) wsf[r32] = 1.f / lt;
#pragma unroll
        for (int r = 0; r < 16; ++r) { const float f = wsf[crow(r, hi)]; bf16_t* op = BR + (size_t)(tq0 + qs + crow(r, hi)) * 1536 + h * 64 + r32;
            op[0] = f2bf(o[0][r] * f); op[32] = f2bf(o[1][r] * f); }
    }
    __syncthreads();
}

DI void seq_bounds(int t0, int& lo, int& hi) { if (t0 < TL) { lo = t0 & ~(SEQ - 1); hi = lo + SEQ; } else { lo = TL + ((t0 - TL) & ~(CTXL - 1)); hi = lo + CTXL; } }

DI void conv_unit(const Args& a, int l, LAS unsigned char* lds, int t0) {
    const int tid = threadIdx.x, lane = tid & 63; const int wid = __builtin_amdgcn_readfirstlane(tid >> 6);
    const bf16_t* U = (const bf16_t*)(a.ws + WS_U); bf16_t* BR = (bf16_t*)(a.ws + WS_BR);
    int slo, shi; seq_bounds(t0, slo, shi);
    for (int idx = tid; idx < 62 * 64; idx += 512) { const int row = idx >> 6, ch = idx & 63; const int tok = t0 - 15 + row; u32x4 v = (u32x4){0u, 0u, 0u, 0u};
        if (tok >= slo && tok < shi) v = *(const u32x4*)(U + (size_t)tok * 512 + ch * 8); *(LAS u32x4*)(lds + row * 1024 + ch * 16) = v; }
    __syncthreads();
    const int c = tid; float w[31];
#pragma unroll
    for (int k = 0; k < 31; ++k) w[k] = a.in[I_CDW][((size_t)l * 31 + k) * 512 + c];
    const float bias = a.in[I_CDWB][l * 512 + c];
    float xin[62];
#pragma unroll
    for (int i = 0; i < 62; ++i) xin[i] = bf2f(((const LAS bf16_t*)lds)[i * 512 + c]);
    LAS float* cs = (LAS float*)(lds + 65536);
#pragma unroll
    for (int t = 0; t < 32; ++t) { float acc = bias;
#pragma unroll
        for (int k = 0; k < 31; ++k) acc = fmaf(xin[t + k], w[k], acc);
        cs[t * 512 + c] = acc; }
    __syncthreads();
    const float* lg = a.in[I_CLNG] + l * 512; const float* lb = a.in[I_CLNB] + l * 512;
#pragma unroll
    for (int tt = 0; tt < 4; ++tt) { const int t = 4 * wid + tt; float v[8]; float s = 0.f;
#pragma unroll
        for (int i = 0; i < 8; ++i) { v[i] = cs[t * 512 + lane + 64 * i]; s += v[i]; }
        const float mean = wave_sum(s) * (1.f / 512.f); float q = 0.f;
#pragma unroll
        for (int i = 0; i < 8; ++i) { v[i] -= mean; q += v[i] * v[i]; }
        const float rstd = 1.0f / sqrtf(wave_sum(q) * (1.f / 512.f) + 1e-6f);
#pragma unroll
        for (int i = 0; i < 8; ++i) { const int c2 = lane + 64 * i; const float y = v[i] * rstd * lg[c2] + lb[c2]; BR[(size_t)(t0 + t) * 1536 + 512 + c2] = f2bf(y * sigm(y)); } }
    __syncthreads();
}
DI void pool_unit(const Args& a, LAS unsigned char* lds, int t0) {
    const int tid = threadIdx.x;
    const bf16_t* Z = (const bf16_t*)(a.ws + WS_Z); bf16_t* BR = (bf16_t*)(a.ws + WS_BR);
    int slo, shi; seq_bounds(t0, slo, shi);
    for (int idx = tid; idx < 48 * 64; idx += 512) { const int row = idx >> 6, ch = idx & 63; const int tok = t0 - 8 + row; u32x4 v = (u32x4){0u, 0u, 0u, 0u};
        if (tok >= slo && tok < shi) v = *(const u32x4*)(Z + (size_t)tok * 512 + ch * 8); *(LAS u32x4*)(lds + row * 1024 + ch * 16) = v; }
    __syncthreads();
    const int c = tid; const int half = 1 << (c >> 7); const LAS bf16_t* zs = (const LAS bf16_t*)lds;
    for (int t = 0; t < 32; ++t) { const int tt = t0 + t; const int lo = (tt - half) > slo ? (tt - half) : slo, hi = (tt + half) < shi ? (tt + half) : shi; float s = 0.f;
        for (int tok = lo; tok < hi; ++tok) s += bf2f(zs[(tok - t0 + 8) * 512 + c]);
        const float d = s / (float)(hi - lo) - bf2f(zs[(t + 8) * 512 + c]);
        BR[(size_t)tt * 1536 + 1024 + c] = f2bf(d); }
    __syncthreads();
}
DI void phase_mix(const Args& a, int l, LAS unsigned char* lds, int G, int c) {
    for (int u = c; u < 512; u += G) attn_unit(a, l, lds, 0, u >> 7, (u >> 2) & 31, (u >> 1) & 1, u & 1);
    const int nconv = l == 0 ? TT / 32 : TL / 32; const int nx = 2 * nconv + (l == 0 ? 32 : 0);
    for (int j = c; j < nx; j += G) {
        if (j < nconv) conv_unit(a, l, lds, j * 32);
        else if (j < 2 * nconv) pool_unit(a, lds, (j - nconv) * 32);
        else { const int x = j - 2 * nconv; attn_unit(a, l, lds, 1, x >> 3, (x >> 2) & 1, (x >> 1) & 1, x & 1); }
    }
}

DI void topk_unit(const Args& a, LAS unsigned char* lds, int set, int e) {
    const int tid = threadIdx.x; const bool lat = set < 4; const int b = set & 3;
    const int N = lat ? SEQ : CTXL, cap = N / 8, tok0 = lat ? b * SEQ : TL + b * CTXL, sbase = e * ESLOT + (lat ? b * 512 : 2048 + b * 32);
    const float* AFF = (const float*)(a.ws + WS_AFF); int* SLOTOF = (int*)(a.ws + WS_SLOTOF); int* TOKOF = (int*)(a.ws + WS_TOKOF);
    LAS unsigned long long* key = (LAS unsigned long long*)lds;
    for (int i = tid; i < N; i += 512) key[i] = ((unsigned long long)__float_as_uint(AFF[(size_t)(tok0 + i) * 16 + e]) << 32) | (unsigned long long)(0xFFFFFFFFu - (unsigned)i);
    __syncthreads();
    for (int k = 2; k <= N; k <<= 1)
        for (int j = k >> 1; j > 0; j >>= 1) {
            for (int i = tid; i < N / 2; i += 512) { const int lo = ((i & ~(j - 1)) << 1) | (i & (j - 1)), hi2 = lo | j; const bool up = (lo & k) == 0;
                const unsigned long long x = key[lo], y = key[hi2]; if ((x > y) == up) { key[lo] = y; key[hi2] = x; } }
            __syncthreads();
        }
    for (int p = tid; p < N; p += 512) { const unsigned long long kk = key[p]; const int i = (int)(0xFFFFFFFFu - (unsigned)kk); const int tok = tok0 + i;
        if (p >= N - cap) { const int slot = sbase + (N - 1 - p); SLOTOF[(size_t)tok * 16 + e] = slot; TOKOF[slot] = tok; } else SLOTOF[(size_t)tok * 16 + e] = -1; }
    if (set == 4 && tid < 128) TOKOF[e * ESLOT + 2176 + tid] = 0;
    __syncthreads();
}

#define XB_TMO      128
#define XB_XCNT(j)  (256  + 64 * (j))
#define XB_XSUB(j)  (1280 + 64 * (j))
#define XB_XGEN(j)  (2304 + 64 * (j))
#define XB_TOP      3328
#define XB_TOPGEN   3392
#define XCD_BAR_WORDS 3456
#define XB_SPIN_CAP (1u << 22)
DI unsigned xb_ld(unsigned* p) { return __hip_atomic_load(p, __ATOMIC_RELAXED, __HIP_MEMORY_SCOPE_AGENT); }
DI unsigned xb_add(unsigned* p, unsigned v) { return __hip_atomic_fetch_add(p, v, __ATOMIC_RELAXED, __HIP_MEMORY_SCOPE_AGENT); }
DI unsigned xb_xcc_id() { return (unsigned)__builtin_amdgcn_s_getreg((3 << 11) | 20) & 0xFu; }
#define XB_SPIN(cond, bar) do { unsigned _sp = 0; while (cond) { __builtin_amdgcn_s_sleep(1); \
    if ((++_sp & 255u) == 0u) { if (xb_ld(&(bar)[XB_TMO])) break; if (_sp > XB_SPIN_CAP) { atomicAdd(&(bar)[XB_TMO], 1u); break; } } } } while (0)
struct XcdBarrier { unsigned* bar; unsigned x; volatile LAS unsigned* st; };
DI XcdBarrier xcd_barrier_post(unsigned* bar, volatile LAS unsigned* st) {
    XcdBarrier b; b.bar = bar; b.x = xb_xcc_id(); b.st = st;
    if (threadIdx.x == 0) (void)xb_add(&bar[XB_XCNT(b.x)], 1u);
    return b;
}
DI void xcd_barrier_complete(unsigned* bar, unsigned x, unsigned& nloc, unsigned& nx) {
    const unsigned G = gridDim.x * gridDim.y * gridDim.z;
    unsigned sum, cnt, mine, sp = 0u;
    for (;;) {
        sum = 0u; cnt = 0u; mine = 0u;
#pragma unroll
        for (unsigned j = 0; j < 16; ++j) { const unsigned c = xb_ld(&bar[XB_XCNT(j)]); sum += c; cnt += (c > 0u) ? 1u : 0u; mine = (j == x) ? c : mine; }
        if (sum == G) break;
        __builtin_amdgcn_s_sleep(1);
        if ((++sp & 255u) == 0u) { if (xb_ld(&bar[XB_TMO])) break; if (sp > XB_SPIN_CAP) { atomicAdd(&bar[XB_TMO], 1u); break; } }
    }
    nloc = mine > 0u ? mine : 1u; nx = cnt > 0u ? cnt : 1u;
}
DI void xcd_barrier(const XcdBarrier& b) {
    asm volatile("s_waitcnt vmcnt(0)" ::: "memory");
    __syncthreads();
    if (threadIdx.x == 0) {
        unsigned* bar = b.bar;
        __builtin_amdgcn_s_waitcnt(0);
        unsigned nloc = b.st[0], nx = b.st[1];
        if (nloc == 0u) { xcd_barrier_complete(bar, b.x, nloc, nx); b.st[0] = nloc; b.st[1] = nx; }
        const unsigned old = xb_add(&bar[XB_XSUB(b.x)], 1u);
        const unsigned gen = old / nloc;
        if (old + 1u == (gen + 1u) * nloc) {
            __builtin_amdgcn_fence(__ATOMIC_RELEASE, "agent");
            asm volatile("s_waitcnt vmcnt(0)" ::: "memory");
            const unsigned og = xb_add(&bar[XB_TOP], 1u);
            const unsigned tg = og / nx;
            if (og + 1u == (tg + 1u) * nx) xb_add(&bar[XB_TOPGEN], 1u);
            else XB_SPIN(xb_ld(&bar[XB_TOPGEN]) == tg, bar);
            __builtin_amdgcn_fence(__ATOMIC_ACQUIRE, "agent");
            xb_add(&bar[XB_XGEN(b.x)], 1u);
            asm volatile("s_waitcnt vmcnt(0)" ::: "memory");
        } else {
            XB_SPIN(xb_ld(&bar[XB_XGEN(b.x)]) == gen, bar);
            __builtin_amdgcn_fence(__ATOMIC_ACQUIRE, "agent");
            asm volatile("s_waitcnt vmcnt(0)" ::: "memory");
        }
    }
    __syncthreads();
}

#if !MK_PER_PHASE
#define GRID_BAR() xcd_barrier(bar)
#else
#define GRID_BAR() do {} while (0)
#endif
#ifndef PROBE_DUP
#define PROBE_DUP 0
#endif
#define REPS(bit) (1 + ((PROBE_DUP >> (bit)) & 1))
#define REP(bit) for (int _r = 0; _r < REPS(bit); ++_r)
#define REPU(bit) _Pragma("unroll") for (int _r = 0; _r < REPS(bit); ++_r)
#define REPBAR() do { if (_r) GRID_BAR(); } while (0)
#define IN(k) (lo <= (k) && (k) < hi)
#define SEAM(k) do { if (lo < (k) && (k) < hi) GRID_BAR(); } while (0)

template <int L> DI void run_layer(const Args& a, LAS unsigned char* lds, int G, int c, int lo, int hi, const XcdBarrier& bar) {
    unsigned char* ws = a.ws;
    constexpr int l = L, base = 1 + 9 * L, nM = L == 0 ? 68 : 64, nmt = L == 0 ? 9 : 8;
    const int tid = threadIdx.x;
    SEAM(base + 0);
    if (IN(base + 0)) { if (L == 0) { REP(0) { REPBAR(); norm_phase<0>(a, 0, lds, G, c); } } else norm_phase<1>(a, 1, lds, G, c); }
    SEAM(base + 1);
    if (IN(base + 1)) REPU(1) { REPBAR();
        SchedInProj S; S.nt = 16; S.ldb_b = 2048; S.lda_b = 2048; S.G = G; S.c = c; S.A = (const char*)(ws + WS_H); S.B = (const char*)(ws + WS_WIN) + (size_t)l * INW * 2048;
        S.nM = nM; S.nmain = nM * 21; S.nextra = l == 0 ? 0 : 4;
        EpiInProj E{(bf16_t*)(ws + WS_Q), (bf16_t*)(ws + WS_K), (bf16_t*)(ws + WS_VT), (bf16_t*)(ws + WS_U), (bf16_t*)(ws + WS_Z), (bf16_t*)(ws + WS_G), (const float*)(ws + WS_ROPE)};
        pg8::gemm_phase(lds, S, E);
    }
    SEAM(base + 2);
    if (IN(base + 2)) REP(2) { REPBAR(); phase_mix(a, l, lds, G, c); }
    SEAM(base + 3);
    if (IN(base + 3)) REP(3) { REPBAR();
        SchedMerge S; S.nt = 8; S.ldb_b = 3072; S.lda_b = 3072; S.G = G; S.c = c; S.A = (const char*)(ws + WS_BR); S.B = (const char*)(ws + WS_WMERGE) + (size_t)l * 1024 * 3072; S.nM = nM;
        EpiMerge E{(const bf16_t*)(ws + WS_G), (bf16_t*)(ws + WS_MERGED)};
        pg8::gemm_phase(lds, S, E);
    }
    SEAM(base + 4);
    if (IN(base + 4)) for (int _r = 0; _r < (L == 0 ? REPS(4) : 1); ++_r) { REPBAR();
        SchedOut S; S.nt = 16; S.ldb_b = 2048; S.lda_b = 2048; S.G = G; S.c = c; S.A = (const char*)(ws + WS_MERGED); S.B = (const char*)(ws + WS_WOUT) + (size_t)l * 1024 * 2048; S.nM = nM;
        EpiOut E{a.in[I_X], a.in[I_CTX], (float*)(ws + WS_X), (const float*)(ws + WS_MOD), l};
        pg8::gemm_phase(lds, S, E);
    }
    SEAM(base + 5);
    if (IN(base + 5)) REP(5) { REPBAR(); norm_phase<2>(a, l, lds, G, c); }
    SEAM(base + 6);
    if (IN(base + 6)) REP(6) { REPBAR();
        const int nu = l == 0 ? 128 : 64;
        for (int u = c; u < nu; u += G) topk_unit(a, lds, u >> 4, u & 15);
        if (l == 1) {
            __syncthreads();
            const int wid = __builtin_amdgcn_readfirstlane(tid >> 6);
            convert_experts(a, 1, (LAS float*)(lds + wid * 16384), c * 8 + wid, G * 8, tid & 63);
        }
    }
    SEAM(base + 7);
    if (IN(base + 7)) REP(7) { REPBAR();
        const int* TOKOF = (const int*)(ws + WS_TOKOF); LAS int* idx = (LAS int*)(lds + LDS_IDX_OFF);
        const int nunits = NE * nmt * 8;
        for (int ibase = 0; ibase * G + c < nunits; ibase += 8) {
            __syncthreads();
            for (int q = tid; q < 8 * 256; q += 512) { const int i = q >> 8; const int Lu = (ibase + i) * G + c;
                if (Lu < nunits) { const int mt = (Lu / 8) % nmt, e = Lu / (8 * nmt); idx[q] = TOKOF[e * ESLOT + mt * 256 + (q & 255)]; } }
            __syncthreads();
            SchedGU S; S.nt = 16; S.ldb_b = 2048; S.lda_b = 2048; S.G = G; S.c = c; S.A = (const char*)(ws + WS_H); S.B = (const char*)(ws + WS_WGU); S.nmt = nmt; S.ibase = ibase; S.idx = idx;
            EpiGU E{(bf16_t*)(ws + WS_ACT)};
            pg8::gemm_phase(lds, S, E);
        }
    }
    SEAM(base + 8);
    if (IN(base + 8)) REP(8) { REPBAR();
        SchedDown S; S.nt = 16; S.ldb_b = 2048; S.lda_b = 2048; S.G = G; S.c = c; S.A = (const char*)(ws + WS_ACT); S.B = (const char*)(ws + WS_WDN); S.nmt = nmt;
        EpiDown E{(bf16_t*)(ws + WS_Y)};
        pg8::gemm_phase(lds, S, E);
    }
}

__global__ void __launch_bounds__(512, 2) fwd_kernel(Args a) {
    extern __shared__ __attribute__((aligned(16))) unsigned char lds_raw[];
    LAS unsigned char* lds = (LAS unsigned char*)lds_raw;
    const int tid = threadIdx.x; const int G = gridDim.x, c = blockIdx.x;
    volatile LAS unsigned* MISC = (volatile LAS unsigned*)(lds + LDS_MISC_OFF);
    if (tid < 32) MISC[tid] = 0u;
    __syncthreads();
#if !MK_PER_PHASE
    XcdBarrier bar = xcd_barrier_post((unsigned*)(a.ws + WS_BAR), MISC + 8);
#else
    XcdBarrier bar; bar.bar = nullptr; bar.x = 0; bar.st = MISC + 8;
#endif
    const int lo = a.ph_lo, hi = a.ph_hi;
    if (IN(0)) REP(9) { REPBAR(); phase_prep(a, lds, G, c); }
    run_layer<0>(a, lds, G, c, lo, hi, bar);
    run_layer<1>(a, lds, G, c, lo, hi, bar);
    SEAM(NPHASE - 1);
    if (IN(NPHASE - 1)) REP(10) { REPBAR(); norm_phase<3>(a, 1, lds, G, c); }
}

extern "C" void kernel_launch(void* const* d_in, const int* in_sizes, int n_in, void* d_out, int out_size, void* d_ws, size_t ws_size, hipStream_t stream) {
    static int grid = 0;
    if (grid == 0) {
        if (n_in != 25 || out_size != TL * DM || ws_size < WS_END) { fprintf(stderr, "kernel_launch: unexpected shapes (n_in %d out %d ws %zu)\n", n_in, out_size, ws_size); grid = -1; return; }
        int dev = 0, cus = 0, per_cu = 0;
        if (hipGetDevice(&dev) != hipSuccess || hipDeviceGetAttribute(&cus, hipDeviceAttributeMultiprocessorCount, dev) != hipSuccess) { grid = -1; return; }
        if (hipFuncSetAttribute((const void*)fwd_kernel, hipFuncAttributeMaxDynamicSharedMemorySize, LDS_BYTES) != hipSuccess) { fprintf(stderr, "kernel_launch: hipFuncSetAttribute failed\n"); grid = -1; return; }
        if (hipOccupancyMaxActiveBlocksPerMultiprocessor(&per_cu, (const void*)fwd_kernel, 512, LDS_BYTES) != hipSuccess || per_cu < 1) { fprintf(stderr, "kernel_launch: occupancy query says %d blocks per CU\n", per_cu); (void)hipGetLastError(); grid = -1; return; }
        grid = cus;
    }
    if (grid < 0) return;
    (void)hipMemsetAsync((char*)d_ws + WS_BAR, 0, 65536, stream);
    Args a{};
    for (int i = 0; i < 25; ++i) a.in[i] = (const float*)d_in[i];
    a.out = (float*)d_out; a.ws = (unsigned char*)d_ws;
#if MK_PER_PHASE
    for (int ph = 0; ph < NPHASE; ++ph) { a.ph_lo = ph; a.ph_hi = ph + 1; hipLaunchKernelGGL(fwd_kernel, dim3(grid), dim3(512), LDS_BYTES, stream, a); }
#else
    a.ph_lo = 0; a.ph_hi = NPHASE;
    hipLaunchKernelGGL(fwd_kernel, dim3(grid), dim3(512), LDS_BYTES, stream, a);
#endif
}
```

```cpp
#include <hip/hip_runtime.h>
#include <hip/hip_cooperative_groups.h>
#include <cstdio>
#include <cstdint>
namespace cg = cooperative_groups;

#ifndef MK_PER_PHASE
#define MK_PER_PHASE 0
#endif

#define LAS __attribute__((address_space(3)))
#define DI __device__ __forceinline__
typedef unsigned short bf16_t;
typedef short bf16x8 __attribute__((ext_vector_type(8)));
typedef short s16x4 __attribute__((ext_vector_type(4)));
typedef float f32x4 __attribute__((ext_vector_type(4)));
typedef float f32x16 __attribute__((ext_vector_type(16)));
typedef unsigned u32x4 __attribute__((ext_vector_type(4)));
typedef unsigned u32x2 __attribute__((ext_vector_type(2)));

constexpr int DM = 1024, NBATCH = 4, SEQ = 4096, CTXL = 256;
constexpr int TL = NBATCH * SEQ, TC = NBATCH * CTXL, TT = TL + TC;
constexpr int INW = 5376;
constexpr int NE = 16, ESLOT = 2304;
constexpr float LOG2E = 1.4426950408889634f;
constexpr float QSC = 0.125f * LOG2E;
constexpr int NPHASE = 20;

constexpr size_t MiB = (size_t)1 << 20;
constexpr size_t WS_BAR = 0;
constexpr size_t WS_MOD = 1 * MiB, WS_ROPE = 1 * MiB + 512 * 1024;
constexpr size_t WS_AFF = 2 * MiB, WS_SLOTOF = 4 * MiB, WS_TOKOF = 6 * MiB;
constexpr size_t WS_WIN = 8 * MiB, WS_WMERGE = 29 * MiB, WS_WOUT = 35 * MiB, WS_WGU = 40 * MiB, WS_WDN = 104 * MiB;
constexpr size_t WS_X = 136 * MiB, WS_H = 204 * MiB;
constexpr size_t WS_Q = 238 * MiB, WS_K = 255 * MiB, WS_VT = 260 * MiB, WS_U = 265 * MiB, WS_Z = 282 * MiB, WS_G = 299 * MiB, WS_BR = 401 * MiB;
constexpr size_t WS_DELTA = 401 * MiB;
constexpr size_t WS_MERGED = 238 * MiB;
constexpr size_t WS_ACT = 238 * MiB, WS_Y = 310 * MiB;
constexpr size_t WS_WGU1 = 452 * MiB, WS_WDN1 = 516 * MiB;
constexpr size_t WS_END = 548 * MiB;
DI size_t ws_wgu(int l) { return l == 0 ? WS_WGU : WS_WGU1; }
DI size_t ws_wdn(int l) { return l == 0 ? WS_WDN : WS_WDN1; }

constexpr int LDS_BYTES = 147456;
constexpr int RING_BYTES = 131072;
constexpr int LDS_IDX_OFF = RING_BYTES;
constexpr int LDS_MISC_OFF = RING_BYTES + 8192;

struct Args { const float* in[25]; float* out; unsigned char* ws; int ph_lo, ph_hi; };
enum { I_X = 0, I_C, I_CTX, I_CCTX, I_N1G, I_N2G, I_WMOD, I_BMOD, I_WIN, I_SINK, I_WAO, I_CDW, I_CDWB, I_CLNG, I_CLNB, I_WCO, I_WPOOL, I_PSCALE, I_WPO, I_WOUT, I_WR, I_WEG, I_WEU, I_WED, I_FNG };

DI unsigned pk_bf16(float lo, float hi) {
    typedef float f2 __attribute__((ext_vector_type(2))); typedef __bf16 b2 __attribute__((ext_vector_type(2)));
    f2 v = {lo, hi}; b2 b = __builtin_convertvector(v, b2); return __builtin_bit_cast(unsigned, b);
}
DI bf16_t f2bf(float f) { return (bf16_t)(pk_bf16(f, 0.f) & 0xffffu); }
DI float bf_lo(unsigned u) { return __uint_as_float(u << 16); }
DI float bf_hi(unsigned u) { return __uint_as_float(u & 0xffff0000u); }
DI float bf2f(bf16_t b) { return __uint_as_float(((unsigned)b) << 16); }
DI float sigm(float x) { return __builtin_amdgcn_rcpf(1.f + __builtin_amdgcn_exp2f(x * -LOG2E)); }
DI float wave_sum(float v) {
#pragma unroll
    for (int o = 1; o < 64; o <<= 1) v += __shfl_xor(v, o);
    return v;
}
DI float max3f(float a, float b, float c) { float r; asm("v_max3_f32 %0, %1, %2, %3" : "=v"(r) : "v"(a), "v"(b), "v"(c)); return r; }
DI int crow(int r, int hi) { return (r & 3) + 8 * (r >> 2) + 4 * hi; }
#define LDS_WAIT() asm volatile("s_waitcnt lgkmcnt(0)" ::: "memory")

namespace pg8 {
constexpr int BM = 256, BK = 64, HALF = 128, HTB = HALF * BK * 2;
DI int lds_byte(int r, int c) { const int st = (r >> 4) * 2 + (c >> 5), rr = r & 15, cc = c & 31, ob = rr * 64 + cc * 2; return st * 1024 + (ob ^ (((ob >> 9) & 1) << 5)); }
DI void stage_rc(int b, int& R, int& C) { const int st = b / 1024, sb = b % 1024, swz = sb ^ (((sb >> 9) & 1) << 5); R = (st >> 1) * 16 + swz / 64; C = (st & 1) * 32 + (swz % 64) / 2; }

struct Unit { const char* a; const char* b; int i0, i1, i2, ui; };

DI void tile_order(int L, int nM, int nN, int& pm, int& pn) {
    const int nwg = nM * nN; int wgid = L;
    { const int q = nwg / 8, r = nwg % 8, xcd = wgid % 8, off = wgid / 8; wgid = (xcd < r ? xcd * (q + 1) : r * (q + 1) + (xcd - r) * q) + off; }
    const int nig = 8 * nN, gid = wgid / nig, fm = gid * 8, gsz = (nM - fm) < 8 ? (nM - fm) : 8;
    pm = fm + ((wgid % nig) % gsz); pn = (wgid % nig) / gsz;
}

template <class Epi, class Sched>
DI void gemm_phase(LAS unsigned char* lds, const Sched& S, const Epi& E) {
    const int tid = threadIdx.x, wid = __builtin_amdgcn_readfirstlane(tid >> 6), lane = tid & 63, wr = wid >> 2, wc = wid & 3, fr = lane & 15, fq = lane >> 4;
    const int nt = S.nt;
    int R0, C0, R1, C1; stage_rc(tid * 16, R0, C0); stage_rc(tid * 16 + 8192, R1, C1);
    unsigned voffB[2][2];
#pragma unroll
    for (int h = 0; h < 2; ++h) { voffB[h][0] = (unsigned)((h * HALF + R0) * S.ldb_b + C0 * 2); voffB[h][1] = (unsigned)((h * HALF + R1) * S.ldb_b + C1 * 2); }
    const size_t kstep = (size_t)(BK * 2);
    const unsigned ldsw = (unsigned)wid * 1024u;
    const int aoff = lds_byte(wr * 64 + fr, fq * 8), boff = lds_byte(wc * 32 + fr, fq * 8);
#define PG8_SA(b, h) (((b) * 2 + (h)) * HTB)
#define PG8_SB(b, h) ((4 + (b) * 2 + (h)) * HTB)
#define PG8_STAGE(bufoff, gbase, voff) do { _Pragma("unroll") for (int _i = 0; _i < 2; ++_i) \
        __builtin_amdgcn_global_load_lds((const unsigned*)((const char*)(gbase) + (voff)[_i]), (LAS unsigned*)(lds + (bufoff) + ldsw + _i * 8192), 16, 0, 0); } while (0)
#define PG8_LDA(dst, b, h) do { _Pragma("unroll") for (int m = 0; m < 4; ++m) _Pragma("unroll") for (int k = 0; k < 2; ++k) dst[m][k] = *(const LAS bf16x8*)(lds + PG8_SA(b, h) + aoff + m * 2048 + k * 1024); } while (0)
#define PG8_LDB(dst, b, h) do { _Pragma("unroll") for (int n = 0; n < 2; ++n) _Pragma("unroll") for (int k = 0; k < 2; ++k) dst[n][k] = *(const LAS bf16x8*)(lds + PG8_SB(b, h) + boff + n * 2048 + k * 1024); } while (0)
#define PG8_MMA(ai, bj, At, Bt) do { __builtin_amdgcn_s_setprio(1); _Pragma("unroll") for (int m = 0; m < 4; ++m) _Pragma("unroll") for (int n = 0; n < 2; ++n) _Pragma("unroll") for (int k = 0; k < 2; ++k) \
        acc[ai][bj][m][n] = __builtin_amdgcn_mfma_f32_16x16x32_bf16(Bt[n][k], At[m][k], acc[ai][bj][m][n], 0, 0, 0); __builtin_amdgcn_s_setprio(0); } while (0)
#define PG8_WAIT_V(n) asm volatile("s_waitcnt vmcnt(" #n ")" ::: "memory")
#define PG8_WAIT_L(n) asm volatile("s_waitcnt lgkmcnt(" #n ")" ::: "memory")
#define PG8_BAR __builtin_amdgcn_s_barrier()
#define PG8_SCHED __builtin_amdgcn_sched_barrier(0)
    Unit cur, nxt; int ui = 0;
    if (!S.next(0, cur)) return;
    f32x4 acc[2][2][4][2];
#pragma unroll
    for (int a = 0; a < 2; ++a)
#pragma unroll
        for (int b = 0; b < 2; ++b)
#pragma unroll
            for (int m = 0; m < 4; ++m)
#pragma unroll
                for (int n = 0; n < 2; ++n) acc[a][b][m][n] = (f32x4){0.f, 0.f, 0.f, 0.f};
    bf16x8 At[4][2], B0[2][2], B1[2][2];
    unsigned cvA[2][2], nvA[2][2];
    S.voff(cur, R0, C0, R1, C1, cvA);
    const char* cA = cur.a; const char* cB = cur.b;
    PG8_STAGE(PG8_SB(0, 0), cB, voffB[0]); PG8_STAGE(PG8_SB(0, 1), cB, voffB[1]); PG8_STAGE(PG8_SA(0, 0), cA, cvA[0]); PG8_STAGE(PG8_SA(0, 1), cA, cvA[1]);
    if (wr == 1) PG8_BAR;
    PG8_WAIT_V(2); PG8_BAR;
    PG8_STAGE(PG8_SB(1, 0), cB + kstep, voffB[0]); PG8_STAGE(PG8_SA(1, 0), cA + kstep, cvA[0]); PG8_STAGE(PG8_SB(1, 1), cB + kstep, voffB[1]);
    PG8_WAIT_V(6); PG8_BAR;
    for (;;) {
        const bool has_next = S.next(ui + 1, nxt);
        const char* nA = has_next ? nxt.a : cA; const char* nB = has_next ? nxt.b : cB;
        if (has_next) S.voff(nxt, R0, C0, R1, C1, nvA);
        else {
#pragma unroll
            for (int h = 0; h < 2; ++h) { nvA[h][0] = cvA[h][0]; nvA[h][1] = cvA[h][1]; }
        }
        for (int t = 0; t < nt; t += 2) {
            if constexpr (Epi::HOOK) { if (t == 8 || t == 16) E.hook(acc, cur, t >> 4, wr, wc, fr, fq); }
            const bool last = (t == nt - 2);
            const char* a1 = cA + (size_t)(t + 1) * kstep;
            const char* a2 = last ? nA : cA + (size_t)(t + 2) * kstep; const char* b2 = last ? nB : cB + (size_t)(t + 2) * kstep;
            const char* a3 = a2 + kstep; const char* b3 = b2 + kstep;
            unsigned v2[2][2];
#pragma unroll
            for (int h = 0; h < 2; ++h) { v2[h][0] = last ? nvA[h][0] : cvA[h][0]; v2[h][1] = last ? nvA[h][1] : cvA[h][1]; }
            PG8_LDB(B0, 0, 0); PG8_LDB(B1, 0, 1); PG8_SCHED; PG8_LDA(At, 0, 0); PG8_STAGE(PG8_SA(1, 1), a1, cvA[1]);
            PG8_WAIT_V(8); PG8_WAIT_L(0); PG8_BAR; PG8_MMA(0, 0, At, B0); PG8_MMA(0, 1, At, B1); PG8_BAR; PG8_SCHED;
            PG8_LDA(At, 0, 1); PG8_STAGE(PG8_SB(0, 0), b2, voffB[0]); PG8_STAGE(PG8_SB(0, 1), b2, voffB[1]); PG8_STAGE(PG8_SA(0, 0), a2, v2[0]);
            PG8_WAIT_V(8); PG8_WAIT_L(0); PG8_BAR; PG8_MMA(1, 0, At, B0); PG8_MMA(1, 1, At, B1); PG8_BAR; PG8_SCHED;
            PG8_LDB(B0, 1, 0); PG8_LDB(B1, 1, 1); PG8_SCHED; PG8_LDA(At, 1, 0); PG8_STAGE(PG8_SA(0, 1), a2, v2[1]);
            PG8_WAIT_V(8); PG8_WAIT_L(0); PG8_BAR; PG8_MMA(0, 0, At, B0); PG8_MMA(0, 1, At, B1); PG8_BAR; PG8_SCHED;
            PG8_LDA(At, 1, 1); PG8_STAGE(PG8_SB(1, 0), b3, voffB[0]); PG8_STAGE(PG8_SB(1, 1), b3, voffB[1]); PG8_STAGE(PG8_SA(1, 0), a3, v2[0]);
            PG8_WAIT_V(8); PG8_WAIT_L(0); PG8_BAR; PG8_MMA(1, 0, At, B0); PG8_MMA(1, 1, At, B1); PG8_BAR; PG8_SCHED;
        }
        if (wr == 0) PG8_BAR;
        E(acc, cur, wr, wc, fr, fq);
        if (!has_next) break;
#pragma unroll
        for (int a = 0; a < 2; ++a)
#pragma unroll
            for (int b = 0; b < 2; ++b)
#pragma unroll
                for (int m = 0; m < 4; ++m)
#pragma unroll
                    for (int n = 0; n < 2; ++n) acc[a][b][m][n] = (f32x4){0.f, 0.f, 0.f, 0.f};
        cur = nxt; cA = nA; cB = nB; ++ui;
#pragma unroll
        for (int h = 0; h < 2; ++h) { cvA[h][0] = nvA[h][0]; cvA[h][1] = nvA[h][1]; }
        if (wr == 1) PG8_BAR;
    }
    PG8_WAIT_V(0);
    PG8_BAR;
#undef PG8_SA
#undef PG8_SB
#undef PG8_STAGE
#undef PG8_LDA
#undef PG8_LDB
#undef PG8_MMA
#undef PG8_WAIT_V
#undef PG8_WAIT_L
#undef PG8_BAR
#undef PG8_SCHED
}
}
using pg8::Unit;
typedef f32x4 Acc[2][2][4][2];

struct SchedBase {
    int nt, ldb_b, lda_b, G, c;
    DI void voff_contig(int R0, int C0, int R1, int C1, unsigned (&vo)[2][2]) const {
#pragma unroll
        for (int h = 0; h < 2; ++h) { vo[h][0] = (unsigned)((h * 128 + R0) * lda_b + C0 * 2); vo[h][1] = (unsigned)((h * 128 + R1) * lda_b + C1 * 2); }
    }
};
struct SchedInProj : SchedBase {
    const char* A; const char* B; int nM, n1, n1p, ntot, lo, hi;
    DI void init_counts(int nM_, int extra) { nM = nM_; n1 = nM * 9 + extra; n1p = (n1 + 7) & ~7; ntot = n1p + nM * 12; }
    DI bool next(int i, Unit& u) const {
        const int L = lo + i * G + c; if (L >= hi) return false; int pm, pn;
        if (L < n1p) { const int L1 = L < n1 ? L : L - n1; if (L1 < nM * 9) pg8::tile_order(L1, nM, 9, pm, pn); else { pm = 64 + (L1 - nM * 9); pn = 2; } }
        else { pg8::tile_order(L - n1p, nM, 12, pm, pn); pn += 9; }
        u.a = A + (size_t)pm * 256 * 2048; u.b = B + (size_t)pn * 256 * 2048; u.i0 = pm; u.i1 = pn; u.i2 = 0; u.ui = i; return true;
    }
    DI void voff(const Unit&, int R0, int C0, int R1, int C1, unsigned (&vo)[2][2]) const { voff_contig(R0, C0, R1, C1, vo); }
};
struct SchedMerge : SchedBase {
    const char* A; const char* B; int nM;
    DI bool next(int i, Unit& u) const {
        const int L = i * G + c; if (L >= nM * 4) return false;
        int pm, pn; pg8::tile_order(L, nM, 4, pm, pn);
        u.a = A + (size_t)pm * 256 * 3072; u.b = B + (size_t)pn * 256 * 3072; u.i0 = pm; u.i1 = pn; u.i2 = 0; u.ui = i; return true;
    }
    DI void voff(const Unit&, int R0, int C0, int R1, int C1, unsigned (&vo)[2][2]) const { voff_contig(R0, C0, R1, C1, vo); }
};
struct SchedOut : SchedBase {
    const char* A; const char* B; int nM;
    DI bool next(int i, Unit& u) const {
        const int L = i * G + c; if (L >= nM * 4) return false;
        int pm, pn; pg8::tile_order(L, nM, 4, pm, pn);
        u.a = A + (size_t)pm * 256 * 2048; u.b = B + (size_t)pn * 256 * 2048; u.i0 = pm; u.i1 = pn; u.i2 = 0; u.ui = i; return true;
    }
    DI void voff(const Unit&, int R0, int C0, int R1, int C1, unsigned (&vo)[2][2]) const { voff_contig(R0, C0, R1, C1, vo); }
};
struct SchedGU : SchedBase {
    const char* A; const char* B; int nmt, ibase; const LAS int* idx;
    DI bool next(int i, Unit& u) const {
        if (i >= 8) return false;
        const int L = (ibase + i) * G + c; if (L >= NE * nmt * 8) return false;
        const int n8 = L % 8, mt = (L / 8) % nmt, e = L / (8 * nmt);
        u.a = A; u.b = B + ((size_t)e * 2048 + n8 * 256) * 2048; u.i0 = e; u.i1 = mt; u.i2 = n8; u.ui = i; return true;
    }
    DI void voff(const Unit& u, int R0, int C0, int R1, int C1, unsigned (&vo)[2][2]) const {
#pragma unroll
        for (int h = 0; h < 2; ++h) { vo[h][0] = (unsigned)(idx[u.ui * 256 + h * 128 + R0] * 2048 + C0 * 2); vo[h][1] = (unsigned)(idx[u.ui * 256 + h * 128 + R1] * 2048 + C1 * 2); }
    }
};
struct SchedDown : SchedBase {
    const char* A; const char* B; int nmt;
    DI bool next(int i, Unit& u) const {
        const int L = i * G + c; if (L >= NE * nmt * 4) return false;
        const int n4 = L % 4, mt = (L / 4) % nmt, e = L / (4 * nmt);
        u.a = A + ((size_t)e * ESLOT + mt * 256) * 2048; u.b = B + ((size_t)e * 1024 + n4 * 256) * 2048; u.i0 = e; u.i1 = mt; u.i2 = n4; u.ui = i; return true;
    }
    DI void voff(const Unit&, int R0, int C0, int R1, int C1, unsigned (&vo)[2][2]) const { voff_contig(R0, C0, R1, C1, vo); }
};

DI void st_bf4(bf16_t* p, f32x4 v) { u32x2 w; w.x = pk_bf16(v[0], v[1]); w.y = pk_bf16(v[2], v[3]); *(u32x2*)p = w; }
DI float gatef(float x) { return fminf(1.f + __builtin_amdgcn_exp2f(x * -LOG2E), 1e18f); }
DI f32x4 gate4(f32x4 v) { return (f32x4){gatef(v[0]), gatef(v[1]), gatef(v[2]), gatef(v[3])}; }
DI f32x4 sig4(f32x4 v) { return (f32x4){sigm(v[0]), sigm(v[1]), sigm(v[2]), sigm(v[3])}; }

struct EpiInProj {
    static constexpr bool HOOK = false;
    bf16_t *Q, *K, *VT, *U, *Z, *G; const float* rope;
    DI void operator()(const Acc& acc, const Unit& u, int wr, int wc, int fr, int fq) const {
        const int pm = u.i0, pn = u.i1;
#pragma unroll
        for (int bj = 0; bj < 2; ++bj) {
            const int gc = 256 * pn + 128 * bj + 32 * wc;
#pragma unroll
            for (int ai = 0; ai < 2; ++ai)
#pragma unroll
                for (int m = 0; m < 4; ++m) {
                    const int t = 256 * pm + 128 * ai + 64 * wr + 16 * m + fr;
                    const f32x4 v0 = acc[ai][bj][m][0], v1 = acc[ai][bj][m][1];
                    if (gc < 640) {
                        f32x4 o0 = v0, o1 = v1;
                        if (t < TL) {
                            const int s = t & (SEQ - 1); const int p = ((gc >> 5) & 1) ? (s & 63) : (s >> 6);
                            const f32x4 cs = *(const f32x4*)(rope + p * 16 + 4 * fq), sn = *(const f32x4*)(rope + 1024 + p * 16 + 4 * fq);
                            o0 = v0 * cs - v1 * sn; o1 = v1 * cs + v0 * sn;
                        }
                        bf16_t* dst;
                        if (gc < 512) { o0 = o0 * QSC; o1 = o1 * QSC; dst = Q + (size_t)t * 512 + gc + 4 * fq; } else dst = K + (size_t)t * 128 + (gc - 512) + 4 * fq;
                        st_bf4(dst, o0); st_bf4(dst + 16, o1);
                    } else if (gc < 768) {
                        const int c0 = gc - 640 + 4 * fq;
#pragma unroll
                        for (int j = 0; j < 4; ++j) { VT[(size_t)(c0 + j) * TT + t] = f2bf(v0[j]); VT[(size_t)(c0 + 16 + j) * TT + t] = f2bf(v1[j]); }
                    } else if (gc < 1792) {
                        const int ch = ((gc - 768) >> 1) + 4 * fq;
                        st_bf4(U + (size_t)t * 512 + ch, v0 * sig4(v1));
                    } else if (gc < 2304) {
                        bf16_t* dst = Z + (size_t)t * 512 + (gc - 1792) + 4 * fq; st_bf4(dst, v0); st_bf4(dst + 16, v1);
                    } else {
                        const int gt = pn - 9; const size_t gb = ((((size_t)(pm * 3 + (gt >> 2)) * 4 + (gt & 3)) * 8 + (wr * 4 + wc)) * 16 + ((ai * 4 + m) * 2 + bj)) * 64 + (fq * 16 + fr);
                        const f32x4 g0 = gate4(v0), g1 = gate4(v1); u32x4 gw; gw.x = pk_bf16(g0[0], g0[1]); gw.y = pk_bf16(g0[2], g0[3]); gw.z = pk_bf16(g1[0], g1[1]); gw.w = pk_bf16(g1[2], g1[3]);
                        __builtin_nontemporal_store(gw, (u32x4*)(G + gb * 8));
                    }
                }
        }
    }
};
struct EpiMerge {
    static constexpr bool HOOK = true;
    const bf16_t* G; bf16_t* M;
    DI static f32x4 lo4(u32x4 w) { return (f32x4){bf_lo(w.x), bf_hi(w.x), bf_lo(w.y), bf_hi(w.y)}; }
    DI static f32x4 hi4(u32x4 w) { return (f32x4){bf_lo(w.z), bf_hi(w.z), bf_lo(w.w), bf_hi(w.w)}; }
    DI static f32x4 rcp4(f32x4 v) { return (f32x4){__builtin_amdgcn_rcpf(v[0]), __builtin_amdgcn_rcpf(v[1]), __builtin_amdgcn_rcpf(v[2]), __builtin_amdgcn_rcpf(v[3])}; }
    DI void hook(Acc& acc, const Unit& u, int which, int wr, int wc, int fr, int fq) const {
        int lofs = fq * 16 + fr; asm volatile("" : "+v"(lofs));
        const u32x4* pa = (const u32x4*)G + ((((size_t)(u.i0 * 3 + which) * 4 + u.i1) * 8 + (wr * 4 + wc)) * 16) * 64 + lofs;
        const u32x4* pb = pa + (size_t)4 * 8 * 16 * 64;
        u32x4 ba[4][2], bb[4][2];
#pragma unroll
        for (int h = 0; h < 2; ++h) {
#pragma unroll
            for (int g = 0; g < 4; ++g)
#pragma unroll
                for (int q = 0; q < 2; ++q) { ba[g][q] = pa[((4 * h + g) * 2 + q) * 64]; bb[g][q] = pb[((4 * h + g) * 2 + q) * 64]; }
#pragma unroll
            for (int g = 0; g < 4; ++g)
#pragma unroll
                for (int q = 0; q < 2; ++q) {
                    acc[h][q][g][0] = acc[h][q][g][0] * (lo4(bb[g][q]) * rcp4(lo4(ba[g][q])));
                    acc[h][q][g][1] = acc[h][q][g][1] * (hi4(bb[g][q]) * rcp4(hi4(ba[g][q]))); }
            asm volatile("" ::: "memory");
        }
    }
    DI void operator()(const Acc& acc, const Unit& u, int wr, int wc, int fr, int fq) const {
        const int pm = u.i0, pn = u.i1;
        const u32x4* pc = (const u32x4*)G + ((((size_t)(pm * 3 + 2) * 4 + pn) * 8 + (wr * 4 + wc)) * 16) * 64 + (fq * 16 + fr);
#pragma unroll
        for (int ai = 0; ai < 2; ++ai)
#pragma unroll
            for (int m = 0; m < 4; ++m) {
                const int t = 256 * pm + 128 * ai + 64 * wr + 16 * m + fr;
#pragma unroll
                for (int bj = 0; bj < 2; ++bj) {
                    const u32x4 gw = pc[((ai * 4 + m) * 2 + bj) * 64];
                    const int cc = 256 * pn + 128 * bj + 32 * wc + 4 * fq;
                    st_bf4(M + (size_t)t * 1024 + cc, acc[ai][bj][m][0] * rcp4(lo4(gw))); st_bf4(M + (size_t)t * 1024 + cc + 16, acc[ai][bj][m][1] * rcp4(hi4(gw)));
                }
            }
    }
};
struct EpiOut {
    static constexpr bool HOOK = false;
    bf16_t* D; const float* mod; int layer;
    DI void operator()(const Acc& acc, const Unit& u, int wr, int wc, int fr, int fq) const {
        const int pm = u.i0, pn = u.i1; const int row0 = 256 * pm;
        const int mr = row0 < TL ? (row0 >> 12) : 4;
        const float* g1 = mod + (size_t)(layer * 5 + mr) * 6144 + 2048;
#pragma unroll
        for (int bj = 0; bj < 2; ++bj)
#pragma unroll
            for (int n = 0; n < 2; ++n) {
                const int cc = 256 * pn + 128 * bj + 32 * wc + 16 * n + 4 * fq;
                const f32x4 gv = *(const f32x4*)(g1 + cc);
#pragma unroll
                for (int ai = 0; ai < 2; ++ai)
#pragma unroll
                    for (int m = 0; m < 4; ++m) {
                        const int t = row0 + 128 * ai + 64 * wr + 16 * m + fr;
                        st_bf4(D + (size_t)t * DM + cc, gv * acc[ai][bj][m][n]);
                    }
            }
    }
};
struct EpiGU {
    static constexpr bool HOOK = false;
    bf16_t* ACT;
    DI void operator()(const Acc& acc, const Unit& u, int wr, int wc, int fr, int fq) const {
        const int e = u.i0, mt = u.i1, n8 = u.i2;
#pragma unroll
        for (int ai = 0; ai < 2; ++ai)
#pragma unroll
            for (int m = 0; m < 4; ++m) {
                const size_t slot = (size_t)e * ESLOT + mt * 256 + 128 * ai + 64 * wr + 16 * m + fr;
#pragma unroll
                for (int bj = 0; bj < 2; ++bj) {
                    const int col = ((256 * n8 + 128 * bj + 32 * wc) >> 1) + 4 * fq;
                    const f32x4 gt = acc[ai][bj][m][0], up = acc[ai][bj][m][1];
                    st_bf4(ACT + slot * 1024 + col, gt * sig4(gt) * up);
                }
            }
    }
};
struct EpiDown {
    static constexpr bool HOOK = false;
    bf16_t* Y;
    DI void operator()(const Acc& acc, const Unit& u, int wr, int wc, int fr, int fq) const {
        const int e = u.i0, mt = u.i1, n4 = u.i2;
#pragma unroll
        for (int ai = 0; ai < 2; ++ai)
#pragma unroll
            for (int m = 0; m < 4; ++m) {
                const size_t slot = (size_t)e * ESLOT + mt * 256 + 128 * ai + 64 * wr + 16 * m + fr;
#pragma unroll
                for (int bj = 0; bj < 2; ++bj)
#pragma unroll
                    for (int n = 0; n < 2; ++n) st_bf4(Y + slot * 1024 + 256 * n4 + 128 * bj + 32 * wc + 16 * n + 4 * fq, acc[ai][bj][m][n]);
            }
    }
};

DI int maprow(int mode, int n) {
    if (mode == 1) {
        if (n >= 768 && n < 1280) { const int ch = n - 768; return 768 + 32 * (ch >> 4) + (ch & 15); }
        if (n >= 1280 && n < 1792) { const int ch = n - 1280; return 768 + 32 * (ch >> 4) + 16 + (ch & 15); }
        return n;
    }
    if (mode == 2) return 32 * (n >> 4) + (n & 15);
    if (mode == 3) return 32 * (n >> 4) + 16 + (n & 15);
    return n;
}
struct ConvTile { const float* W; bf16_t* WT; int N, dpitch, dcol0, mode, kb, nb; };
DI void tile_load(const ConvTile& t, int lane, f32x4 (&x)[8]) {
    const float* p = t.W + (size_t)(64 * t.kb + 8 * (lane & 7)) * t.N + 32 * t.nb + 4 * (lane >> 3);
#pragma unroll
    for (int r = 0; r < 8; ++r) x[r] = __builtin_nontemporal_load((const f32x4*)(p + (size_t)r * t.N));
}
DI void tile_store(const ConvTile& t, int lane, const f32x4 (&x)[8]) {
    const int n = 32 * t.nb + 4 * (lane >> 3);
#pragma unroll
    for (int i = 0; i < 4; ++i) { u32x4 o; o.x = pk_bf16(x[0][i], x[1][i]); o.y = pk_bf16(x[2][i], x[3][i]); o.z = pk_bf16(x[4][i], x[5][i]); o.w = pk_bf16(x[6][i], x[7][i]);
        *(u32x4*)(t.WT + (size_t)maprow(t.mode, n + i) * t.dpitch + t.dcol0 + 64 * t.kb + 8 * (lane & 7)) = o; }
}
DI ConvTile small_tile(const Args& a, int it) {
    unsigned char* ws = a.ws; ConvTile t;
    constexpr int I_A = 16 * 168, I_B = 8 * 32, I_C = 8 * 32, I_D = 16 * 32, PER = I_A + I_B + I_C + I_D;
    const int l = it / PER; int r = it % PER;
    if (r < I_A) { t.W = a.in[I_WIN] + (size_t)l * 1024 * INW; t.N = INW; t.WT = (bf16_t*)(ws + WS_WIN) + (size_t)l * INW * 1024; t.dpitch = 1024; t.dcol0 = 0; t.mode = 1; }
    else if ((r -= I_A) < I_B) { t.W = a.in[I_WAO] + (size_t)l * 512 * 1024; t.N = 1024; t.WT = (bf16_t*)(ws + WS_WMERGE) + (size_t)l * 1024 * 1536; t.dpitch = 1536; t.dcol0 = 0; t.mode = 0; }
    else if ((r -= I_B) < I_C) { t.W = a.in[I_WCO] + (size_t)l * 512 * 1024; t.N = 1024; t.WT = (bf16_t*)(ws + WS_WMERGE) + (size_t)l * 1024 * 1536; t.dpitch = 1536; t.dcol0 = 512; t.mode = 0; }
    else { r -= I_C; t.W = a.in[I_WOUT] + (size_t)l * 1024 * 1024; t.N = 1024; t.WT = (bf16_t*)(ws + WS_WOUT) + (size_t)l * 1024 * 1024; t.dpitch = 1024; t.dcol0 = 0; t.mode = 0; }
    const int nblk = t.N / 32; t.kb = r / nblk; t.nb = r % nblk; return t;
}
constexpr int N_SMALL_TILES = 2 * (16 * 168 + 8 * 32 + 8 * 32 + 16 * 32);
DI ConvTile expert_tile(const Args& a, int l, int it) {
    unsigned char* ws = a.ws; ConvTile t;
    const int m = it >> 9, r = it & 511, e = m / 3, kind = m % 3; const size_t wo = ((size_t)l * NE + e) * 1024 * 1024;
    t.N = 1024; t.dpitch = 1024; t.dcol0 = 0; t.kb = r >> 5; t.nb = r & 31;
    const long long d1 = (const char*)a.in[I_WEU] - (const char*)a.in[I_WEG], d2 = (const char*)a.in[I_WED] - (const char*)a.in[I_WEG];
    const long long dsel = kind == 0 ? 0ll : (kind == 1 ? d1 : d2);
    t.W = (const float*)((const char*)a.in[I_WEG] + dsel) + wo;
    t.WT = kind == 2 ? (bf16_t*)(ws + ws_wdn(l)) + (size_t)e * 1024 * 1024 : (bf16_t*)(ws + ws_wgu(l)) + (size_t)e * 2048 * 1024;
    t.mode = kind == 0 ? 2 : (kind == 1 ? 3 : 0);
    return t;
}
constexpr int N_EXPERT_TILES = NE * 3 * 512;
template <class F> DI void convert_loop(int ntiles, int gw, int NGW, int lane, F&& get) {
    for (int it = gw; it < ntiles; it += 2 * NGW) {
        const ConvTile t0 = get(it); const bool two = it + NGW < ntiles; const ConvTile t1 = get(two ? it + NGW : it);
        f32x4 x0[8], x1[8];
        tile_load(t0, lane, x0); if (two) tile_load(t1, lane, x1);
        tile_store(t0, lane, x0); if (two) tile_store(t1, lane, x1);
    }
}
constexpr int CTR_WORD0 = 8192, CTR_STRIDE = 64;
DI void convert_pull(const Args& a, int l, int lane, const unsigned* done = nullptr, unsigned G = 0u) {
    unsigned* ctr = (unsigned*)(a.ws + WS_BAR) + CTR_WORD0 + l * CTR_STRIDE;
    for (;;) {
        if (done) { unsigned d = 0u; if (lane == 0) d = __hip_atomic_load(done, __ATOMIC_RELAXED, __HIP_MEMORY_SCOPE_AGENT); if ((unsigned)__builtin_amdgcn_readfirstlane((int)d) >= G) break; }
        unsigned itu = 0u; if (lane == 0) itu = __hip_atomic_fetch_add(ctr, 16u, __ATOMIC_RELAXED, __HIP_MEMORY_SCOPE_AGENT);
        const int it0 = __builtin_amdgcn_readfirstlane((int)itu);
        if (it0 >= N_EXPERT_TILES) break;
#pragma unroll 1
        for (int it = it0; it < it0 + 16; it += 2) {
            const ConvTile t0 = expert_tile(a, l, it), t1 = expert_tile(a, l, it + 1);
            f32x4 x0[8], x1[8];
            tile_load(t0, lane, x0); tile_load(t1, lane, x1);
            tile_store(t0, lane, x0); tile_store(t1, lane, x1);
        }
    }
}
DI void convert_small(const Args& a, int gw, int NGW, int lane) { convert_loop(N_SMALL_TILES, gw, NGW, lane, [&](int it) __attribute__((always_inline)) { return small_tile(a, it); }); }
DI void convert_experts(const Args& a, int l, int gw, int NGW, int lane) { convert_loop(N_EXPERT_TILES, gw, NGW, lane, [&](int it) __attribute__((always_inline)) { return expert_tile(a, l, it); }); }
DI void mod_item(const Args& a, LAS unsigned char* lds, int item) {
    const int tid = threadIdx.x, l = item / 96, cb = item % 96;
    LAS float* sc = (LAS float*)lds; LAS float* red = (LAS float*)(lds + 20480);
    for (int idx = tid; idx < 5120; idx += 512) { const int r = idx >> 10, k = idx & 1023; const float v = r < 4 ? a.in[I_C][r * 1024 + k] : a.in[I_CCTX][k]; sc[idx] = v / (1.f + expf(-v)); }
    __syncthreads();
    const int c4 = tid & 15, kg = tid >> 4; const float* w = a.in[I_WMOD] + (size_t)l * 1024 * 6144 + cb * 64 + c4 * 4 + (size_t)(kg * 32) * 6144;
    f32x4 acc[5];
#pragma unroll
    for (int r = 0; r < 5; ++r) acc[r] = (f32x4){0.f, 0.f, 0.f, 0.f};
#pragma unroll
    for (int k8 = 0; k8 < 32; k8 += 8) { f32x4 wv[8];
#pragma unroll
        for (int i = 0; i < 8; ++i) wv[i] = __builtin_nontemporal_load((const f32x4*)(w + (size_t)(k8 + i) * 6144));
#pragma unroll
        for (int i = 0; i < 8; ++i)
#pragma unroll
            for (int r = 0; r < 5; ++r) acc[r] = acc[r] + sc[r * 1024 + kg * 32 + k8 + i] * wv[i]; }
#pragma unroll
    for (int r = 0; r < 5; ++r) *(LAS f32x4*)(red + (kg * 5 + r) * 64 + c4 * 4) = acc[r];
    __syncthreads();
    if (tid < 320) { const int r = tid >> 6, col = tid & 63; float s = a.in[I_BMOD][l * 6144 + cb * 64 + col];
#pragma unroll 8
        for (int g = 0; g < 32; ++g) s += red[(g * 5 + r) * 64 + col];
        ((float*)(a.ws + WS_MOD))[(size_t)(l * 5 + r) * 6144 + cb * 64 + col] = s; }
    __syncthreads();
}
DI void rope_item(const Args& a) {
    float* rp = (float*)(a.ws + WS_ROPE);
    for (int idx = threadIdx.x; idx < 1024; idx += 512) { const int p = idx >> 4, i = idx & 15; const float fr = powf(10000.f, -(float)i / 16.f); const float ang = (float)p * fr; rp[idx] = cosf(ang); rp[1024 + idx] = sinf(ang); }
}
DI void fold_item(const Args& a, LAS unsigned char* lds, int item) {
    const int tid = threadIdx.x; const int nh = item & 1, kb = (item >> 1) & 15, gi = (item >> 5) & 3, l = item >> 7;
    LAS float* wp = (LAS float*)lds; LAS float* psv = (LAS float*)(lds + 4096);
    for (int idx = tid; idx < 1024; idx += 512) wp[idx] = a.in[I_WPOOL][(((size_t)l * 4 + gi) * 128 + kb * 8 + (idx >> 7)) * 128 + (idx & 127)];
    if (tid < 128) psv[tid] = a.in[I_PSCALE][l * 512 + gi * 128 + tid];
    __syncthreads();
    const int n = nh * 512 + tid; const float* wo = a.in[I_WPO] + ((size_t)l * 512 + gi * 128) * 1024 + n;
    float acc[8] = {0.f, 0.f, 0.f, 0.f, 0.f, 0.f, 0.f, 0.f};
#pragma unroll 16
    for (int j = 0; j < 128; ++j) { const float v = wo[(size_t)j * 1024] * psv[j];
#pragma unroll
        for (int kk = 0; kk < 8; ++kk) acc[kk] += wp[kk * 128 + j] * v; }
    u32x4 o; o.x = pk_bf16(acc[0], acc[1]); o.y = pk_bf16(acc[2], acc[3]); o.z = pk_bf16(acc[4], acc[5]); o.w = pk_bf16(acc[6], acc[7]);
    *(u32x4*)((bf16_t*)(a.ws + WS_WMERGE) + ((size_t)l * 1024 + n) * 1536 + 1024 + gi * 128 + kb * 8) = o;
    __syncthreads();
}
DI void phase_prep(const Args& a, LAS unsigned char* lds, int G, int c) {
    constexpr int NBI = 192 + 1 + 256;
    for (int it = c; it < NBI; it += G) { if (it < 192) mod_item(a, lds, it); else if (it == 192) rope_item(a); else fold_item(a, lds, it - 193); }
    __syncthreads();
    const int wid = __builtin_amdgcn_readfirstlane(threadIdx.x >> 6), lane = threadIdx.x & 63;
    convert_small(a, c * 8 + wid, G * 8, lane);
}

template <int MODE> DI void norm_phase(const Args& a, int l, LAS unsigned char* lds, int G, int c) {
    const int tid = threadIdx.x, wid = __builtin_amdgcn_readfirstlane(tid >> 6), lane = tid & 63;
    unsigned char* ws = a.ws;
    float* X = (float*)(ws + WS_X); bf16_t* H = (bf16_t*)(ws + WS_H); const float* MOD = (const float*)(ws + WS_MOD);
    float* AFF = (float*)(ws + WS_AFF); const int* SLOTOF = (const int*)(ws + WS_SLOTOF); const bf16_t* Y = (const bf16_t*)(ws + WS_Y);
    LAS float* wr_l = (LAS float*)lds;
    constexpr int WRP = 1028;
    if (MODE == 2) {
        const f32x4* wsrc = (const f32x4*)(a.in[I_WR] + (size_t)l * 16384); f32x4 wv[8];
#pragma unroll
        for (int i = 0; i < 8; ++i) wv[i] = wsrc[tid + 512 * i];
#pragma unroll
        for (int i = 0; i < 8; ++i) { const int q = tid + 512 * i, k = q >> 2, e0 = (q & 3) * 4;
            wr_l[(e0 + 0) * WRP + k] = wv[i].x; wr_l[(e0 + 1) * WRP + k] = wv[i].y; wr_l[(e0 + 2) * WRP + k] = wv[i].z; wr_l[(e0 + 3) * WRP + k] = wv[i].w; }
        __syncthreads(); }
    constexpr bool COMB = (MODE == 1 || MODE == 3);
    const int nrows = (MODE == 3) ? TL : TT; const int rpb = (nrows + G - 1) / G; const int r0 = c * rpb; const int r1 = (r0 + rpb) < nrows ? (r0 + rpb) : nrows;
    f32x4 vn[2][4]; u32x2 dln[2][4]; int son[2] = {-1, -1}; float afn[2] = {0.f, 0.f};
    auto load_pair = [&](int base) __attribute__((always_inline)) {
#pragma unroll
        for (int r = 0; r < 2; ++r) { const int row = (base + r < r1) ? base + r : base;
            const float* src = (MODE == 0 || MODE == 1) ? (row < TL ? a.in[I_X] + (size_t)row * DM : a.in[I_CTX] + (size_t)(row - TL) * DM) : X + (size_t)row * DM;
#pragma unroll
            for (int j = 0; j < 4; ++j) vn[r][j] = *(const f32x4*)(src + 256 * j + 4 * lane);
            if (COMB) {
#pragma unroll
                for (int j = 0; j < 4; ++j) dln[r][j] = *(const u32x2*)((const bf16_t*)(ws + WS_DELTA) + (size_t)row * DM + 256 * j + 4 * lane); }
            if (COMB) { son[r] = lane < 16 ? SLOTOF[(size_t)row * 16 + lane] : -1; afn[r] = lane < 16 ? AFF[(size_t)row * 16 + lane] : 0.f; } }
    };
    constexpr bool PREF = (MODE != 2);
    f32x4 gsc[4], shf[4], g2c[4], fng[4]; int mr_c = -1;
    if (MODE == 3) {
#pragma unroll
        for (int j = 0; j < 4; ++j) fng[j] = *(const f32x4*)(a.in[I_FNG] + 256 * j + 4 * lane); }
    if (PREF && r0 + 2 * wid < r1) load_pair(r0 + 2 * wid);
    for (int base = r0 + 2 * wid; base < r1; base += 16) {
        const bool two = base + 1 < r1;
        if (!PREF) load_pair(base);
        f32x4 v[2][4]; int so[2]; float af[2]; int mr[2];
#pragma unroll
        for (int r = 0; r < 2; ++r) { const int row = (r == 1 && !two) ? base : base + r; mr[r] = row < TL ? (row >> 12) : 4; so[r] = son[r]; af[r] = afn[r];
#pragma unroll
            for (int j = 0; j < 4; ++j) { v[r][j] = vn[r][j]; if (COMB) v[r][j] = v[r][j] + (f32x4){bf_lo(dln[r][j].x), bf_hi(dln[r][j].x), bf_lo(dln[r][j].y), bf_hi(dln[r][j].y)}; } }
        if (PREF && base + 16 < r1) load_pair(base + 16);
        if (mr[0] != mr_c) { mr_c = mr[0];
            if (MODE != 3) { const float* gvv = (MODE == 2 ? a.in[I_N2G] : a.in[I_N1G]) + (size_t)l * DM; const float* mb = MOD + (size_t)(l * 5 + mr_c) * 6144 + (MODE == 2 ? 3072 : 0);
#pragma unroll
                for (int j = 0; j < 4; ++j) { const int k = 256 * j + 4 * lane; gsc[j] = *(const f32x4*)(gvv + k) * (1.f + *(const f32x4*)(mb + 1024 + k)); shf[j] = *(const f32x4*)(mb + k); } }
            if (COMB) { const float* g2p = MOD + (size_t)(((MODE == 1) ? 0 : 1) * 5 + mr_c) * 6144 + 5120;
#pragma unroll
                for (int j = 0; j < 4; ++j) g2c[j] = *(const f32x4*)(g2p + 256 * j + 4 * lane); } }
        if (COMB) {
            const int lp = (MODE == 1) ? 0 : 1;
            f32x4 cacc[2][4]; unsigned mask[2];
            int s1[2], s2[2]; float w1[2], w2[2];
#pragma unroll
            for (int r = 0; r < 2; ++r) {
#pragma unroll
                for (int j = 0; j < 4; ++j) cacc[r][j] = (f32x4){0.f, 0.f, 0.f, 0.f};
                mask[r] = (r == 0 || two) ? ((unsigned)__ballot(so[r] >= 0) & 0xffffu) : 0u;
                const bool h1 = mask[r] != 0u; const int e1 = h1 ? __builtin_ctz(mask[r]) : 0; if (h1) mask[r] &= mask[r] - 1;
                const bool h2 = mask[r] != 0u; const int e2 = h2 ? __builtin_ctz(mask[r]) : e1; if (h2) mask[r] &= mask[r] - 1;
                const int t1 = __builtin_amdgcn_readlane(so[r], e1), t2 = __builtin_amdgcn_readlane(so[r], e2);
                s1[r] = h1 ? t1 : 0; s2[r] = h2 ? t2 : s1[r];
                w1[r] = h1 ? __uint_as_float(__builtin_amdgcn_readlane(__float_as_uint(af[r]), e1)) : 0.f;
                w2[r] = h2 ? __uint_as_float(__builtin_amdgcn_readlane(__float_as_uint(af[r]), e2)) : 0.f; }
            { u32x2 ya[2][4], yb[2][4];
#pragma unroll
              for (int r = 0; r < 2; ++r)
#pragma unroll
                for (int j = 0; j < 4; ++j) { ya[r][j] = *(const u32x2*)(Y + (size_t)s1[r] * 1024 + 4 * lane + 256 * j); yb[r][j] = *(const u32x2*)(Y + (size_t)s2[r] * 1024 + 4 * lane + 256 * j); }
#pragma unroll
              for (int r = 0; r < 2; ++r)
#pragma unroll
                for (int j = 0; j < 4; ++j) cacc[r][j] = cacc[r][j] + w1[r] * (f32x4){bf_lo(ya[r][j].x), bf_hi(ya[r][j].x), bf_lo(ya[r][j].y), bf_hi(ya[r][j].y)} + w2[r] * (f32x4){bf_lo(yb[r][j].x), bf_hi(yb[r][j].x), bf_lo(yb[r][j].y), bf_hi(yb[r][j].y)}; }
#pragma unroll
            for (int r = 0; r < 2; ++r) if (r == 0 || two) { const int row = base + r;
                unsigned mk = mask[r];
                while (mk) {
                    const int e1 = __builtin_ctz(mk); mk &= mk - 1;
                    const int t1 = __builtin_amdgcn_readlane(so[r], e1); const float ww = __uint_as_float(__builtin_amdgcn_readlane(__float_as_uint(af[r]), e1));
                    const bf16_t* y1 = Y + (size_t)t1 * 1024 + 4 * lane;
#pragma unroll
                    for (int j = 0; j < 4; ++j) { const u32x2 yv = *(const u32x2*)(y1 + 256 * j); cacc[r][j] = cacc[r][j] + ww * (f32x4){bf_lo(yv.x), bf_hi(yv.x), bf_lo(yv.y), bf_hi(yv.y)}; }
                }
                if (mr[r] == mr_c) {
#pragma unroll
                    for (int j = 0; j < 4; ++j) v[r][j] = v[r][j] + g2c[j] * cacc[r][j];
                } else { const float* g2 = MOD + (size_t)(lp * 5 + mr[r]) * 6144 + 5120;
#pragma unroll
                    for (int j = 0; j < 4; ++j) v[r][j] = v[r][j] + *(const f32x4*)(g2 + 256 * j + 4 * lane) * cacc[r][j]; }
                if (MODE == 1) {
#pragma unroll
                    for (int j = 0; j < 4; ++j) *(f32x4*)(X + (size_t)row * DM + 256 * j + 4 * lane) = v[r][j];
                }
            }
        }
        float rms[2];
#pragma unroll
        for (int r = 0; r < 2; ++r) { float ss = 0.f;
#pragma unroll
            for (int j = 0; j < 4; ++j) ss += (v[r][j].x * v[r][j].x + v[r][j].y * v[r][j].y) + (v[r][j].z * v[r][j].z + v[r][j].w * v[r][j].w);
            rms[r] = 1.0f / sqrtf(wave_sum(ss) * (1.f / DM) + 1e-6f); }
        if (MODE == 3) {
#pragma unroll
            for (int r = 0; r < 2; ++r) if (r == 0 || two) {
#pragma unroll
                for (int j = 0; j < 4; ++j) *(f32x4*)(a.out + (size_t)(base + r) * DM + 256 * j + 4 * lane) = v[r][j] * rms[r] * fng[j]; }
        } else {
            const float* gv = (MODE == 2 ? a.in[I_N2G] : a.in[I_N1G]) + (size_t)l * DM;
#pragma unroll
            for (int r = 0; r < 2; ++r) {
                if (mr[r] == mr_c) {
#pragma unroll
                    for (int j = 0; j < 4; ++j) v[r][j] = (v[r][j] * rms[r]) * gsc[j] + shf[j];
                } else { const float* mb = MOD + (size_t)(l * 5 + mr[r]) * 6144 + (MODE == 2 ? 3072 : 0);
#pragma unroll
                    for (int j = 0; j < 4; ++j) { const int k = 256 * j + 4 * lane; v[r][j] = (v[r][j] * rms[r] * *(const f32x4*)(gv + k)) * (1.f + *(const f32x4*)(mb + 1024 + k)) + *(const f32x4*)(mb + k); } }
#pragma unroll
                for (int j = 0; j < 4; ++j) if (r == 0 || two) st_bf4(H + (size_t)(base + r) * DM + 256 * j + 4 * lane, v[r][j]); }
            if (MODE == 2) {
                float lg[2][16];
#pragma unroll
                for (int e = 0; e < 16; ++e) { float s0 = 0.f, s1 = 0.f;
#pragma unroll
                    for (int j = 0; j < 4; ++j) { const f32x4 w4 = *(const LAS f32x4*)(wr_l + e * WRP + 256 * j + 4 * lane);
                        s0 += (v[0][j].x * w4.x + v[0][j].y * w4.y) + (v[0][j].z * w4.z + v[0][j].w * w4.w);
                        s1 += (v[1][j].x * w4.x + v[1][j].y * w4.y) + (v[1][j].z * w4.z + v[1][j].w * w4.w); }
                    if (e & 1) asm volatile("" : "+v"(s0), "+v"(s1) :: "memory");
                    lg[0][e] = s0; lg[1][e] = s1; }
#pragma unroll
                for (int r = 0; r < 2; ++r) {
                    float a8[8], a4[4], a2[2], a1;
                    const bool b0 = lane & 1, b1 = lane & 2, b2 = lane & 4, b3 = lane & 8;
#pragma unroll
                    for (int i = 0; i < 8; ++i) { const float snd = b0 ? lg[r][i] : lg[r][i + 8], kp = b0 ? lg[r][i + 8] : lg[r][i]; a8[i] = kp + __shfl_xor(snd, 1); }
#pragma unroll
                    for (int i = 0; i < 4; ++i) { const float snd = b1 ? a8[i] : a8[i + 4], kp = b1 ? a8[i + 4] : a8[i]; a4[i] = kp + __shfl_xor(snd, 2); }
#pragma unroll
                    for (int i = 0; i < 2; ++i) { const float snd = b2 ? a4[i] : a4[i + 2], kp = b2 ? a4[i + 2] : a4[i]; a2[i] = kp + __shfl_xor(snd, 4); }
                    { const float snd = b3 ? a2[0] : a2[1], kp = b3 ? a2[1] : a2[0]; a1 = kp + __shfl_xor(snd, 8); }
                    a1 += __shfl_xor(a1, 16); a1 += __shfl_xor(a1, 32);
                    float mx = a1;
#pragma unroll
                    for (int o = 1; o < 16; o <<= 1) mx = fmaxf(mx, __shfl_xor(mx, o));
                    const float ex = expf(a1 - mx); float sum = ex;
#pragma unroll
                    for (int o = 1; o < 16; o <<= 1) sum += __shfl_xor(sum, o);
                    const int e = (b0 ? 8 : 0) + (b1 ? 4 : 0) + (b2 ? 2 : 0) + (b3 ? 1 : 0);
                    if (lane < 16 && (r == 0 || two)) AFF[(size_t)(base + r) * 16 + e] = ex / sum;
                }
            }
        }
    }
    __syncthreads();
}

DI void norm2_phase(const Args& a, int l, LAS unsigned char* lds, int G, int c) {
    const int tid = threadIdx.x, wid = __builtin_amdgcn_readfirstlane(tid >> 6), lane = tid & 63;
    unsigned char* ws = a.ws;
    const float* X = (const float*)(ws + WS_X); bf16_t* H = (bf16_t*)(ws + WS_H); const float* MOD = (const float*)(ws + WS_MOD); float* AFF = (float*)(ws + WS_AFF);
    const bf16_t* DL = (const bf16_t*)(ws + WS_DELTA);
    auto xrow = [&](int row) __attribute__((always_inline)) -> const float* { return l == 0 ? (row < TL ? a.in[I_X] + (size_t)row * DM : a.in[I_CTX] + (size_t)(row - TL) * DM) : X + (size_t)row * DM; };
    LAS float* wr_l = (LAS float*)lds;
    constexpr int WRP = 1028;
    { const f32x4* wsrc = (const f32x4*)(a.in[I_WR] + (size_t)l * 16384); f32x4 wv[8];
#pragma unroll
      for (int i = 0; i < 8; ++i) wv[i] = wsrc[tid + 512 * i];
#pragma unroll
      for (int i = 0; i < 8; ++i) { const int q = tid + 512 * i, k = q >> 2, e0 = (q & 3) * 4;
          wr_l[(e0 + 0) * WRP + k] = wv[i].x; wr_l[(e0 + 1) * WRP + k] = wv[i].y; wr_l[(e0 + 2) * WRP + k] = wv[i].z; wr_l[(e0 + 3) * WRP + k] = wv[i].w; }
      __syncthreads(); }
    const int rpb = (TT + G - 1) / G; const int r0 = c * rpb; const int r1 = (r0 + rpb) < TT ? (r0 + rpb) : TT;
    const float* gv = a.in[I_N2G] + (size_t)l * DM;
    f32x4 gsc[4], shf[4]; int mr_c = -1;
    f32x4 vn[4]; u32x2 dn[4];
    if (r0 + wid < r1) { const float* xr = xrow(r0 + wid);
#pragma unroll
        for (int j = 0; j < 4; ++j) { vn[j] = *(const f32x4*)(xr + 256 * j + 4 * lane); dn[j] = *(const u32x2*)(DL + (size_t)(r0 + wid) * DM + 256 * j + 4 * lane); } }
    for (int row = r0 + wid; row < r1; row += 8) {
        f32x4 v[4];
#pragma unroll
        for (int j = 0; j < 4; ++j) v[j] = vn[j] + (f32x4){bf_lo(dn[j].x), bf_hi(dn[j].x), bf_lo(dn[j].y), bf_hi(dn[j].y)};
        if (row + 8 < r1) { const float* xr = xrow(row + 8);
#pragma unroll
            for (int j = 0; j < 4; ++j) { vn[j] = *(const f32x4*)(xr + 256 * j + 4 * lane); dn[j] = *(const u32x2*)(DL + (size_t)(row + 8) * DM + 256 * j + 4 * lane); } }
        const int mr = row < TL ? (row >> 12) : 4;
        float ss = 0.f;
#pragma unroll
        for (int j = 0; j < 4; ++j) ss += (v[j].x * v[j].x + v[j].y * v[j].y) + (v[j].z * v[j].z + v[j].w * v[j].w);
        const float rms = 1.0f / sqrtf(wave_sum(ss) * (1.f / DM) + 1e-6f);
        if (mr != mr_c) { mr_c = mr; const float* mb = MOD + (size_t)(l * 5 + mr) * 6144 + 3072;
#pragma unroll
            for (int j = 0; j < 4; ++j) { const int k = 256 * j + 4 * lane; gsc[j] = *(const f32x4*)(gv + k) * (1.f + *(const f32x4*)(mb + 1024 + k)); shf[j] = *(const f32x4*)(mb + k); } }
#pragma unroll
        for (int j = 0; j < 4; ++j) { const int k = 256 * j + 4 * lane;
            v[j] = (v[j] * rms) * gsc[j] + shf[j];
            st_bf4(H + (size_t)row * DM + k, v[j]); }
        float lg[16];
#pragma unroll
        for (int e = 0; e < 16; ++e) { float s0 = 0.f;
#pragma unroll
            for (int j = 0; j < 4; ++j) { const f32x4 w4 = *(const LAS f32x4*)(wr_l + e * WRP + 256 * j + 4 * lane); s0 += (v[j].x * w4.x + v[j].y * w4.y) + (v[j].z * w4.z + v[j].w * w4.w); }
            if ((e & 3) == 3) asm volatile("" : "+v"(s0) :: "memory");
            lg[e] = s0; }
        float a8[8], a4[4], a2[2], a1;
        const bool b0 = lane & 1, b1 = lane & 2, b2 = lane & 4, b3 = lane & 8;
#pragma unroll
        for (int i = 0; i < 8; ++i) { const float snd = b0 ? lg[i] : lg[i + 8], kp = b0 ? lg[i + 8] : lg[i]; a8[i] = kp + __shfl_xor(snd, 1); }
#pragma unroll
        for (int i = 0; i < 4; ++i) { const float snd = b1 ? a8[i] : a8[i + 4], kp = b1 ? a8[i + 4] : a8[i]; a4[i] = kp + __shfl_xor(snd, 2); }
#pragma unroll
        for (int i = 0; i < 2; ++i) { const float snd = b2 ? a4[i] : a4[i + 2], kp = b2 ? a4[i + 2] : a4[i]; a2[i] = kp + __shfl_xor(snd, 4); }
        { const float snd = b3 ? a2[0] : a2[1], kp = b3 ? a2[1] : a2[0]; a1 = kp + __shfl_xor(snd, 8); }
        a1 += __shfl_xor(a1, 16); a1 += __shfl_xor(a1, 32);
        float mx = a1;
#pragma unroll
        for (int o = 1; o < 16; o <<= 1) mx = fmaxf(mx, __shfl_xor(mx, o));
        const float ex = expf(a1 - mx); float sum = ex;
#pragma unroll
        for (int o = 1; o < 16; o <<= 1) sum += __shfl_xor(sum, o);
        const int e = (b0 ? 8 : 0) + (b1 ? 4 : 0) + (b2 ? 2 : 0) + (b3 ? 1 : 0);
        if (lane < 16) AFF[(size_t)row * 16 + e] = ex / sum;
    }
    __syncthreads();
}

constexpr int KPITCH = 144, VPITCH = 272;
constexpr int ATT_K = 0, ATT_V = 128 * KPITCH, ATT_WS = ATT_V + 64 * VPITCH;

DI void attn_seg(int kind, int qb, int tq0, int ctx0, int i, int& tok0, int& mode) {
    mode = 0;
    if (kind == 1) { tok0 = ctx0 + i * 128; return; }
    if (i == 0) tok0 = tq0;
    else if (i < 3) tok0 = ctx0 + (i - 1) * 128;
    else if (i == 3 && qb > 0) { tok0 = tq0 - 128; mode = 1; }
    else { tok0 = tq0 + 128; mode = 2; }
}
DI void attn_unit(const Args& a, int l, LAS unsigned char* lds, int kind, int b, int qb, int kh, int hh) {
    const int tid = threadIdx.x, lane = tid & 63, r32 = lane & 31, hi = lane >> 5; const int wid = __builtin_amdgcn_readfirstlane(tid >> 6);
    unsigned char* ws = a.ws;
    const bf16_t* Q = (const bf16_t*)(ws + WS_Q); const bf16_t* Kb = (const bf16_t*)(ws + WS_K); const bf16_t* VT = (const bf16_t*)(ws + WS_VT); bf16_t* BR = (bf16_t*)(ws + WS_BR);
    const int tq0 = kind == 0 ? b * SEQ + qb * 128 : TL + b * CTXL + qb * 128;
    const int ctx0 = TL + b * CTXL;
    const int h = kh * 4 + hh * 2 + (wid >> 2), qs = (wid & 3) * 32;
    const int qi = qs + r32;
    LAS float* wsf = (LAS float*)(lds + ATT_WS) + wid * 64;
    const int nseg = kind == 0 ? 3 + (qb > 0 ? 1 : 0) + (qb < 31 ? 1 : 0) : 2;
    const int krow = tid >> 3, kch = tid & 7, vrow = tid >> 4, vch = tid & 15;
    u32x4 kreg[2], vreg[2];
    { int tok0, mode; attn_seg(kind, qb, tq0, ctx0, 0, tok0, mode);
#pragma unroll
      for (int i = 0; i < 2; ++i) { kreg[i] = *(const u32x4*)(Kb + (size_t)(tok0 + krow + 64 * i) * 128 + kh * 64 + kch * 8); vreg[i] = *(const u32x4*)(VT + (size_t)(kh * 64 + vrow + 32 * i) * TT + tok0 + vch * 8); } }
    bf16x8 qf[4];
#pragma unroll
    for (int s = 0; s < 4; ++s) qf[s] = *(const bf16x8*)(Q + (size_t)(tq0 + qi) * 512 + h * 64 + s * 16 + hi * 8);
    float mrun = -1e30f, lrun = 0.f;
    f32x16 o[2];
#pragma unroll
    for (int d0 = 0; d0 < 2; ++d0)
#pragma unroll
        for (int r = 0; r < 16; ++r) o[d0][r] = 0.f;
    for (int sg = 0; sg < nseg; ++sg) {
        int tok0, mode; attn_seg(kind, qb, tq0, ctx0, sg, tok0, mode);
        int lo_lim = mode == 1 ? qi : -100000, hi_lim = mode == 2 ? qi : 100000;
        asm volatile("" : "+v"(lo_lim), "+v"(hi_lim));
        __syncthreads();
#pragma unroll
        for (int i = 0; i < 2; ++i) { *(LAS u32x4*)(lds + ATT_K + (krow + 64 * i) * KPITCH + kch * 16) = kreg[i]; *(LAS u32x4*)(lds + ATT_V + (vrow + 32 * i) * VPITCH + vch * 16) = vreg[i]; }
        __syncthreads();
        if (sg + 1 < nseg) { int tn, mn; attn_seg(kind, qb, tq0, ctx0, sg + 1, tn, mn);
#pragma unroll
            for (int i = 0; i < 2; ++i) { kreg[i] = *(const u32x4*)(Kb + (size_t)(tn + krow + 64 * i) * 128 + kh * 64 + kch * 8); vreg[i] = *(const u32x4*)(VT + (size_t)(kh * 64 + vrow + 32 * i) * TT + tn + vch * 8); } }
#pragma unroll 1
        for (int tk = 0; tk < 2; ++tk) {
            if (mode == 1 && tk * 64 + 63 < qs) continue;
            if (mode == 2 && tk * 64 > qs + 31) continue;
            f32x16 s0, s1;
#pragma unroll
            for (int r = 0; r < 16; ++r) { s0[r] = 0.f; s1[r] = 0.f; }
            const LAS unsigned char* kp = lds + ATT_K + (tk * 64 + r32) * KPITCH + hi * 16;
#pragma unroll
            for (int s = 0; s < 4; ++s) {
                const bf16x8 k0 = *(const LAS bf16x8*)(kp + s * 32);
                const bf16x8 k1 = *(const LAS bf16x8*)(kp + 32 * KPITCH + s * 32);
                s0 = __builtin_amdgcn_mfma_f32_32x32x16_bf16(k0, qf[s], s0, 0, 0, 0);
                s1 = __builtin_amdgcn_mfma_f32_32x32x16_bf16(k1, qf[s], s1, 0, 0, 0);
            }
            asm volatile("s_nop 15\n\ts_nop 7" : "+v"(s0), "+v"(s1));
            if (mode != 0) {
                const int kb0 = tk * 64 + 4 * hi;
#pragma unroll
                for (int r = 0; r < 16; ++r) { const int kj = kb0 + (r & 3) + 8 * (r >> 2);
                    if (kj < lo_lim || kj > hi_lim) s0[r] = -1e30f;
                    if (kj + 32 < lo_lim || kj + 32 > hi_lim) s1[r] = -1e30f; }
            }
            float tm = mrun;
            float tm2 = s0[0];
#pragma unroll
            for (int r = 0; r < 16; r += 2) { tm = max3f(tm, s0[r], s1[r]); tm2 = max3f(tm2, s0[r + 1], s1[r + 1]); }
            tm = max3f(tm, tm2, __shfl_xor(max3f(tm, tm2, tm2), 32));
            const float mnew = tm;
            typedef float f32x2 __attribute__((ext_vector_type(2)));
            f32x2 ls2 = {0.f, 0.f}; const f32x2 m2 = {mnew, mnew};
#pragma unroll
            for (int r = 0; r < 16; r += 2) {
                f32x2 a = (f32x2){s0[r], s0[r + 1]} - m2, b = (f32x2){s1[r], s1[r + 1]} - m2;
                a.x = __builtin_amdgcn_exp2f(a.x); a.y = __builtin_amdgcn_exp2f(a.y); b.x = __builtin_amdgcn_exp2f(b.x); b.y = __builtin_amdgcn_exp2f(b.y);
                s0[r] = a.x; s0[r + 1] = a.y; s1[r] = b.x; s1[r + 1] = b.y; ls2 = ls2 + a + b; }
            const float ls = ls2.x + ls2.y;
            if (__any(mnew > mrun)) {
                const float alpha = __builtin_amdgcn_exp2f(mrun - mnew);
                lrun *= alpha;
                if (hi == 0) wsf[r32] = alpha;
#pragma unroll
                for (int r = 0; r < 16; ++r) { const float f = wsf[crow(r, hi)]; o[0][r] *= f; o[1][r] *= f; }
            }
            mrun = mnew; lrun += ls;
            const LAS unsigned char* vp0 = lds + ATT_V + r32 * VPITCH + (tk * 64 + 4 * hi) * 2;
#pragma unroll
            for (int cc = 0; cc < 2; ++cc)
#pragma unroll
                for (int s = 0; s < 2; ++s) {
                    u32x4 pw;
                    if (cc == 0) { pw.x = pk_bf16(s0[8 * s], s0[8 * s + 1]); pw.y = pk_bf16(s0[8 * s + 2], s0[8 * s + 3]); pw.z = pk_bf16(s0[8 * s + 4], s0[8 * s + 5]); pw.w = pk_bf16(s0[8 * s + 6], s0[8 * s + 7]); }
                    else { pw.x = pk_bf16(s1[8 * s], s1[8 * s + 1]); pw.y = pk_bf16(s1[8 * s + 2], s1[8 * s + 3]); pw.z = pk_bf16(s1[8 * s + 4], s1[8 * s + 5]); pw.w = pk_bf16(s1[8 * s + 6], s1[8 * s + 7]); }
                    const bf16x8 pa = __builtin_bit_cast(bf16x8, pw);
#pragma unroll
                    for (int d0 = 0; d0 < 2; ++d0) {
                        const LAS unsigned char* vp = vp0 + d0 * 32 * VPITCH + (cc * 32 + s * 16) * 2;
                        const s16x4 lo = *(const LAS s16x4*)vp, hh2 = *(const LAS s16x4*)(vp + 16);
                        const bf16x8 vb = (bf16x8){lo[0], lo[1], lo[2], lo[3], hh2[0], hh2[1], hh2[2], hh2[3]};
                        o[d0] = __builtin_amdgcn_mfma_f32_32x32x16_bf16(pa, vb, o[d0], 0, 0, 0);
                    }
                }
        }
    }
    const float sk = a.in[I_SINK][l * 8 + h] * LOG2E;
    {
        const float lt = lrun + __shfl_xor(lrun, 32) + __builtin_amdgcn_exp2f(sk - mrun);
        if (hi == 0) wsf[r32] = 1.f / lt;
#pragma unroll
        for (int r = 0; r < 16; ++r) { const float f = wsf[crow(r, hi)]; bf16_t* op = BR + (size_t)(tq0 + qs + crow(r, hi)) * 1536 + h * 64 + r32;
            op[0] = f2bf(o[0][r] * f); op[32] = f2bf(o[1][r] * f); }
    }
    __syncthreads();
}

DI void seq_bounds(int t0, int& lo, int& hi) { if (t0 < TL) { lo = t0 & ~(SEQ - 1); hi = lo + SEQ; } else { lo = TL + ((t0 - TL) & ~(CTXL - 1)); hi = lo + CTXL; } }

DI void conv_unit(const Args& a, int l, LAS unsigned char* lds, int t0) {
    const int tid = threadIdx.x, lane = tid & 63; const int wid = __builtin_amdgcn_readfirstlane(tid >> 6);
    const bf16_t* U = (const bf16_t*)(a.ws + WS_U); bf16_t* BR = (bf16_t*)(a.ws + WS_BR);
    int slo, shi; seq_bounds(t0, slo, shi);
    const int c = tid; float w[31];
#pragma unroll
    for (int k = 0; k < 31; ++k) w[k] = a.in[I_CDW][((size_t)l * 31 + k) * 512 + c];
    const float bias = a.in[I_CDWB][l * 512 + c];
    { u32x4 tv[8];
#pragma unroll
      for (int i = 0; i < 8; ++i) { const int idx = tid + 512 * i; const int row = idx >> 6, ch = idx & 63; const int tok = t0 - 15 + row; tv[i] = (u32x4){0u, 0u, 0u, 0u};
          if (row < 62 && tok >= slo && tok < shi) tv[i] = *(const u32x4*)(U + (size_t)tok * 512 + ch * 8); }
#pragma unroll
      for (int i = 0; i < 8; ++i) { const int idx = tid + 512 * i; const int row = idx >> 6, ch = idx & 63; if (row < 62) *(LAS u32x4*)(lds + row * 1024 + ch * 16) = tv[i]; } }
    __syncthreads();
    float xin[62];
#pragma unroll
    for (int i = 0; i < 62; ++i) xin[i] = bf2f(((const LAS bf16_t*)lds)[i * 512 + c]);
    LAS float* cs = (LAS float*)(lds + 65536);
#pragma unroll
    for (int t = 0; t < 32; ++t) { float acc = bias;
#pragma unroll
        for (int k = 0; k < 31; ++k) acc = fmaf(xin[t + k], w[k], acc);
        cs[t * 512 + c] = acc; }
    __syncthreads();
    const float* lg = a.in[I_CLNG] + l * 512; const float* lb = a.in[I_CLNB] + l * 512;
#pragma unroll
    for (int tt = 0; tt < 4; ++tt) { const int t = 4 * wid + tt; float v[8]; float s = 0.f;
#pragma unroll
        for (int i = 0; i < 8; ++i) { v[i] = cs[t * 512 + lane + 64 * i]; s += v[i]; }
        const float mean = wave_sum(s) * (1.f / 512.f); float q = 0.f;
#pragma unroll
        for (int i = 0; i < 8; ++i) { v[i] -= mean; q += v[i] * v[i]; }
        const float rstd = 1.0f / sqrtf(wave_sum(q) * (1.f / 512.f) + 1e-6f);
#pragma unroll
        for (int i = 0; i < 8; ++i) { const int c2 = lane + 64 * i; const float y = v[i] * rstd * lg[c2] + lb[c2]; BR[(size_t)(t0 + t) * 1536 + 512 + c2] = f2bf(y * sigm(y)); } }
    __syncthreads();
}
template <int HALF> DI void pool_compute(const LAS bf16_t* zs, int c, int t0, int slo, int shi, bf16_t* BR) {
    float P[49];
    float zc[32];
    P[0] = 0.f;
#pragma unroll
    for (int r = 0; r < 48; ++r) { const float z = bf2f(zs[r * 512 + c]); P[r + 1] = P[r] + z; if (r >= 8 && r < 40) zc[r - 8] = z; }
#pragma unroll
    for (int t = 0; t < 32; ++t) { const int tt = t0 + t; const int lo = (tt - HALF) > slo ? (tt - HALF) : slo, hi = (tt + HALF) < shi ? (tt + HALF) : shi;
        const float d = (P[t + 8 + HALF] - P[t + 8 - HALF]) * __builtin_amdgcn_rcpf((float)(hi - lo)) - zc[t];
        BR[(size_t)tt * 1536 + 1024 + c] = f2bf(d); }
}
DI void pool_unit(const Args& a, LAS unsigned char* lds, int t0) {
    const int tid = threadIdx.x;
    const bf16_t* Z = (const bf16_t*)(a.ws + WS_Z); bf16_t* BR = (bf16_t*)(a.ws + WS_BR);
    int slo, shi; seq_bounds(t0, slo, shi);
    { u32x4 tv[6];
#pragma unroll
      for (int i = 0; i < 6; ++i) { const int idx = tid + 512 * i; const int row = idx >> 6, ch = idx & 63; const int tok = t0 - 8 + row; tv[i] = (u32x4){0u, 0u, 0u, 0u};
          if (tok >= slo && tok < shi) tv[i] = *(const u32x4*)(Z + (size_t)tok * 512 + ch * 8); }
#pragma unroll
      for (int i = 0; i < 6; ++i) { const int idx = tid + 512 * i; const int row = idx >> 6, ch = idx & 63; *(LAS u32x4*)(lds + row * 1024 + ch * 16) = tv[i]; } }
    __syncthreads();
    const int c = tid; const int gi = __builtin_amdgcn_readfirstlane(c >> 7); const LAS bf16_t* zs = (const LAS bf16_t*)lds;
    if (gi == 0) pool_compute<1>(zs, c, t0, slo, shi, BR); else if (gi == 1) pool_compute<2>(zs, c, t0, slo, shi, BR);
    else if (gi == 2) pool_compute<4>(zs, c, t0, slo, shi, BR); else pool_compute<8>(zs, c, t0, slo, shi, BR);
    __syncthreads();
}
DI void phase_mix(const Args& a, int l, LAS unsigned char* lds, int G, int c, const SchedInProj& SI, const EpiInProj& EI) {
    for (int u = c; u < 512; u += G) attn_unit(a, l, lds, 0, u >> 7, (u >> 2) & 31, (u >> 1) & 1, u & 1);
    const int ng = (SI.hi - SI.lo) < G ? (SI.hi - SI.lo) : G;
    const int nconv = l == 0 ? TT / 32 : TL / 32;
    const bool gblk = c < ng; const int nrest = G - ng;
    const int sg = nrest > 0 ? (l == 0 ? 130 : 40) : 256;
    const int ncg = ng > 0 ? (nconv * sg) >> 8 : 0;
    const int jb = gblk ? 0 : ncg, j1 = gblk ? ncg : nconv, js = gblk ? ng : nrest, ci = gblk ? c : c - ng;
    for (int j = jb + ci; j < j1; j += js) conv_unit(a, l, lds, j * 32);
    for (int j = jb + (js - 1 - ci); j < j1; j += js) pool_unit(a, lds, j * 32);
    if (l == 0) { const int x0 = nrest >= 32 ? c - ng : c;
        if (x0 >= 0) for (int x = x0; x < 32; x += (nrest >= 32 ? nrest : G)) attn_unit(a, l, lds, 1, x >> 3, (x >> 2) & 1, (x >> 1) & 1, x & 1); }
    if (ng > 0) pg8::gemm_phase(lds, SI, EI);
}

DI void topk_unit(const Args& a, LAS unsigned char* lds, int set, int e) {
    const int tid = threadIdx.x, lane = tid & 63, wid = tid >> 6; const bool lat = set < 4; const int b = set & 3;
    const int N = lat ? SEQ : CTXL, cap = N / 8, tok0 = lat ? b * SEQ : TL + b * CTXL, sbase = e * ESLOT + (lat ? b * 512 : 2048 + b * 32);
    const float* AFF = (const float*)(a.ws + WS_AFF); int* SLOTOF = (int*)(a.ws + WS_SLOTOF); int* TOKOF = (int*)(a.ws + WS_TOKOF);
    LAS unsigned* hist = (LAS unsigned*)lds; LAS unsigned* wtot = hist + 256; LAS unsigned* bc = hist + 272;
    int nvalid = N - tid * 8; nvalid = nvalid < 0 ? 0 : (nvalid > 8 ? 8 : nvalid);
    unsigned v[8];
#pragma unroll
    for (int j = 0; j < 8; ++j) v[j] = j < nvalid ? __float_as_uint(AFF[(size_t)(tok0 + tid * 8 + j) * 16 + e]) : 0u;
    unsigned prefix = 0u, pmask = 0u; unsigned need = (unsigned)cap;
#pragma unroll 1
    for (int r = 0; r < 4; ++r) {
        const int shift = 24 - 8 * r;
        if (tid < 256) hist[tid] = 0u;
        __syncthreads();
#pragma unroll
        for (int j = 0; j < 8; ++j) if (j < nvalid && (v[j] & pmask) == prefix) __hip_atomic_fetch_add(&hist[(v[j] >> shift) & 255u], 1u, __ATOMIC_RELAXED, __HIP_MEMORY_SCOPE_WORKGROUP);
        __syncthreads();
        unsigned hv = 0u, suf = 0u;
        if (tid < 256) { hv = hist[tid]; suf = hv;
#pragma unroll
            for (int o = 1; o < 64; o <<= 1) { const unsigned t = __shfl_down(suf, o); if (lane + o < 64) suf += t; }
            if (lane == 0) wtot[wid] = suf; }
        __syncthreads();
        if (tid < 256) { unsigned above = 0u; for (int w = wid + 1; w < 4; ++w) above += wtot[w];
            suf += above; const unsigned sn = suf - hv;
            if (suf >= need && sn < need) { bc[0] = (unsigned)tid; bc[1] = need - sn; } }
        __syncthreads();
        prefix |= bc[0] << shift; pmask |= 255u << shift; need = bc[1];
    }
    const unsigned T = prefix, need_eq = need, count_gt = (unsigned)cap - need_eq;
    unsigned cg = 0u, ce = 0u;
#pragma unroll
    for (int j = 0; j < 8; ++j) if (j < nvalid) { cg += v[j] > T ? 1u : 0u; ce += v[j] == T ? 1u : 0u; }
    const unsigned pk = cg | (ce << 16); unsigned inc = pk;
#pragma unroll
    for (int o = 1; o < 64; o <<= 1) { const unsigned t = __shfl_up(inc, o); if (lane >= o) inc += t; }
    if (lane == 63) wtot[wid] = inc;
    __syncthreads();
    unsigned basev = 0u; for (int w = 0; w < wid; ++w) basev += wtot[w];
    const unsigned ex = basev + inc - pk; unsigned rg = ex & 0xffffu, re = ex >> 16;
#pragma unroll
    for (int j = 0; j < 8; ++j) if (j < nvalid) { const int tok = tok0 + tid * 8 + j; int slot = -1;
        if (v[j] > T) { slot = sbase + (int)rg; ++rg; } else if (v[j] == T) { if (re < need_eq) slot = sbase + (int)(count_gt + re); ++re; }
        SLOTOF[(size_t)tok * 16 + e] = slot; if (slot >= 0) TOKOF[slot] = tok; }
    if (set == 4 && tid < 128) TOKOF[e * ESLOT + 2176 + tid] = 0;
    __syncthreads();
}

#define XB_TMO      128
#define XB_XCNT(j)  (256  + 64 * (j))
#define XB_XSUB(j)  (1280 + 64 * (j))
#define XB_XGEN(j)  (2304 + 64 * (j))
#define XB_TOP      3328
#define XB_TOPGEN   3392
#define XCD_BAR_WORDS 3456
#define XB_SPIN_CAP (1u << 22)
DI unsigned xb_ld(unsigned* p) { return __hip_atomic_load(p, __ATOMIC_RELAXED, __HIP_MEMORY_SCOPE_AGENT); }
DI unsigned xb_add(unsigned* p, unsigned v) { return __hip_atomic_fetch_add(p, v, __ATOMIC_RELAXED, __HIP_MEMORY_SCOPE_AGENT); }
DI unsigned xb_xcc_id() { return (unsigned)__builtin_amdgcn_s_getreg((3 << 11) | 20) & 0xFu; }
#define XB_SPIN(cond, bar) do { unsigned _sp = 0; while (cond) { __builtin_amdgcn_s_sleep(1); \
    if ((++_sp & 255u) == 0u) { if (xb_ld(&(bar)[XB_TMO])) break; if (_sp > XB_SPIN_CAP) { atomicAdd(&(bar)[XB_TMO], 1u); break; } } } } while (0)
struct XcdBarrier { unsigned* bar; unsigned x; volatile LAS unsigned* st; };
DI XcdBarrier xcd_barrier_post(unsigned* bar, volatile LAS unsigned* st) {
    XcdBarrier b; b.bar = bar; b.x = xb_xcc_id(); b.st = st;
    if (threadIdx.x == 0) (void)xb_add(&bar[XB_XCNT(b.x)], 1u);
    return b;
}
DI void xcd_barrier_complete(unsigned* bar, unsigned x, unsigned& nloc, unsigned& nx) {
    const unsigned G = gridDim.x * gridDim.y * gridDim.z;
    unsigned sum, cnt, mine, sp = 0u;
    for (;;) {
        sum = 0u; cnt = 0u; mine = 0u;
#pragma unroll
        for (unsigned j = 0; j < 16; ++j) { const unsigned c = xb_ld(&bar[XB_XCNT(j)]); sum += c; cnt += (c > 0u) ? 1u : 0u; mine = (j == x) ? c : mine; }
        if (sum == G) break;
        __builtin_amdgcn_s_sleep(1);
        if ((++sp & 255u) == 0u) { if (xb_ld(&bar[XB_TMO])) break; if (sp > XB_SPIN_CAP) { atomicAdd(&bar[XB_TMO], 1u); break; } }
    }
    nloc = mine > 0u ? mine : 1u; nx = cnt > 0u ? cnt : 1u;
}
DI void xcd_barrier(const XcdBarrier& b) {
    asm volatile("s_waitcnt vmcnt(0)" ::: "memory");
    __syncthreads();
    if (threadIdx.x == 0) {
        unsigned* bar = b.bar;
        __builtin_amdgcn_s_waitcnt(0);
        unsigned nloc = b.st[0], nx = b.st[1];
        if (nloc == 0u) { xcd_barrier_complete(bar, b.x, nloc, nx); b.st[0] = nloc; b.st[1] = nx; }
        const unsigned old = xb_add(&bar[XB_XSUB(b.x)], 1u);
        const unsigned gen = old / nloc;
        if (old + 1u == (gen + 1u) * nloc) {
            __builtin_amdgcn_fence(__ATOMIC_RELEASE, "agent");
            asm volatile("s_waitcnt vmcnt(0)" ::: "memory");
            const unsigned og = xb_add(&bar[XB_TOP], 1u);
            const unsigned tg = og / nx;
            if (og + 1u == (tg + 1u) * nx) xb_add(&bar[XB_TOPGEN], 1u);
            else XB_SPIN(xb_ld(&bar[XB_TOPGEN]) == tg, bar);
            __builtin_amdgcn_fence(__ATOMIC_ACQUIRE, "agent");
            xb_add(&bar[XB_XGEN(b.x)], 1u);
            asm volatile("s_waitcnt vmcnt(0)" ::: "memory");
        } else {
            XB_SPIN(xb_ld(&bar[XB_XGEN(b.x)]) == gen, bar);
            __builtin_amdgcn_fence(__ATOMIC_ACQUIRE, "agent");
            asm volatile("s_waitcnt vmcnt(0)" ::: "memory");
        }
    }
    __syncthreads();
}

#if !MK_PER_PHASE
#define GRID_BAR() xcd_barrier(bar)
#else
#define GRID_BAR() do {} while (0)
#endif
#ifndef PROBE_DUP
#define PROBE_DUP 0
#endif
#define REPS(bit) (1 + ((PROBE_DUP >> (bit)) & 1))
#define REP(bit) for (int _r = 0; _r < REPS(bit); ++_r)
#define REPU(bit) _Pragma("unroll") for (int _r = 0; _r < REPS(bit); ++_r)
#define REPBAR() do { if (_r) GRID_BAR(); } while (0)
#define IN(k) (lo <= (k) && (k) < hi)
#ifndef PROBE_SPIN
#define PROBE_SPIN (-1)
#endif
#ifndef PROBE_SPIN_END
#define PROBE_SPIN_END (PROBE_SPIN + 1)
#endif
#ifndef PROBE_MULT
#define PROBE_MULT 4
#endif
#define STAMP(k) do { if (PROBE_SPIN >= 0 && blockIdx.x == 0 && threadIdx.x == 0) ((volatile LAS unsigned long long*)(lds + LDS_MISC_OFF + 256))[k] = __builtin_amdgcn_s_memrealtime(); } while (0)
#define SEAM(k) do { if (lo < (k) && (k) < hi) GRID_BAR(); STAMP(k); } while (0)

template <int L> DI void run_layer(const Args& a, LAS unsigned char* lds, int G, int c, int lo, int hi, const XcdBarrier& bar) {
    unsigned char* ws = a.ws;
    constexpr int l = L, base = 1 + 9 * L, nM = L == 0 ? 68 : 64, nmt = L == 0 ? 9 : 8;
    const int tid = threadIdx.x;
    SEAM(base + 0);
    if (IN(base + 0)) { if (L == 0) { REP(0) { REPBAR(); norm_phase<0>(a, 0, lds, G, c); } } else norm_phase<1>(a, 1, lds, G, c); }
    SEAM(base + 1);
#define MK_INPROJ_SCHED(SI, EI) \
    SchedInProj SI; SI.nt = 16; SI.ldb_b = 2048; SI.lda_b = 2048; SI.G = G; SI.c = c; SI.A = (const char*)(ws + WS_H); SI.B = (const char*)(ws + WS_WIN) + (size_t)l * INW * 2048; \
    SI.init_counts(nM, l == 0 ? 0 : 4); \
    const int np2 = (SI.ntot / G) * G > 0 ? (SI.ntot / G) * G : SI.ntot;      \
    const EpiInProj EI{(bf16_t*)(ws + WS_Q), (bf16_t*)(ws + WS_K), (bf16_t*)(ws + WS_VT), (bf16_t*)(ws + WS_U), (bf16_t*)(ws + WS_Z), (bf16_t*)(ws + WS_G), (const float*)(ws + WS_ROPE)};
    if (IN(base + 1)) REPU(1) { REPBAR();
        MK_INPROJ_SCHED(SI, EI)
        SI.lo = 0; SI.hi = np2;
        pg8::gemm_phase(lds, SI, EI);
    }
    SEAM(base + 2);
    if (IN(base + 2)) REP(2) { REPBAR(); MK_INPROJ_SCHED(SI, EI) SI.lo = np2; SI.hi = SI.ntot; phase_mix(a, l, lds, G, c, SI, EI); }
    SEAM(base + 3);
    if (IN(base + 3)) REP(3) { REPBAR();
        SchedMerge S; S.nt = 24; S.ldb_b = 3072; S.lda_b = 3072; S.G = G; S.c = c; S.A = (const char*)(ws + WS_BR); S.B = (const char*)(ws + WS_WMERGE) + (size_t)l * 1024 * 3072; S.nM = nM;
        EpiMerge E{(const bf16_t*)(ws + WS_G), (bf16_t*)(ws + WS_MERGED)};
        pg8::gemm_phase(lds, S, E);
        if (L == 0) convert_pull(a, 0, tid & 63);
    }
    SEAM(base + 4);
    if (IN(base + 4)) for (int _r = 0; _r < (L == 0 ? REPS(4) : 1); ++_r) { REPBAR();
        SchedOut S; S.nt = 16; S.ldb_b = 2048; S.lda_b = 2048; S.G = G; S.c = c; S.A = (const char*)(ws + WS_MERGED); S.B = (const char*)(ws + WS_WOUT) + (size_t)l * 1024 * 2048; S.nM = nM;
        EpiOut E{(bf16_t*)(ws + WS_DELTA), (const float*)(ws + WS_MOD), l};
        pg8::gemm_phase(lds, S, E);
        if (L == 0) convert_pull(a, 0, tid & 63);
    }
    SEAM(base + 5);
    if (IN(base + 5)) REP(5) { REPBAR(); norm2_phase(a, l, lds, G, c); }
    SEAM(base + 6);
    if (IN(base + 6)) REP(6) { REPBAR();
        const int nu = l == 0 ? 128 : 64;
        for (int u = c; u < nu; u += G) topk_unit(a, lds, u >> 4, u & 15);
        if (l == 1) {
            const int wid = __builtin_amdgcn_readfirstlane(tid >> 6);
            convert_experts(a, 1, c * 8 + wid, G * 8, tid & 63);
        }
    }
    SEAM(base + 7);
    if (IN(base + 7)) REP(7) { REPBAR();
        const int* TOKOF = (const int*)(ws + WS_TOKOF); LAS int* idx = (LAS int*)(lds + LDS_IDX_OFF);
        const int nunits = NE * nmt * 8;
        for (int ibase = 0; ibase * G + c < nunits; ibase += 8) {
            __syncthreads();
            for (int q = tid; q < 8 * 256; q += 512) { const int i = q >> 8; const int Lu = (ibase + i) * G + c;
                if (Lu < nunits) { const int mt = (Lu / 8) % nmt, e = Lu / (8 * nmt); idx[q] = TOKOF[e * ESLOT + mt * 256 + (q & 255)]; } }
            __syncthreads();
            SchedGU S; S.nt = 16; S.ldb_b = 2048; S.lda_b = 2048; S.G = G; S.c = c; S.A = (const char*)(ws + WS_H); S.B = (const char*)(ws + ws_wgu(l)); S.nmt = nmt; S.ibase = ibase; S.idx = idx;
            EpiGU E{(bf16_t*)(ws + WS_ACT)};
            pg8::gemm_phase(lds, S, E);
        }
    }
    SEAM(base + 8);
    if (IN(base + 8)) REP(8) { REPBAR();
        SchedDown S; S.nt = 16; S.ldb_b = 2048; S.lda_b = 2048; S.G = G; S.c = c; S.A = (const char*)(ws + WS_ACT); S.B = (const char*)(ws + ws_wdn(l)); S.nmt = nmt;
        EpiDown E{(bf16_t*)(ws + WS_Y)};
        pg8::gemm_phase(lds, S, E);
    }
}

__global__ void __launch_bounds__(512, 2) fwd_kernel(Args a) {
    extern __shared__ __attribute__((aligned(16))) unsigned char lds_raw[];
    LAS unsigned char* lds = (LAS unsigned char*)lds_raw;
    const int tid = threadIdx.x; const int G = gridDim.x, c = blockIdx.x;
    volatile LAS unsigned* MISC = (volatile LAS unsigned*)(lds + LDS_MISC_OFF);
    if (tid < 32) MISC[tid] = 0u;
    __syncthreads();
#if !MK_PER_PHASE
    XcdBarrier bar = xcd_barrier_post((unsigned*)(a.ws + WS_BAR), MISC + 8);
#else
    XcdBarrier bar; bar.bar = nullptr; bar.x = 0; bar.st = MISC + 8;
#endif
    const int lo = a.ph_lo, hi = a.ph_hi;
    STAMP(0);
    if (IN(0)) REP(9) { REPBAR(); phase_prep(a, lds, G, c); }
    run_layer<0>(a, lds, G, c, lo, hi, bar);
    run_layer<1>(a, lds, G, c, lo, hi, bar);
    SEAM(NPHASE - 1);
    if (IN(NPHASE - 1)) REP(10) { REPBAR(); norm_phase<3>(a, 1, lds, G, c); }
    if (PROBE_SPIN >= 0) {
        GRID_BAR(); STAMP(NPHASE);
        if (blockIdx.x == 0 && threadIdx.x == 0) { volatile LAS unsigned long long* st = (volatile LAS unsigned long long*)(lds + LDS_MISC_OFF + 256);
            const unsigned long long dur = (st[PROBE_SPIN_END] - st[PROBE_SPIN]) * PROBE_MULT, t0 = __builtin_amdgcn_s_memrealtime();
            while (__builtin_amdgcn_s_memrealtime() - t0 < dur) __builtin_amdgcn_s_sleep(8); }
    }
}

extern "C" void kernel_launch(void* const* d_in, const int* in_sizes, int n_in, void* d_out, int out_size, void* d_ws, size_t ws_size, hipStream_t stream) {
    static int grid = 0;
    if (grid == 0) {
        if (n_in != 25 || out_size != TL * DM || ws_size < WS_END) { fprintf(stderr, "kernel_launch: unexpected shapes (n_in %d out %d ws %zu)\n", n_in, out_size, ws_size); grid = -1; return; }
        int dev = 0, cus = 0, per_cu = 0;
        if (hipGetDevice(&dev) != hipSuccess || hipDeviceGetAttribute(&cus, hipDeviceAttributeMultiprocessorCount, dev) != hipSuccess) { grid = -1; return; }
        if (hipFuncSetAttribute((const void*)fwd_kernel, hipFuncAttributeMaxDynamicSharedMemorySize, LDS_BYTES) != hipSuccess) { fprintf(stderr, "kernel_launch: hipFuncSetAttribute failed\n"); grid = -1; return; }
        if (hipOccupancyMaxActiveBlocksPerMultiprocessor(&per_cu, (const void*)fwd_kernel, 512, LDS_BYTES) != hipSuccess || per_cu < 1) { fprintf(stderr, "kernel_launch: occupancy query says %d blocks per CU\n", per_cu); (void)hipGetLastError(); grid = -1; return; }
        grid = cus;
    }
    if (grid < 0) return;
    (void)hipMemsetAsync((char*)d_ws + WS_BAR, 0, 65536, stream);
    Args a{};
    for (int i = 0; i < 25; ++i) a.in[i] = (const float*)d_in[i];
    a.out = (float*)d_out; a.ws = (unsigned char*)d_ws;
#if MK_PER_PHASE
    for (int ph = 0; ph < NPHASE; ++ph) { a.ph_lo = ph; a.ph_hi = ph + 1; hipLaunchKernelGGL(fwd_kernel, dim3(grid), dim3(512), LDS_BYTES, stream, a); }
#else
    a.ph_lo = 0; a.ph_hi = NPHASE;
    hipLaunchKernelGGL(fwd_kernel, dim3(grid), dim3(512), LDS_BYTES, stream, a);
#endif
}
```

```cpp
#include <hip/hip_runtime.h>
#include <hip/hip_cooperative_groups.h>
#include <cstdio>
#include <cstdint>
namespace cg = cooperative_groups;

#ifndef MK_PER_PHASE
#define MK_PER_PHASE 0
#endif

#define LAS __attribute__((address_space(3)))
#define DI __device__ __forceinline__
typedef unsigned short bf16_t;
typedef short bf16x8 __attribute__((ext_vector_type(8)));
typedef short s16x4 __attribute__((ext_vector_type(4)));
typedef float f32x4 __attribute__((ext_vector_type(4)));
typedef float f32x16 __attribute__((ext_vector_type(16)));
typedef unsigned u32x4 __attribute__((ext_vector_type(4)));
typedef unsigned u32x2 __attribute__((ext_vector_type(2)));

constexpr int DM = 1024, NBATCH = 4, SEQ = 4096, CTXL = 256;
constexpr int TL = NBATCH * SEQ, TC = NBATCH * CTXL, TT = TL + TC;
constexpr int INW = 5376;
constexpr int NE = 16, ESLOT = 2304;
constexpr float LOG2E = 1.4426950408889634f;
constexpr float QSC = 0.125f * LOG2E;
constexpr int NPHASE = 20;

constexpr size_t MiB = (size_t)1 << 20;
constexpr size_t WS_BAR = 0;
constexpr size_t WS_MOD = 1 * MiB, WS_ROPE = 1 * MiB + 512 * 1024;
constexpr size_t WS_AFF = 2 * MiB, WS_SLOTOF = 4 * MiB, WS_TOKOF = 6 * MiB;
constexpr size_t WS_WIN = 8 * MiB, WS_WMERGE = 29 * MiB, WS_WOUT = 35 * MiB, WS_WGU = 40 * MiB, WS_WDN = 104 * MiB;
constexpr size_t WS_X = 136 * MiB, WS_H = 204 * MiB;
constexpr size_t WS_Q = 238 * MiB, WS_K = 255 * MiB, WS_VT = 260 * MiB, WS_U = 265 * MiB, WS_Z = 282 * MiB, WS_G = 299 * MiB, WS_BR = 401 * MiB;
constexpr size_t WS_DELTA = 401 * MiB;
constexpr size_t WS_MERGED = 238 * MiB;
constexpr size_t WS_ACT = 238 * MiB, WS_Y = 310 * MiB;
constexpr size_t WS_WGU1 = 452 * MiB, WS_WDN1 = 516 * MiB;
constexpr size_t WS_END = 548 * MiB;
DI size_t ws_wgu(int l) { return l == 0 ? WS_WGU : WS_WGU1; }
DI size_t ws_wdn(int l) { return l == 0 ? WS_WDN : WS_WDN1; }

constexpr int LDS_BYTES = 147456;
constexpr int RING_BYTES = 131072;
constexpr int LDS_IDX_OFF = RING_BYTES;
constexpr int LDS_MISC_OFF = RING_BYTES + 8192;

struct Args { const float* in[25]; float* out; unsigned char* ws; int ph_lo, ph_hi; };
enum { I_X = 0, I_C, I_CTX, I_CCTX, I_N1G, I_N2G, I_WMOD, I_BMOD, I_WIN, I_SINK, I_WAO, I_CDW, I_CDWB, I_CLNG, I_CLNB, I_WCO, I_WPOOL, I_PSCALE, I_WPO, I_WOUT, I_WR, I_WEG, I_WEU, I_WED, I_FNG };

DI unsigned pk_bf16(float lo, float hi) {
    typedef float f2 __attribute__((ext_vector_type(2))); typedef __bf16 b2 __attribute__((ext_vector_type(2)));
    f2 v = {lo, hi}; b2 b = __builtin_convertvector(v, b2); return __builtin_bit_cast(unsigned, b);
}
DI bf16_t f2bf(float f) { return (bf16_t)(pk_bf16(f, 0.f) & 0xffffu); }
DI float bf_lo(unsigned u) { return __uint_as_float(u << 16); }
DI float bf_hi(unsigned u) { return __uint_as_float(u & 0xffff0000u); }
DI float bf2f(bf16_t b) { return __uint_as_float(((unsigned)b) << 16); }
DI float sigm(float x) { return __builtin_amdgcn_rcpf(1.f + __builtin_amdgcn_exp2f(x * -LOG2E)); }
DI float wave_sum(float v) {
#pragma unroll
    for (int o = 1; o < 64; o <<= 1) v += __shfl_xor(v, o);
    return v;
}
DI float max3f(float a, float b, float c) { float r; asm("v_max3_f32 %0, %1, %2, %3" : "=v"(r) : "v"(a), "v"(b), "v"(c)); return r; }
DI int crow(int r, int hi) { return (r & 3) + 8 * (r >> 2) + 4 * hi; }
#define LDS_WAIT() asm volatile("s_waitcnt lgkmcnt(0)" ::: "memory")

namespace pg8 {
constexpr int BM = 256, BK = 64, HALF = 128, HTB = HALF * BK * 2;
DI int lds_byte(int r, int c) { const int st = (r >> 4) * 2 + (c >> 5), rr = r & 15, cc = c & 31, ob = rr * 64 + cc * 2; return st * 1024 + (ob ^ (((ob >> 9) & 1) << 5)); }
DI void stage_rc(int b, int& R, int& C) { const int st = b / 1024, sb = b % 1024, swz = sb ^ (((sb >> 9) & 1) << 5); R = (st >> 1) * 16 + swz / 64; C = (st & 1) * 32 + (swz % 64) / 2; }

struct Unit { const char* a; const char* b; int i0, i1, i2, ui; int half; };

DI void tile_order(int L, int nM, int nN, int& pm, int& pn) {
    const int nwg = nM * nN; int wgid = L;
    { const int q = nwg / 8, r = nwg % 8, xcd = wgid % 8, off = wgid / 8; wgid = (xcd < r ? xcd * (q + 1) : r * (q + 1) + (xcd - r) * q) + off; }
    const int nig = 8 * nN, gid = wgid / nig, fm = gid * 8, gsz = (nM - fm) < 8 ? (nM - fm) : 8;
    pm = fm + ((wgid % nig) % gsz); pn = (wgid % nig) / gsz;
}

template <class Epi, class Sched>
DI void gemm_phase(LAS unsigned char* lds, const Sched& S, const Epi& E) {
    const int tid = threadIdx.x, wid = __builtin_amdgcn_readfirstlane(tid >> 6), lane = tid & 63, wr = wid >> 2, wc = wid & 3, fr = lane & 15, fq = lane >> 4;
    const int nt = S.nt;
    int R0, C0, R1, C1; stage_rc(tid * 16, R0, C0); stage_rc(tid * 16 + 8192, R1, C1);
    unsigned voffB[2][2];
#pragma unroll
    for (int h = 0; h < 2; ++h) { voffB[h][0] = (unsigned)((h * HALF + R0) * S.ldb_b + C0 * 2); voffB[h][1] = (unsigned)((h * HALF + R1) * S.ldb_b + C1 * 2); }
    const size_t kstep = (size_t)(BK * 2);
    const unsigned ldsw = (unsigned)wid * 1024u;
    const int aoff = lds_byte(wr * 64 + fr, fq * 8), boff = lds_byte(wc * 32 + fr, fq * 8);
#define PG8_SA(b, h) (((b) * 2 + (h)) * HTB)
#define PG8_SB(b, h) ((4 + (b) * 2 + (h)) * HTB)
#define PG8_STAGE(bufoff, gbase, voff) do { _Pragma("unroll") for (int _i = 0; _i < 2; ++_i) \
        __builtin_amdgcn_global_load_lds((const unsigned*)((const char*)(gbase) + (voff)[_i]), (LAS unsigned*)(lds + (bufoff) + ldsw + _i * 8192), 16, 0, 0); } while (0)
#define PG8_LDA(dst, b, h) do { _Pragma("unroll") for (int m = 0; m < 4; ++m) _Pragma("unroll") for (int k = 0; k < 2; ++k) dst[m][k] = *(const LAS bf16x8*)(lds + PG8_SA(b, h) + aoff + m * 2048 + k * 1024); } while (0)
#define PG8_LDB(dst, b, h) do { _Pragma("unroll") for (int n = 0; n < 2; ++n) _Pragma("unroll") for (int k = 0; k < 2; ++k) dst[n][k] = *(const LAS bf16x8*)(lds + PG8_SB(b, h) + boff + n * 2048 + k * 1024); } while (0)
#define PG8_MMA(ai, bj, At, Bt) do { __builtin_amdgcn_s_setprio(1); _Pragma("unroll") for (int m = 0; m < 4; ++m) _Pragma("unroll") for (int n = 0; n < 2; ++n) _Pragma("unroll") for (int k = 0; k < 2; ++k) \
        acc[ai][bj][m][n] = __builtin_amdgcn_mfma_f32_16x16x32_bf16(Bt[n][k], At[m][k], acc[ai][bj][m][n], 0, 0, 0); __builtin_amdgcn_s_setprio(0); } while (0)
#define PG8_WAIT_V(n) asm volatile("s_waitcnt vmcnt(" #n ")" ::: "memory")
#define PG8_WAIT_L(n) asm volatile("s_waitcnt lgkmcnt(" #n ")" ::: "memory")
#define PG8_BAR __builtin_amdgcn_s_barrier()
#define PG8_SCHED __builtin_amdgcn_sched_barrier(0)
    Unit cur, nxt; int ui = 0;
    if (!S.next(0, cur)) return;
    f32x4 acc[2][2][4][2];
#pragma unroll
    for (int a = 0; a < 2; ++a)
#pragma unroll
        for (int b = 0; b < 2; ++b)
#pragma unroll
            for (int m = 0; m < 4; ++m)
#pragma unroll
                for (int n = 0; n < 2; ++n) acc[a][b][m][n] = (f32x4){0.f, 0.f, 0.f, 0.f};
    bf16x8 At[4][2], B0[2][2], B1[2][2];
    unsigned cvA[2][2], nvA[2][2];
    S.voff(cur, R0, C0, R1, C1, cvA);
    const char* cA = cur.a; const char* cB = cur.b;
    PG8_STAGE(PG8_SB(0, 0), cB, voffB[0]); PG8_STAGE(PG8_SB(0, 1), cB, voffB[1]); PG8_STAGE(PG8_SA(0, 0), cA, cvA[0]); PG8_STAGE(PG8_SA(0, 1), cA, cvA[1]);
    if (wr == 1) PG8_BAR;
    PG8_WAIT_V(2); PG8_BAR;
    PG8_STAGE(PG8_SB(1, 0), cB + kstep, voffB[0]); PG8_STAGE(PG8_SA(1, 0), cA + kstep, cvA[0]); PG8_STAGE(PG8_SB(1, 1), cB + kstep, voffB[1]);
    PG8_WAIT_V(6); PG8_BAR;
    for (;;) {
        const bool has_next = S.next(ui + 1, nxt);
        const char* nA = has_next ? nxt.a : cA; const char* nB = has_next ? nxt.b : cB;
        if (has_next) S.voff(nxt, R0, C0, R1, C1, nvA);
        else {
#pragma unroll
            for (int h = 0; h < 2; ++h) { nvA[h][0] = cvA[h][0]; nvA[h][1] = cvA[h][1]; }
        }
        const bool hf = cur.half != 0;
        for (int t = 0; t < nt; t += 2) {
            if constexpr (Epi::HOOK) { if (t == 8 || t == 16) E.hook(acc, cur, t >> 4, wr, wc, fr, fq); }
            const bool last = (t == nt - 2);
            const char* a1 = cA + (size_t)(t + 1) * kstep;
            const char* a2 = last ? nA : cA + (size_t)(t + 2) * kstep; const char* b2 = last ? nB : cB + (size_t)(t + 2) * kstep;
            const char* a3 = a2 + kstep; const char* b3 = b2 + kstep;
            unsigned v2[2][2];
#pragma unroll
            for (int h = 0; h < 2; ++h) { v2[h][0] = last ? nvA[h][0] : cvA[h][0]; v2[h][1] = last ? nvA[h][1] : cvA[h][1]; }
            PG8_LDB(B0, 0, 0); PG8_LDB(B1, 0, 1); PG8_SCHED; PG8_LDA(At, 0, 0); PG8_STAGE(PG8_SA(1, 1), a1, cvA[1]);
            PG8_WAIT_V(8); PG8_WAIT_L(0); PG8_BAR; PG8_MMA(0, 0, At, B0); PG8_MMA(0, 1, At, B1); PG8_BAR; PG8_SCHED;
            PG8_LDA(At, 0, 1); PG8_STAGE(PG8_SB(0, 0), b2, voffB[0]); PG8_STAGE(PG8_SB(0, 1), b2, voffB[1]); PG8_STAGE(PG8_SA(0, 0), a2, v2[0]);
            PG8_WAIT_V(8); PG8_WAIT_L(0); PG8_BAR; if (!hf) { PG8_MMA(1, 0, At, B0); PG8_MMA(1, 1, At, B1); } PG8_BAR; PG8_SCHED;
            PG8_LDB(B0, 1, 0); PG8_LDB(B1, 1, 1); PG8_SCHED; PG8_LDA(At, 1, 0); PG8_STAGE(PG8_SA(0, 1), a2, v2[1]);
            PG8_WAIT_V(8); PG8_WAIT_L(0); PG8_BAR; PG8_MMA(0, 0, At, B0); PG8_MMA(0, 1, At, B1); PG8_BAR; PG8_SCHED;
            PG8_LDA(At, 1, 1); PG8_STAGE(PG8_SB(1, 0), b3, voffB[0]); PG8_STAGE(PG8_SB(1, 1), b3, voffB[1]); PG8_STAGE(PG8_SA(1, 0), a3, v2[0]);
            PG8_WAIT_V(8); PG8_WAIT_L(0); PG8_BAR; if (!hf) { PG8_MMA(1, 0, At, B0); PG8_MMA(1, 1, At, B1); } PG8_BAR; PG8_SCHED;
        }
        if (wr == 0) PG8_BAR;
        E(acc, cur, wr, wc, fr, fq);
        if (!has_next) break;
#pragma unroll
        for (int a = 0; a < 2; ++a)
#pragma unroll
            for (int b = 0; b < 2; ++b)
#pragma unroll
                for (int m = 0; m < 4; ++m)
#pragma unroll
                    for (int n = 0; n < 2; ++n) acc[a][b][m][n] = (f32x4){0.f, 0.f, 0.f, 0.f};
        cur = nxt; cA = nA; cB = nB; ++ui;
#pragma unroll
        for (int h = 0; h < 2; ++h) { cvA[h][0] = nvA[h][0]; cvA[h][1] = nvA[h][1]; }
        if (wr == 1) PG8_BAR;
    }
    PG8_WAIT_V(0);
    PG8_BAR;
#undef PG8_SA
#undef PG8_SB
#undef PG8_STAGE
#undef PG8_LDA
#undef PG8_LDB
#undef PG8_MMA
#undef PG8_WAIT_V
#undef PG8_WAIT_L
#undef PG8_BAR
#undef PG8_SCHED
}
}
using pg8::Unit;
typedef f32x4 Acc[2][2][4][2];

struct SchedBase {
    int nt, ldb_b, lda_b, G, c;
    DI void voff_contig(int R0, int C0, int R1, int C1, unsigned (&vo)[2][2]) const {
#pragma unroll
        for (int h = 0; h < 2; ++h) { vo[h][0] = (unsigned)((h * 128 + R0) * lda_b + C0 * 2); vo[h][1] = (unsigned)((h * 128 + R1) * lda_b + C1 * 2); }
    }
};
struct SchedInProj : SchedBase {
    const char* A; const char* B; int nM, n1, n1p, ntot, lo, hi;
    DI void init_counts(int nM_, int extra) { nM = nM_; n1 = nM * 9 + extra; n1p = (n1 + 7) & ~7; ntot = n1p + nM * 12; }
    DI bool next(int i, Unit& u) const {
        const int L = lo + i * G + c; if (L >= hi) return false; int pm, pn;
        if (L < n1p) { const int L1 = L < n1 ? L : L - n1; if (L1 < nM * 9) pg8::tile_order(L1, nM, 9, pm, pn); else { pm = 64 + (L1 - nM * 9); pn = 2; } }
        else { pg8::tile_order(L - n1p, nM, 12, pm, pn); pn += 9; }
        u.a = A + (size_t)pm * 256 * 2048; u.b = B + (size_t)pn * 256 * 2048; u.i0 = pm; u.i1 = pn; u.i2 = 0; u.ui = i; u.half = 0; return true;
    }
    DI void voff(const Unit&, int R0, int C0, int R1, int C1, unsigned (&vo)[2][2]) const { voff_contig(R0, C0, R1, C1, vo); }
};
struct SchedMerge : SchedBase {
    const char* A; const char* B; int nM;
    DI bool next(int i, Unit& u) const {
        const int L = i * G + c; if (L >= nM * 4) return false;
        int pm, pn; pg8::tile_order(L, nM, 4, pm, pn);
        u.a = A + (size_t)pm * 256 * 3072; u.b = B + (size_t)pn * 256 * 3072; u.i0 = pm; u.i1 = pn; u.i2 = 0; u.ui = i; u.half = 0; return true;
    }
    DI void voff(const Unit&, int R0, int C0, int R1, int C1, unsigned (&vo)[2][2]) const { voff_contig(R0, C0, R1, C1, vo); }
};
struct SchedOut : SchedBase {
    const char* A; const char* B; int nM;
    DI bool next(int i, Unit& u) const {
        const int L = i * G + c; if (L >= nM * 4) return false;
        int pm, pn; pg8::tile_order(L, nM, 4, pm, pn);
        u.a = A + (size_t)pm * 256 * 2048; u.b = B + (size_t)pn * 256 * 2048; u.i0 = pm; u.i1 = pn; u.i2 = 0; u.ui = i; u.half = 0; return true;
    }
    DI void voff(const Unit&, int R0, int C0, int R1, int C1, unsigned (&vo)[2][2]) const { voff_contig(R0, C0, R1, C1, vo); }
};
DI void gu_decode(int L, int& e, int& mt, int& n8) { if (L < NE * 64) { n8 = L & 7; mt = (L >> 3) & 7; e = L >> 6; } else { const int x = L - NE * 64; n8 = x & 7; e = x >> 3; mt = 8; } }
DI void dn_decode(int L, int& e, int& mt, int& n4) { if (L < NE * 32) { n4 = L & 3; mt = (L >> 2) & 7; e = L >> 5; } else { const int x = L - NE * 32; n4 = x & 3; e = x >> 2; mt = 8; } }
struct SchedGU : SchedBase {
    const char* A; const char* B; int lo, hi, c0, ibase; const LAS int* idx;
    DI int unit(int i) const { return lo + (ibase + i) * G + c0; }
    DI bool next(int i, Unit& u) const {
        if (i >= 8 || c0 < 0) return false;
        const int L = unit(i); if (L >= hi) return false;
        int e, mt, n8; gu_decode(L, e, mt, n8);
        u.a = A; u.b = B + ((size_t)e * 2048 + n8 * 256) * 2048; u.i0 = e; u.i1 = mt; u.i2 = n8; u.ui = i; u.half = mt == 8; return true;
    }
    DI void voff(const Unit& u, int R0, int C0, int R1, int C1, unsigned (&vo)[2][2]) const {
#pragma unroll
        for (int h = 0; h < 2; ++h) { vo[h][0] = (unsigned)(idx[u.ui * 256 + h * 128 + R0] * 2048 + C0 * 2); vo[h][1] = (unsigned)(idx[u.ui * 256 + h * 128 + R1] * 2048 + C1 * 2); }
    }
};
struct SchedDown : SchedBase {
    const char* A; const char* B; int lo, hi, c0;
    DI bool next(int i, Unit& u) const {
        if (c0 < 0) return false;
        const int L = lo + i * G + c0; if (L >= hi) return false;
        int e, mt, n4; dn_decode(L, e, mt, n4);
        u.a = A + ((size_t)e * ESLOT + mt * 256) * 2048; u.b = B + ((size_t)e * 1024 + n4 * 256) * 2048; u.i0 = e; u.i1 = mt; u.i2 = n4; u.ui = i; u.half = mt == 8; return true;
    }
    DI void voff(const Unit&, int R0, int C0, int R1, int C1, unsigned (&vo)[2][2]) const { voff_contig(R0, C0, R1, C1, vo); }
};

DI void st_bf4(bf16_t* p, f32x4 v) { u32x2 w; w.x = pk_bf16(v[0], v[1]); w.y = pk_bf16(v[2], v[3]); *(u32x2*)p = w; }
DI float gatef(float x) { return fminf(1.f + __builtin_amdgcn_exp2f(x * -LOG2E), 1e18f); }
DI f32x4 gate4(f32x4 v) { return (f32x4){gatef(v[0]), gatef(v[1]), gatef(v[2]), gatef(v[3])}; }
DI f32x4 sig4(f32x4 v) { return (f32x4){sigm(v[0]), sigm(v[1]), sigm(v[2]), sigm(v[3])}; }

struct EpiInProj {
    static constexpr bool HOOK = false;
    bf16_t *Q, *K, *VT, *U, *Z, *G; const float* rope;
    DI void operator()(const Acc& acc, const Unit& u, int wr, int wc, int fr, int fq) const {
        const int pm = u.i0, pn = u.i1;
#pragma unroll
        for (int bj = 0; bj < 2; ++bj) {
            const int gc = 256 * pn + 128 * bj + 32 * wc;
#pragma unroll
            for (int ai = 0; ai < 2; ++ai)
#pragma unroll
                for (int m = 0; m < 4; ++m) {
                    const int t = 256 * pm + 128 * ai + 64 * wr + 16 * m + fr;
                    const f32x4 v0 = acc[ai][bj][m][0], v1 = acc[ai][bj][m][1];
                    if (gc < 640) {
                        f32x4 o0 = v0, o1 = v1;
                        if (t < TL) {
                            const int s = t & (SEQ - 1); const int p = ((gc >> 5) & 1) ? (s & 63) : (s >> 6);
                            const f32x4 cs = *(const f32x4*)(rope + p * 16 + 4 * fq), sn = *(const f32x4*)(rope + 1024 + p * 16 + 4 * fq);
                            o0 = v0 * cs - v1 * sn; o1 = v1 * cs + v0 * sn;
                        }
                        bf16_t* dst;
                        if (gc < 512) { o0 = o0 * QSC; o1 = o1 * QSC; dst = Q + (size_t)t * 512 + gc + 4 * fq; } else dst = K + (size_t)t * 128 + (gc - 512) + 4 * fq;
                        st_bf4(dst, o0); st_bf4(dst + 16, o1);
                    } else if (gc < 768) {
                        const int c0 = gc - 640 + 4 * fq;
#pragma unroll
                        for (int j = 0; j < 4; ++j) { VT[(size_t)(c0 + j) * TT + t] = f2bf(v0[j]); VT[(size_t)(c0 + 16 + j) * TT + t] = f2bf(v1[j]); }
                    } else if (gc < 1792) {
                        const int ch = ((gc - 768) >> 1) + 4 * fq;
                        st_bf4(U + (size_t)t * 512 + ch, v0 * sig4(v1));
                    } else if (gc < 2304) {
                        bf16_t* dst = Z + (size_t)t * 512 + (gc - 1792) + 4 * fq; st_bf4(dst, v0); st_bf4(dst + 16, v1);
                    } else {
                        const int gt = pn - 9; const size_t gb = ((((size_t)(pm * 3 + (gt >> 2)) * 4 + (gt & 3)) * 8 + (wr * 4 + wc)) * 16 + ((ai * 4 + m) * 2 + bj)) * 64 + (fq * 16 + fr);
                        const f32x4 g0 = gate4(v0), g1 = gate4(v1); u32x4 gw; gw.x = pk_bf16(g0[0], g0[1]); gw.y = pk_bf16(g0[2], g0[3]); gw.z = pk_bf16(g1[0], g1[1]); gw.w = pk_bf16(g1[2], g1[3]);
                        __builtin_nontemporal_store(gw, (u32x4*)(G + gb * 8));
                    }
                }
        }
    }
};
struct EpiMerge {
    static constexpr bool HOOK = true;
    const bf16_t* G; bf16_t* M;
    DI static f32x4 lo4(u32x4 w) { return (f32x4){bf_lo(w.x), bf_hi(w.x), bf_lo(w.y), bf_hi(w.y)}; }
    DI static f32x4 hi4(u32x4 w) { return (f32x4){bf_lo(w.z), bf_hi(w.z), bf_lo(w.w), bf_hi(w.w)}; }
    DI static f32x4 rcp4(f32x4 v) { return (f32x4){__builtin_amdgcn_rcpf(v[0]), __builtin_amdgcn_rcpf(v[1]), __builtin_amdgcn_rcpf(v[2]), __builtin_amdgcn_rcpf(v[3])}; }
    DI void hook(Acc& acc, const Unit& u, int which, int wr, int wc, int fr, int fq) const {
        int lofs = fq * 16 + fr; asm volatile("" : "+v"(lofs));
        const u32x4* pa = (const u32x4*)G + ((((size_t)(u.i0 * 3 + which) * 4 + u.i1) * 8 + (wr * 4 + wc)) * 16) * 64 + lofs;
        const u32x4* pb = pa + (size_t)4 * 8 * 16 * 64;
        u32x4 ba[4][2], bb[4][2];
#pragma unroll
        for (int h = 0; h < 2; ++h) {
#pragma unroll
            for (int g = 0; g < 4; ++g)
#pragma unroll
                for (int q = 0; q < 2; ++q) { ba[g][q] = pa[((4 * h + g) * 2 + q) * 64]; bb[g][q] = pb[((4 * h + g) * 2 + q) * 64]; }
#pragma unroll
            for (int g = 0; g < 4; ++g)
#pragma unroll
                for (int q = 0; q < 2; ++q) {
                    acc[h][q][g][0] = acc[h][q][g][0] * (lo4(bb[g][q]) * rcp4(lo4(ba[g][q])));
                    acc[h][q][g][1] = acc[h][q][g][1] * (hi4(bb[g][q]) * rcp4(hi4(ba[g][q]))); }
            asm volatile("" ::: "memory");
        }
    }
    DI void operator()(const Acc& acc, const Unit& u, int wr, int wc, int fr, int fq) const {
        const int pm = u.i0, pn = u.i1;
        const u32x4* pc = (const u32x4*)G + ((((size_t)(pm * 3 + 2) * 4 + pn) * 8 + (wr * 4 + wc)) * 16) * 64 + (fq * 16 + fr);
#pragma unroll
        for (int ai = 0; ai < 2; ++ai)
#pragma unroll
            for (int m = 0; m < 4; ++m) {
                const int t = 256 * pm + 128 * ai + 64 * wr + 16 * m + fr;
#pragma unroll
                for (int bj = 0; bj < 2; ++bj) {
                    const u32x4 gw = pc[((ai * 4 + m) * 2 + bj) * 64];
                    const int cc = 256 * pn + 128 * bj + 32 * wc + 4 * fq;
                    st_bf4(M + (size_t)t * 1024 + cc, acc[ai][bj][m][0] * rcp4(lo4(gw))); st_bf4(M + (size_t)t * 1024 + cc + 16, acc[ai][bj][m][1] * rcp4(hi4(gw)));
                }
            }
    }
};
struct EpiOut {
    static constexpr bool HOOK = false;
    bf16_t* D; const float* mod; int layer;
    DI void operator()(const Acc& acc, const Unit& u, int wr, int wc, int fr, int fq) const {
        const int pm = u.i0, pn = u.i1; const int row0 = 256 * pm;
        const int mr = row0 < TL ? (row0 >> 12) : 4;
        const float* g1 = mod + (size_t)(layer * 5 + mr) * 6144 + 2048;
#pragma unroll
        for (int bj = 0; bj < 2; ++bj)
#pragma unroll
            for (int n = 0; n < 2; ++n) {
                const int cc = 256 * pn + 128 * bj + 32 * wc + 16 * n + 4 * fq;
                const f32x4 gv = *(const f32x4*)(g1 + cc);
#pragma unroll
                for (int ai = 0; ai < 2; ++ai)
#pragma unroll
                    for (int m = 0; m < 4; ++m) {
                        const int t = row0 + 128 * ai + 64 * wr + 16 * m + fr;
                        st_bf4(D + (size_t)t * DM + cc, gv * acc[ai][bj][m][n]);
                    }
            }
    }
};
struct EpiGU {
    static constexpr bool HOOK = false;
    bf16_t* ACT;
    DI void operator()(const Acc& acc, const Unit& u, int wr, int wc, int fr, int fq) const {
        const int e = u.i0, mt = u.i1, n8 = u.i2;
#pragma unroll
        for (int ai = 0; ai < 2; ++ai) if (ai == 0 || !u.half)
#pragma unroll
            for (int m = 0; m < 4; ++m) {
                const size_t slot = (size_t)e * ESLOT + mt * 256 + 128 * ai + 64 * wr + 16 * m + fr;
#pragma unroll
                for (int bj = 0; bj < 2; ++bj) {
                    const int col = ((256 * n8 + 128 * bj + 32 * wc) >> 1) + 4 * fq;
                    const f32x4 gt = acc[ai][bj][m][0], up = acc[ai][bj][m][1];
                    st_bf4(ACT + slot * 1024 + col, gt * sig4(gt) * up);
                }
            }
    }
};
struct EpiDown {
    static constexpr bool HOOK = false;
    bf16_t* Y;
    DI void operator()(const Acc& acc, const Unit& u, int wr, int wc, int fr, int fq) const {
        const int e = u.i0, mt = u.i1, n4 = u.i2;
#pragma unroll
        for (int ai = 0; ai < 2; ++ai) if (ai == 0 || !u.half)
#pragma unroll
            for (int m = 0; m < 4; ++m) {
                const size_t slot = (size_t)e * ESLOT + mt * 256 + 128 * ai + 64 * wr + 16 * m + fr;
#pragma unroll
                for (int bj = 0; bj < 2; ++bj)
#pragma unroll
                    for (int n = 0; n < 2; ++n) st_bf4(Y + slot * 1024 + 256 * n4 + 128 * bj + 32 * wc + 16 * n + 4 * fq, acc[ai][bj][m][n]);
            }
    }
};

DI int maprow(int mode, int n) {
    if (mode == 1) {
        if (n >= 768 && n < 1280) { const int ch = n - 768; return 768 + 32 * (ch >> 4) + (ch & 15); }
        if (n >= 1280 && n < 1792) { const int ch = n - 1280; return 768 + 32 * (ch >> 4) + 16 + (ch & 15); }
        return n;
    }
    if (mode == 2) return 32 * (n >> 4) + (n & 15);
    if (mode == 3) return 32 * (n >> 4) + 16 + (n & 15);
    return n;
}
struct ConvTile { const float* W; bf16_t* WT; int N, dpitch, dcol0, mode, kb, nb; };
DI void tile_load(const ConvTile& t, int lane, f32x4 (&x)[8]) {
    const float* p = t.W + (size_t)(64 * t.kb + 8 * (lane & 7)) * t.N + 32 * t.nb + 4 * (lane >> 3);
#pragma unroll
    for (int r = 0; r < 8; ++r) x[r] = __builtin_nontemporal_load((const f32x4*)(p + (size_t)r * t.N));
}
DI void tile_store(const ConvTile& t, int lane, const f32x4 (&x)[8]) {
    const int n = 32 * t.nb + 4 * (lane >> 3);
#pragma unroll
    for (int i = 0; i < 4; ++i) { u32x4 o; o.x = pk_bf16(x[0][i], x[1][i]); o.y = pk_bf16(x[2][i], x[3][i]); o.z = pk_bf16(x[4][i], x[5][i]); o.w = pk_bf16(x[6][i], x[7][i]);
        *(u32x4*)(t.WT + (size_t)maprow(t.mode, n + i) * t.dpitch + t.dcol0 + 64 * t.kb + 8 * (lane & 7)) = o; }
}
DI ConvTile small_tile(const Args& a, int it) {
    unsigned char* ws = a.ws; ConvTile t;
    constexpr int I_A = 16 * 168, I_B = 8 * 32, I_C = 8 * 32, I_D = 16 * 32, PER = I_A + I_B + I_C + I_D;
    const int l = it / PER; int r = it % PER;
    if (r < I_A) { t.W = a.in[I_WIN] + (size_t)l * 1024 * INW; t.N = INW; t.WT = (bf16_t*)(ws + WS_WIN) + (size_t)l * INW * 1024; t.dpitch = 1024; t.dcol0 = 0; t.mode = 1; }
    else if ((r -= I_A) < I_B) { t.W = a.in[I_WAO] + (size_t)l * 512 * 1024; t.N = 1024; t.WT = (bf16_t*)(ws + WS_WMERGE) + (size_t)l * 1024 * 1536; t.dpitch = 1536; t.dcol0 = 0; t.mode = 0; }
    else if ((r -= I_B) < I_C) { t.W = a.in[I_WCO] + (size_t)l * 512 * 1024; t.N = 1024; t.WT = (bf16_t*)(ws + WS_WMERGE) + (size_t)l * 1024 * 1536; t.dpitch = 1536; t.dcol0 = 512; t.mode = 0; }
    else { r -= I_C; t.W = a.in[I_WOUT] + (size_t)l * 1024 * 1024; t.N = 1024; t.WT = (bf16_t*)(ws + WS_WOUT) + (size_t)l * 1024 * 1024; t.dpitch = 1024; t.dcol0 = 0; t.mode = 0; }
    const int nblk = t.N / 32; t.kb = r / nblk; t.nb = r % nblk; return t;
}
constexpr int N_SMALL_TILES = 2 * (16 * 168 + 8 * 32 + 8 * 32 + 16 * 32);
DI ConvTile expert_tile(const Args& a, int l, int it) {
    unsigned char* ws = a.ws; ConvTile t;
    const int m = it >> 9, r = it & 511, e = m / 3, kind = m % 3; const size_t wo = ((size_t)l * NE + e) * 1024 * 1024;
    t.N = 1024; t.dpitch = 1024; t.dcol0 = 0; t.kb = r >> 5; t.nb = r & 31;
    const long long d1 = (const char*)a.in[I_WEU] - (const char*)a.in[I_WEG], d2 = (const char*)a.in[I_WED] - (const char*)a.in[I_WEG];
    const long long dsel = kind == 0 ? 0ll : (kind == 1 ? d1 : d2);
    t.W = (const float*)((const char*)a.in[I_WEG] + dsel) + wo;
    t.WT = kind == 2 ? (bf16_t*)(ws + ws_wdn(l)) + (size_t)e * 1024 * 1024 : (bf16_t*)(ws + ws_wgu(l)) + (size_t)e * 2048 * 1024;
    t.mode = kind == 0 ? 2 : (kind == 1 ? 3 : 0);
    return t;
}
constexpr int N_EXPERT_TILES = NE * 3 * 512;
template <class F> DI void convert_loop(int ntiles, int gw, int NGW, int lane, F&& get) {
    for (int it = gw; it < ntiles; it += 2 * NGW) {
        const ConvTile t0 = get(it); const bool two = it + NGW < ntiles; const ConvTile t1 = get(two ? it + NGW : it);
        f32x4 x0[8], x1[8];
        tile_load(t0, lane, x0); if (two) tile_load(t1, lane, x1);
        tile_store(t0, lane, x0); if (two) tile_store(t1, lane, x1);
    }
}
constexpr int CTR_WORD0 = 8192, CTR_STRIDE = 64;
DI void convert_pull(const Args& a, int l, int lane, const unsigned* done = nullptr, unsigned G = 0u) {
    unsigned* ctr = (unsigned*)(a.ws + WS_BAR) + CTR_WORD0 + l * CTR_STRIDE;
    for (;;) {
        if (done) { unsigned d = 0u; if (lane == 0) d = __hip_atomic_load(done, __ATOMIC_RELAXED, __HIP_MEMORY_SCOPE_AGENT); if ((unsigned)__builtin_amdgcn_readfirstlane((int)d) >= G) break; }
        unsigned itu = 0u; if (lane == 0) itu = __hip_atomic_fetch_add(ctr, 16u, __ATOMIC_RELAXED, __HIP_MEMORY_SCOPE_AGENT);
        const int it0 = __builtin_amdgcn_readfirstlane((int)itu);
        if (it0 >= N_EXPERT_TILES) break;
#pragma unroll 1
        for (int it = it0; it < it0 + 16; it += 2) {
            const ConvTile t0 = expert_tile(a, l, it), t1 = expert_tile(a, l, it + 1);
            f32x4 x0[8], x1[8];
            tile_load(t0, lane, x0); tile_load(t1, lane, x1);
            tile_store(t0, lane, x0); tile_store(t1, lane, x1);
        }
    }
}
DI void convert_small(const Args& a, int gw, int NGW, int lane) { convert_loop(N_SMALL_TILES, gw, NGW, lane, [&](int it) __attribute__((always_inline)) { return small_tile(a, it); }); }
DI void convert_experts(const Args& a, int l, int gw, int NGW, int lane) { convert_loop(N_EXPERT_TILES, gw, NGW, lane, [&](int it) __attribute__((always_inline)) { return expert_tile(a, l, it); }); }
DI void mod_item(const Args& a, LAS unsigned char* lds, int item) {
    const int tid = threadIdx.x, l = item / 96, cb = item % 96;
    LAS float* sc = (LAS float*)lds; LAS float* red = (LAS float*)(lds + 20480);
    for (int idx = tid; idx < 5120; idx += 512) { const int r = idx >> 10, k = idx & 1023; const float v = r < 4 ? a.in[I_C][r * 1024 + k] : a.in[I_CCTX][k]; sc[idx] = v / (1.f + expf(-v)); }
    __syncthreads();
    const int c4 = tid & 15, kg = tid >> 4; const float* w = a.in[I_WMOD] + (size_t)l * 1024 * 6144 + cb * 64 + c4 * 4 + (size_t)(kg * 32) * 6144;
    f32x4 acc[5];
#pragma unroll
    for (int r = 0; r < 5; ++r) acc[r] = (f32x4){0.f, 0.f, 0.f, 0.f};
#pragma unroll
    for (int k8 = 0; k8 < 32; k8 += 8) { f32x4 wv[8];
#pragma unroll
        for (int i = 0; i < 8; ++i) wv[i] = __builtin_nontemporal_load((const f32x4*)(w + (size_t)(k8 + i) * 6144));
#pragma unroll
        for (int i = 0; i < 8; ++i)
#pragma unroll
            for (int r = 0; r < 5; ++r) acc[r] = acc[r] + sc[r * 1024 + kg * 32 + k8 + i] * wv[i]; }
#pragma unroll
    for (int r = 0; r < 5; ++r) *(LAS f32x4*)(red + (kg * 5 + r) * 64 + c4 * 4) = acc[r];
    __syncthreads();
    if (tid < 320) { const int r = tid >> 6, col = tid & 63; float s = a.in[I_BMOD][l * 6144 + cb * 64 + col];
#pragma unroll 8
        for (int g = 0; g < 32; ++g) s += red[(g * 5 + r) * 64 + col];
        ((float*)(a.ws + WS_MOD))[(size_t)(l * 5 + r) * 6144 + cb * 64 + col] = s; }
    __syncthreads();
}
DI void rope_item(const Args& a) {
    float* rp = (float*)(a.ws + WS_ROPE);
    for (int idx = threadIdx.x; idx < 1024; idx += 512) { const int p = idx >> 4, i = idx & 15; const float fr = powf(10000.f, -(float)i / 16.f); const float ang = (float)p * fr; rp[idx] = cosf(ang); rp[1024 + idx] = sinf(ang); }
}
DI void fold_item(const Args& a, LAS unsigned char* lds, int item) {
    const int tid = threadIdx.x; const int nh = item & 1, kb = (item >> 1) & 15, gi = (item >> 5) & 3, l = item >> 7;
    LAS float* wp = (LAS float*)lds; LAS float* psv = (LAS float*)(lds + 4096);
    for (int idx = tid; idx < 1024; idx += 512) wp[idx] = a.in[I_WPOOL][(((size_t)l * 4 + gi) * 128 + kb * 8 + (idx >> 7)) * 128 + (idx & 127)];
    if (tid < 128) psv[tid] = a.in[I_PSCALE][l * 512 + gi * 128 + tid];
    __syncthreads();
    const int n = nh * 512 + tid; const float* wo = a.in[I_WPO] + ((size_t)l * 512 + gi * 128) * 1024 + n;
    float acc[8] = {0.f, 0.f, 0.f, 0.f, 0.f, 0.f, 0.f, 0.f};
#pragma unroll 16
    for (int j = 0; j < 128; ++j) { const float v = wo[(size_t)j * 1024] * psv[j];
#pragma unroll
        for (int kk = 0; kk < 8; ++kk) acc[kk] += wp[kk * 128 + j] * v; }
    u32x4 o; o.x = pk_bf16(acc[0], acc[1]); o.y = pk_bf16(acc[2], acc[3]); o.z = pk_bf16(acc[4], acc[5]); o.w = pk_bf16(acc[6], acc[7]);
    *(u32x4*)((bf16_t*)(a.ws + WS_WMERGE) + ((size_t)l * 1024 + n) * 1536 + 1024 + gi * 128 + kb * 8) = o;
    __syncthreads();
}
DI void phase_prep(const Args& a, LAS unsigned char* lds, int G, int c) {
    constexpr int NBI = 192 + 1 + 256;
    for (int it = c; it < NBI; it += G) { if (it < 192) mod_item(a, lds, it); else if (it == 192) rope_item(a); else fold_item(a, lds, it - 193); }
    __syncthreads();
    const int wid = __builtin_amdgcn_readfirstlane(threadIdx.x >> 6), lane = threadIdx.x & 63;
    convert_small(a, c * 8 + wid, G * 8, lane);
}

template <int MODE> DI void norm_phase(const Args& a, int l, LAS unsigned char* lds, int G, int c) {
    const int tid = threadIdx.x, wid = __builtin_amdgcn_readfirstlane(tid >> 6), lane = tid & 63;
    unsigned char* ws = a.ws;
    float* X = (float*)(ws + WS_X); bf16_t* H = (bf16_t*)(ws + WS_H); const float* MOD = (const float*)(ws + WS_MOD);
    float* AFF = (float*)(ws + WS_AFF); const int* SLOTOF = (const int*)(ws + WS_SLOTOF); const bf16_t* Y = (const bf16_t*)(ws + WS_Y);
    LAS float* wr_l = (LAS float*)lds;
    constexpr int WRP = 1028;
    if (MODE == 2) {
        const f32x4* wsrc = (const f32x4*)(a.in[I_WR] + (size_t)l * 16384); f32x4 wv[8];
#pragma unroll
        for (int i = 0; i < 8; ++i) wv[i] = wsrc[tid + 512 * i];
#pragma unroll
        for (int i = 0; i < 8; ++i) { const int q = tid + 512 * i, k = q >> 2, e0 = (q & 3) * 4;
            wr_l[(e0 + 0) * WRP + k] = wv[i].x; wr_l[(e0 + 1) * WRP + k] = wv[i].y; wr_l[(e0 + 2) * WRP + k] = wv[i].z; wr_l[(e0 + 3) * WRP + k] = wv[i].w; }
        __syncthreads(); }
    constexpr bool COMB = (MODE == 1 || MODE == 3);
    const int nrows = (MODE == 3) ? TL : TT; const int rpb = (nrows + G - 1) / G; const int r0 = c * rpb; const int r1 = (r0 + rpb) < nrows ? (r0 + rpb) : nrows;
    f32x4 vn[2][4]; u32x2 dln[2][4]; int son[2] = {-1, -1}; float afn[2] = {0.f, 0.f};
    auto load_pair = [&](int base) __attribute__((always_inline)) {
#pragma unroll
        for (int r = 0; r < 2; ++r) { const int row = (base + r < r1) ? base + r : base;
            const float* src = (MODE == 0 || MODE == 1) ? (row < TL ? a.in[I_X] + (size_t)row * DM : a.in[I_CTX] + (size_t)(row - TL) * DM) : X + (size_t)row * DM;
#pragma unroll
            for (int j = 0; j < 4; ++j) vn[r][j] = *(const f32x4*)(src + 256 * j + 4 * lane);
            if (COMB) {
#pragma unroll
                for (int j = 0; j < 4; ++j) dln[r][j] = *(const u32x2*)((const bf16_t*)(ws + WS_DELTA) + (size_t)row * DM + 256 * j + 4 * lane); }
            if (COMB) { son[r] = lane < 16 ? SLOTOF[(size_t)row * 16 + lane] : -1; afn[r] = lane < 16 ? AFF[(size_t)row * 16 + lane] : 0.f; } }
    };
    constexpr bool PREF = (MODE != 2);
    f32x4 gsc[4], shf[4], g2c[4], fng[4]; int mr_c = -1;
    if (MODE == 3) {
#pragma unroll
        for (int j = 0; j < 4; ++j) fng[j] = *(const f32x4*)(a.in[I_FNG] + 256 * j + 4 * lane); }
    if (PREF && r0 + 2 * wid < r1) load_pair(r0 + 2 * wid);
    for (int base = r0 + 2 * wid; base < r1; base += 16) {
        const bool two = base + 1 < r1;
        if (!PREF) load_pair(base);
        f32x4 v[2][4]; int so[2]; float af[2]; int mr[2];
#pragma unroll
        for (int r = 0; r < 2; ++r) { const int row = (r == 1 && !two) ? base : base + r; mr[r] = row < TL ? (row >> 12) : 4; so[r] = son[r]; af[r] = afn[r];
#pragma unroll
            for (int j = 0; j < 4; ++j) { v[r][j] = vn[r][j]; if (COMB) v[r][j] = v[r][j] + (f32x4){bf_lo(dln[r][j].x), bf_hi(dln[r][j].x), bf_lo(dln[r][j].y), bf_hi(dln[r][j].y)}; } }
        if (PREF && base + 16 < r1) load_pair(base + 16);
        if (mr[0] != mr_c) { mr_c = mr[0];
            if (MODE != 3) { const float* gvv = (MODE == 2 ? a.in[I_N2G] : a.in[I_N1G]) + (size_t)l * DM; const float* mb = MOD + (size_t)(l * 5 + mr_c) * 6144 + (MODE == 2 ? 3072 : 0);
#pragma unroll
                for (int j = 0; j < 4; ++j) { const int k = 256 * j + 4 * lane; gsc[j] = *(const f32x4*)(gvv + k) * (1.f + *(const f32x4*)(mb + 1024 + k)); shf[j] = *(const f32x4*)(mb + k); } }
            if (COMB) { const float* g2p = MOD + (size_t)(((MODE == 1) ? 0 : 1) * 5 + mr_c) * 6144 + 5120;
#pragma unroll
                for (int j = 0; j < 4; ++j) g2c[j] = *(const f32x4*)(g2p + 256 * j + 4 * lane); } }
        if (COMB) {
            const int lp = (MODE == 1) ? 0 : 1;
            f32x4 cacc[2][4]; unsigned mask[2];
            int s1[2], s2[2]; float w1[2], w2[2];
#pragma unroll
            for (int r = 0; r < 2; ++r) {
#pragma unroll
                for (int j = 0; j < 4; ++j) cacc[r][j] = (f32x4){0.f, 0.f, 0.f, 0.f};
                mask[r] = (r == 0 || two) ? ((unsigned)__ballot(so[r] >= 0) & 0xffffu) : 0u;
                const bool h1 = mask[r] != 0u; const int e1 = h1 ? __builtin_ctz(mask[r]) : 0; if (h1) mask[r] &= mask[r] - 1;
                const bool h2 = mask[r] != 0u; const int e2 = h2 ? __builtin_ctz(mask[r]) : e1; if (h2) mask[r] &= mask[r] - 1;
                const int t1 = __builtin_amdgcn_readlane(so[r], e1), t2 = __builtin_amdgcn_readlane(so[r], e2);
                s1[r] = h1 ? t1 : 0; s2[r] = h2 ? t2 : s1[r];
                w1[r] = h1 ? __uint_as_float(__builtin_amdgcn_readlane(__float_as_uint(af[r]), e1)) : 0.f;
                w2[r] = h2 ? __uint_as_float(__builtin_amdgcn_readlane(__float_as_uint(af[r]), e2)) : 0.f; }
            { u32x2 ya[2][4], yb[2][4];
#pragma unroll
              for (int r = 0; r < 2; ++r)
#pragma unroll
                for (int j = 0; j < 4; ++j) { ya[r][j] = *(const u32x2*)(Y + (size_t)s1[r] * 1024 + 4 * lane + 256 * j); yb[r][j] = *(const u32x2*)(Y + (size_t)s2[r] * 1024 + 4 * lane + 256 * j); }
#pragma unroll
              for (int r = 0; r < 2; ++r)
#pragma unroll
                for (int j = 0; j < 4; ++j) cacc[r][j] = cacc[r][j] + w1[r] * (f32x4){bf_lo(ya[r][j].x), bf_hi(ya[r][j].x), bf_lo(ya[r][j].y), bf_hi(ya[r][j].y)} + w2[r] * (f32x4){bf_lo(yb[r][j].x), bf_hi(yb[r][j].x), bf_lo(yb[r][j].y), bf_hi(yb[r][j].y)}; }
#pragma unroll
            for (int r = 0; r < 2; ++r) if (r == 0 || two) { const int row = base + r;
                unsigned mk = mask[r];
                while (mk) {
                    const int e1 = __builtin_ctz(mk); mk &= mk - 1;
                    const int t1 = __builtin_amdgcn_readlane(so[r], e1); const float ww = __uint_as_float(__builtin_amdgcn_readlane(__float_as_uint(af[r]), e1));
                    const bf16_t* y1 = Y + (size_t)t1 * 1024 + 4 * lane;
#pragma unroll
                    for (int j = 0; j < 4; ++j) { const u32x2 yv = *(const u32x2*)(y1 + 256 * j); cacc[r][j] = cacc[r][j] + ww * (f32x4){bf_lo(yv.x), bf_hi(yv.x), bf_lo(yv.y), bf_hi(yv.y)}; }
                }
                if (mr[r] == mr_c) {
#pragma unroll
                    for (int j = 0; j < 4; ++j) v[r][j] = v[r][j] + g2c[j] * cacc[r][j];
                } else { const float* g2 = MOD + (size_t)(lp * 5 + mr[r]) * 6144 + 5120;
#pragma unroll
                    for (int j = 0; j < 4; ++j) v[r][j] = v[r][j] + *(const f32x4*)(g2 + 256 * j + 4 * lane) * cacc[r][j]; }
                if (MODE == 1) {
#pragma unroll
                    for (int j = 0; j < 4; ++j) *(f32x4*)(X + (size_t)row * DM + 256 * j + 4 * lane) = v[r][j];
                }
            }
        }
        float rms[2];
#pragma unroll
        for (int r = 0; r < 2; ++r) { float ss = 0.f;
#pragma unroll
            for (int j = 0; j < 4; ++j) ss += (v[r][j].x * v[r][j].x + v[r][j].y * v[r][j].y) + (v[r][j].z * v[r][j].z + v[r][j].w * v[r][j].w);
            rms[r] = 1.0f / sqrtf(wave_sum(ss) * (1.f / DM) + 1e-6f); }
        if (MODE == 3) {
#pragma unroll
            for (int r = 0; r < 2; ++r) if (r == 0 || two) {
#pragma unroll
                for (int j = 0; j < 4; ++j) *(f32x4*)(a.out + (size_t)(base + r) * DM + 256 * j + 4 * lane) = v[r][j] * rms[r] * fng[j]; }
        } else {
            const float* gv = (MODE == 2 ? a.in[I_N2G] : a.in[I_N1G]) + (size_t)l * DM;
#pragma unroll
            for (int r = 0; r < 2; ++r) {
                if (mr[r] == mr_c) {
#pragma unroll
                    for (int j = 0; j < 4; ++j) v[r][j] = (v[r][j] * rms[r]) * gsc[j] + shf[j];
                } else { const float* mb = MOD + (size_t)(l * 5 + mr[r]) * 6144 + (MODE == 2 ? 3072 : 0);
#pragma unroll
                    for (int j = 0; j < 4; ++j) { const int k = 256 * j + 4 * lane; v[r][j] = (v[r][j] * rms[r] * *(const f32x4*)(gv + k)) * (1.f + *(const f32x4*)(mb + 1024 + k)) + *(const f32x4*)(mb + k); } }
#pragma unroll
                for (int j = 0; j < 4; ++j) if (r == 0 || two) st_bf4(H + (size_t)(base + r) * DM + 256 * j + 4 * lane, v[r][j]); }
            if (MODE == 2) {
                float lg[2][16];
#pragma unroll
                for (int e = 0; e < 16; ++e) { float s0 = 0.f, s1 = 0.f;
#pragma unroll
                    for (int j = 0; j < 4; ++j) { const f32x4 w4 = *(const LAS f32x4*)(wr_l + e * WRP + 256 * j + 4 * lane);
                        s0 += (v[0][j].x * w4.x + v[0][j].y * w4.y) + (v[0][j].z * w4.z + v[0][j].w * w4.w);
                        s1 += (v[1][j].x * w4.x + v[1][j].y * w4.y) + (v[1][j].z * w4.z + v[1][j].w * w4.w); }
                    if (e & 1) asm volatile("" : "+v"(s0), "+v"(s1) :: "memory");
                    lg[0][e] = s0; lg[1][e] = s1; }
#pragma unroll
                for (int r = 0; r < 2; ++r) {
                    float a8[8], a4[4], a2[2], a1;
                    const bool b0 = lane & 1, b1 = lane & 2, b2 = lane & 4, b3 = lane & 8;
#pragma unroll
                    for (int i = 0; i < 8; ++i) { const float snd = b0 ? lg[r][i] : lg[r][i + 8], kp = b0 ? lg[r][i + 8] : lg[r][i]; a8[i] = kp + __shfl_xor(snd, 1); }
#pragma unroll
                    for (int i = 0; i < 4; ++i) { const float snd = b1 ? a8[i] : a8[i + 4], kp = b1 ? a8[i + 4] : a8[i]; a4[i] = kp + __shfl_xor(snd, 2); }
#pragma unroll
                    for (int i = 0; i < 2; ++i) { const float snd = b2 ? a4[i] : a4[i + 2], kp = b2 ? a4[i + 2] : a4[i]; a2[i] = kp + __shfl_xor(snd, 4); }
                    { const float snd = b3 ? a2[0] : a2[1], kp = b3 ? a2[1] : a2[0]; a1 = kp + __shfl_xor(snd, 8); }
                    a1 += __shfl_xor(a1, 16); a1 += __shfl_xor(a1, 32);
                    float mx = a1;
#pragma unroll
                    for (int o = 1; o < 16; o <<= 1) mx = fmaxf(mx, __shfl_xor(mx, o));
                    const float ex = expf(a1 - mx); float sum = ex;
#pragma unroll
                    for (int o = 1; o < 16; o <<= 1) sum += __shfl_xor(sum, o);
                    const int e = (b0 ? 8 : 0) + (b1 ? 4 : 0) + (b2 ? 2 : 0) + (b3 ? 1 : 0);
                    if (lane < 16 && (r == 0 || two)) AFF[(size_t)(base + r) * 16 + e] = ex / sum;
                }
            }
        }
    }
    __syncthreads();
}

DI void norm2_phase(const Args& a, int l, LAS unsigned char* lds, int G, int c) {
    const int tid = threadIdx.x, wid = __builtin_amdgcn_readfirstlane(tid >> 6), lane = tid & 63;
    unsigned char* ws = a.ws;
    const float* X = (const float*)(ws + WS_X); bf16_t* H = (bf16_t*)(ws + WS_H); const float* MOD = (const float*)(ws + WS_MOD); float* AFF = (float*)(ws + WS_AFF);
    const bf16_t* DL = (const bf16_t*)(ws + WS_DELTA);
    auto xrow = [&](int row) __attribute__((always_inline)) -> const float* { return l == 0 ? (row < TL ? a.in[I_X] + (size_t)row * DM : a.in[I_CTX] + (size_t)(row - TL) * DM) : X + (size_t)row * DM; };
    LAS float* wr_l = (LAS float*)lds;
    constexpr int WRP = 1028;
    { const f32x4* wsrc = (const f32x4*)(a.in[I_WR] + (size_t)l * 16384); f32x4 wv[8];
#pragma unroll
      for (int i = 0; i < 8; ++i) wv[i] = wsrc[tid + 512 * i];
#pragma unroll
      for (int i = 0; i < 8; ++i) { const int q = tid + 512 * i, k = q >> 2, e0 = (q & 3) * 4;
          wr_l[(e0 + 0) * WRP + k] = wv[i].x; wr_l[(e0 + 1) * WRP + k] = wv[i].y; wr_l[(e0 + 2) * WRP + k] = wv[i].z; wr_l[(e0 + 3) * WRP + k] = wv[i].w; }
      __syncthreads(); }
    const int rpb = (TT + G - 1) / G; const int r0 = c * rpb; const int r1 = (r0 + rpb) < TT ? (r0 + rpb) : TT;
    const float* gv = a.in[I_N2G] + (size_t)l * DM;
    f32x4 gsc[4], shf[4]; int mr_c = -1;
    f32x4 vn[4]; u32x2 dn[4];
    if (r0 + wid < r1) { const float* xr = xrow(r0 + wid);
#pragma unroll
        for (int j = 0; j < 4; ++j) { vn[j] = *(const f32x4*)(xr + 256 * j + 4 * lane); dn[j] = *(const u32x2*)(DL + (size_t)(r0 + wid) * DM + 256 * j + 4 * lane); } }
    for (int row = r0 + wid; row < r1; row += 8) {
        f32x4 v[4];
#pragma unroll
        for (int j = 0; j < 4; ++j) v[j] = vn[j] + (f32x4){bf_lo(dn[j].x), bf_hi(dn[j].x), bf_lo(dn[j].y), bf_hi(dn[j].y)};
        if (row + 8 < r1) { const float* xr = xrow(row + 8);
#pragma unroll
            for (int j = 0; j < 4; ++j) { vn[j] = *(const f32x4*)(xr + 256 * j + 4 * lane); dn[j] = *(const u32x2*)(DL + (size_t)(row + 8) * DM + 256 * j + 4 * lane); } }
        const int mr = row < TL ? (row >> 12) : 4;
        float ss = 0.f;
#pragma unroll
        for (int j = 0; j < 4; ++j) ss += (v[j].x * v[j].x + v[j].y * v[j].y) + (v[j].z * v[j].z + v[j].w * v[j].w);
        const float rms = 1.0f / sqrtf(wave_sum(ss) * (1.f / DM) + 1e-6f);
        if (mr != mr_c) { mr_c = mr; const float* mb = MOD + (size_t)(l * 5 + mr) * 6144 + 3072;
#pragma unroll
            for (int j = 0; j < 4; ++j) { const int k = 256 * j + 4 * lane; gsc[j] = *(const f32x4*)(gv + k) * (1.f + *(const f32x4*)(mb + 1024 + k)); shf[j] = *(const f32x4*)(mb + k); } }
#pragma unroll
        for (int j = 0; j < 4; ++j) { const int k = 256 * j + 4 * lane;
            v[j] = (v[j] * rms) * gsc[j] + shf[j];
            st_bf4(H + (size_t)row * DM + k, v[j]); }
        float lg[16];
#pragma unroll
        for (int e = 0; e < 16; ++e) { float s0 = 0.f;
#pragma unroll
            for (int j = 0; j < 4; ++j) { const f32x4 w4 = *(const LAS f32x4*)(wr_l + e * WRP + 256 * j + 4 * lane); s0 += (v[j].x * w4.x + v[j].y * w4.y) + (v[j].z * w4.z + v[j].w * w4.w); }
            if ((e & 3) == 3) asm volatile("" : "+v"(s0) :: "memory");
            lg[e] = s0; }
        float a8[8], a4[4], a2[2], a1;
        const bool b0 = lane & 1, b1 = lane & 2, b2 = lane & 4, b3 = lane & 8;
#pragma unroll
        for (int i = 0; i < 8; ++i) { const float snd = b0 ? lg[i] : lg[i + 8], kp = b0 ? lg[i + 8] : lg[i]; a8[i] = kp + __shfl_xor(snd, 1); }
#pragma unroll
        for (int i = 0; i < 4; ++i) { const float snd = b1 ? a8[i] : a8[i + 4], kp = b1 ? a8[i + 4] : a8[i]; a4[i] = kp + __shfl_xor(snd, 2); }
#pragma unroll
        for (int i = 0; i < 2; ++i) { const float snd = b2 ? a4[i] : a4[i + 2], kp = b2 ? a4[i + 2] : a4[i]; a2[i] = kp + __shfl_xor(snd, 4); }
        { const float snd = b3 ? a2[0] : a2[1], kp = b3 ? a2[1] : a2[0]; a1 = kp + __shfl_xor(snd, 8); }
        a1 += __shfl_xor(a1, 16); a1 += __shfl_xor(a1, 32);
        float mx = a1;
#pragma unroll
        for (int o = 1; o < 16; o <<= 1) mx = fmaxf(mx, __shfl_xor(mx, o));
        const float ex = expf(a1 - mx); float sum = ex;
#pragma unroll
        for (int o = 1; o < 16; o <<= 1) sum += __shfl_xor(sum, o);
        const int e = (b0 ? 8 : 0) + (b1 ? 4 : 0) + (b2 ? 2 : 0) + (b3 ? 1 : 0);
        if (lane < 16) AFF[(size_t)row * 16 + e] = ex / sum;
    }
    __syncthreads();
}

constexpr int KPITCH = 144, VPITCH = 272;
constexpr int ATT_K = 0, ATT_V = 128 * KPITCH, ATT_WS = ATT_V + 64 * VPITCH;

DI void attn_seg(int kind, int qb, int tq0, int ctx0, int i, int& tok0, int& mode) {
    mode = 0;
    if (kind == 1) { tok0 = ctx0 + i * 128; return; }
    if (i == 0) tok0 = tq0;
    else if (i < 3) tok0 = ctx0 + (i - 1) * 128;
    else if (i == 3 && qb > 0) { tok0 = tq0 - 128; mode = 1; }
    else { tok0 = tq0 + 128; mode = 2; }
}
DI void attn_unit(const Args& a, int l, LAS unsigned char* lds, int kind, int b, int qb, int kh, int hh) {
    const int tid = threadIdx.x, lane = tid & 63, r32 = lane & 31, hi = lane >> 5; const int wid = __builtin_amdgcn_readfirstlane(tid >> 6);
    unsigned char* ws = a.ws;
    const bf16_t* Q = (const bf16_t*)(ws + WS_Q); const bf16_t* Kb = (const bf16_t*)(ws + WS_K); const bf16_t* VT = (const bf16_t*)(ws + WS_VT); bf16_t* BR = (bf16_t*)(ws + WS_BR);
    const int tq0 = kind == 0 ? b * SEQ + qb * 128 : TL + b * CTXL + qb * 128;
    const int ctx0 = TL + b * CTXL;
    const int h = kh * 4 + hh * 2 + (wid >> 2), qs = (wid & 3) * 32;
    const int qi = qs + r32;
    LAS float* wsf = (LAS float*)(lds + ATT_WS) + wid * 64;
    const int nseg = kind == 0 ? 3 + (qb > 0 ? 1 : 0) + (qb < 31 ? 1 : 0) : 2;
    const int krow = tid >> 3, kch = tid & 7, vrow = tid >> 4, vch = tid & 15;
    u32x4 kreg[2], vreg[2];
    { int tok0, mode; attn_seg(kind, qb, tq0, ctx0, 0, tok0, mode);
#pragma unroll
      for (int i = 0; i < 2; ++i) { kreg[i] = *(const u32x4*)(Kb + (size_t)(tok0 + krow + 64 * i) * 128 + kh * 64 + kch * 8); vreg[i] = *(const u32x4*)(VT + (size_t)(kh * 64 + vrow + 32 * i) * TT + tok0 + vch * 8); } }
    bf16x8 qf[4];
#pragma unroll
    for (int s = 0; s < 4; ++s) qf[s] = *(const bf16x8*)(Q + (size_t)(tq0 + qi) * 512 + h * 64 + s * 16 + hi * 8);
    float mrun = -1e30f, lrun = 0.f;
    f32x16 o[2];
#pragma unroll
    for (int d0 = 0; d0 < 2; ++d0)
#pragma unroll
        for (int r = 0; r < 16; ++r) o[d0][r] = 0.f;
    for (int sg = 0; sg < nseg; ++sg) {
        int tok0, mode; attn_seg(kind, qb, tq0, ctx0, sg, tok0, mode);
        int lo_lim = mode == 1 ? qi : -100000, hi_lim = mode == 2 ? qi : 100000;
        asm volatile("" : "+v"(lo_lim), "+v"(hi_lim));
        __syncthreads();
#pragma unroll
        for (int i = 0; i < 2; ++i) { *(LAS u32x4*)(lds + ATT_K + (krow + 64 * i) * KPITCH + kch * 16) = kreg[i]; *(LAS u32x4*)(lds + ATT_V + (vrow + 32 * i) * VPITCH + vch * 16) = vreg[i]; }
        __syncthreads();
        if (sg + 1 < nseg) { int tn, mn; attn_seg(kind, qb, tq0, ctx0, sg + 1, tn, mn);
#pragma unroll
            for (int i = 0; i < 2; ++i) { kreg[i] = *(const u32x4*)(Kb + (size_t)(tn + krow + 64 * i) * 128 + kh * 64 + kch * 8); vreg[i] = *(const u32x4*)(VT + (size_t)(kh * 64 + vrow + 32 * i) * TT + tn + vch * 8); } }
#pragma unroll 1
        for (int tk = 0; tk < 2; ++tk) {
            if (mode == 1 && tk * 64 + 63 < qs) continue;
            if (mode == 2 && tk * 64 > qs + 31) continue;
            f32x16 s0, s1;
#pragma unroll
            for (int r = 0; r < 16; ++r) { s0[r] = 0.f; s1[r] = 0.f; }
            const LAS unsigned char* kp = lds + ATT_K + (tk * 64 + r32) * KPITCH + hi * 16;
#pragma unroll
            for (int s = 0; s < 4; ++s) {
                const bf16x8 k0 = *(const LAS bf16x8*)(kp + s * 32);
                const bf16x8 k1 = *(const LAS bf16x8*)(kp + 32 * KPITCH + s * 32);
                s0 = __builtin_amdgcn_mfma_f32_32x32x16_bf16(k0, qf[s], s0, 0, 0, 0);
                s1 = __builtin_amdgcn_mfma_f32_32x32x16_bf16(k1, qf[s], s1, 0, 0, 0);
            }
            asm volatile("s_nop 15\n\ts_nop 7" : "+v"(s0), "+v"(s1));
            if (mode != 0) {
                const int kb0 = tk * 64 + 4 * hi;
#pragma unroll
                for (int r = 0; r < 16; ++r) { const int kj = kb0 + (r & 3) + 8 * (r >> 2);
                    if (kj < lo_lim || kj > hi_lim) s0[r] = -1e30f;
                    if (kj + 32 < lo_lim || kj + 32 > hi_lim) s1[r] = -1e30f; }
            }
            float tm = mrun;
            float tm2 = s0[0];
#pragma unroll
            for (int r = 0; r < 16; r += 2) { tm = max3f(tm, s0[r], s1[r]); tm2 = max3f(tm2, s0[r + 1], s1[r + 1]); }
            tm = max3f(tm, tm2, __shfl_xor(max3f(tm, tm2, tm2), 32));
            const float mnew = tm;
            typedef float f32x2 __attribute__((ext_vector_type(2)));
            f32x2 ls2 = {0.f, 0.f}; const f32x2 m2 = {mnew, mnew};
#pragma unroll
            for (int r = 0; r < 16; r += 2) {
                f32x2 a = (f32x2){s0[r], s0[r + 1]} - m2, b = (f32x2){s1[r], s1[r + 1]} - m2;
                a.x = __builtin_amdgcn_exp2f(a.x); a.y = __builtin_amdgcn_exp2f(a.y); b.x = __builtin_amdgcn_exp2f(b.x); b.y = __builtin_amdgcn_exp2f(b.y);
                s0[r] = a.x; s0[r + 1] = a.y; s1[r] = b.x; s1[r + 1] = b.y; ls2 = ls2 + a + b; }
            const float ls = ls2.x + ls2.y;
            if (__any(mnew > mrun)) {
                const float alpha = __builtin_amdgcn_exp2f(mrun - mnew);
                lrun *= alpha;
                if (hi == 0) wsf[r32] = alpha;
#pragma unroll
                for (int r = 0; r < 16; ++r) { const float f = wsf[crow(r, hi)]; o[0][r] *= f; o[1][r] *= f; }
            }
            mrun = mnew; lrun += ls;
            const LAS unsigned char* vp0 = lds + ATT_V + r32 * VPITCH + (tk * 64 + 4 * hi) * 2;
#pragma unroll
            for (int cc = 0; cc < 2; ++cc)
#pragma unroll
                for (int s = 0; s < 2; ++s) {
                    u32x4 pw;
                    if (cc == 0) { pw.x = pk_bf16(s0[8 * s], s0[8 * s + 1]); pw.y = pk_bf16(s0[8 * s + 2], s0[8 * s + 3]); pw.z = pk_bf16(s0[8 * s + 4], s0[8 * s + 5]); pw.w = pk_bf16(s0[8 * s + 6], s0[8 * s + 7]); }
                    else { pw.x = pk_bf16(s1[8 * s], s1[8 * s + 1]); pw.y = pk_bf16(s1[8 * s + 2], s1[8 * s + 3]); pw.z = pk_bf16(s1[8 * s + 4], s1[8 * s + 5]); pw.w = pk_bf16(s1[8 * s + 6], s1[8 * s + 7]); }
                    const bf16x8 pa = __builtin_bit_cast(bf16x8, pw);
#pragma unroll
                    for (int d0 = 0; d0 < 2; ++d0) {
                        const LAS unsigned char* vp = vp0 + d0 * 32 * VPITCH + (cc * 32 + s * 16) * 2;
                        const s16x4 lo = *(const LAS s16x4*)vp, hh2 = *(const LAS s16x4*)(vp + 16);
                        const bf16x8 vb = (bf16x8){lo[0], lo[1], lo[2], lo[3], hh2[0], hh2[1], hh2[2], hh2[3]};
                        o[d0] = __builtin_amdgcn_mfma_f32_32x32x16_bf16(pa, vb, o[d0], 0, 0, 0);
                    }
                }
        }
    }
    const float sk = a.in[I_SINK][l * 8 + h] * LOG2E;
    {
        const float lt = lrun + __shfl_xor(lrun, 32) + __builtin_amdgcn_exp2f(sk - mrun);
        if (hi == 0) wsf[r32] = 1.f / lt;
#pragma unroll
        for (int r = 0; r < 16; ++r) { const float f = wsf[crow(r, hi)]; bf16_t* op = BR + (size_t)(tq0 + qs + crow(r, hi)) * 1536 + h * 64 + r32;
            op[0] = f2bf(o[0][r] * f); op[32] = f2bf(o[1][r] * f); }
    }
    __syncthreads();
}

DI void seq_bounds(int t0, int& lo, int& hi) { if (t0 < TL) { lo = t0 & ~(SEQ - 1); hi = lo + SEQ; } else { lo = TL + ((t0 - TL) & ~(CTXL - 1)); hi = lo + CTXL; } }

DI void conv_unit(const Args& a, int l, LAS unsigned char* lds, int t0) {
    const int tid = threadIdx.x, lane = tid & 63; const int wid = __builtin_amdgcn_readfirstlane(tid >> 6);
    const bf16_t* U = (const bf16_t*)(a.ws + WS_U); bf16_t* BR = (bf16_t*)(a.ws + WS_BR);
    int slo, shi; seq_bounds(t0, slo, shi);
    const int c = tid; float w[31];
#pragma unroll
    for (int k = 0; k < 31; ++k) w[k] = a.in[I_CDW][((size_t)l * 31 + k) * 512 + c];
    const float bias = a.in[I_CDWB][l * 512 + c];
    { u32x4 tv[8];
#pragma unroll
      for (int i = 0; i < 8; ++i) { const int idx = tid + 512 * i; const int row = idx >> 6, ch = idx & 63; const int tok = t0 - 15 + row; tv[i] = (u32x4){0u, 0u, 0u, 0u};
          if (row < 62 && tok >= slo && tok < shi) tv[i] = *(const u32x4*)(U + (size_t)tok * 512 + ch * 8); }
#pragma unroll
      for (int i = 0; i < 8; ++i) { const int idx = tid + 512 * i; const int row = idx >> 6, ch = idx & 63; if (row < 62) *(LAS u32x4*)(lds + row * 1024 + ch * 16) = tv[i]; } }
    __syncthreads();
    float xin[62];
#pragma unroll
    for (int i = 0; i < 62; ++i) xin[i] = bf2f(((const LAS bf16_t*)lds)[i * 512 + c]);
    LAS float* cs = (LAS float*)(lds + 65536);
#pragma unroll
    for (int t = 0; t < 32; ++t) { float acc = bias;
#pragma unroll
        for (int k = 0; k < 31; ++k) acc = fmaf(xin[t + k], w[k], acc);
        cs[t * 512 + c] = acc; }
    __syncthreads();
    const float* lg = a.in[I_CLNG] + l * 512; const float* lb = a.in[I_CLNB] + l * 512;
#pragma unroll
    for (int tt = 0; tt < 4; ++tt) { const int t = 4 * wid + tt; float v[8]; float s = 0.f;
#pragma unroll
        for (int i = 0; i < 8; ++i) { v[i] = cs[t * 512 + lane + 64 * i]; s += v[i]; }
        const float mean = wave_sum(s) * (1.f / 512.f); float q = 0.f;
#pragma unroll
        for (int i = 0; i < 8; ++i) { v[i] -= mean; q += v[i] * v[i]; }
        const float rstd = 1.0f / sqrtf(wave_sum(q) * (1.f / 512.f) + 1e-6f);
#pragma unroll
        for (int i = 0; i < 8; ++i) { const int c2 = lane + 64 * i; const float y = v[i] * rstd * lg[c2] + lb[c2]; BR[(size_t)(t0 + t) * 1536 + 512 + c2] = f2bf(y * sigm(y)); } }
    __syncthreads();
}
template <int HALF> DI void pool_compute(const LAS bf16_t* zs, int c, int t0, int slo, int shi, bf16_t* BR) {
    float P[49];
    float zc[32];
    P[0] = 0.f;
#pragma unroll
    for (int r = 0; r < 48; ++r) { const float z = bf2f(zs[r * 512 + c]); P[r + 1] = P[r] + z; if (r >= 8 && r < 40) zc[r - 8] = z; }
#pragma unroll
    for (int t = 0; t < 32; ++t) { const int tt = t0 + t; const int lo = (tt - HALF) > slo ? (tt - HALF) : slo, hi = (tt + HALF) < shi ? (tt + HALF) : shi;
        const float d = (P[t + 8 + HALF] - P[t + 8 - HALF]) * __builtin_amdgcn_rcpf((float)(hi - lo)) - zc[t];
        BR[(size_t)tt * 1536 + 1024 + c] = f2bf(d); }
}
DI void pool_unit(const Args& a, LAS unsigned char* lds, int t0) {
    const int tid = threadIdx.x;
    const bf16_t* Z = (const bf16_t*)(a.ws + WS_Z); bf16_t* BR = (bf16_t*)(a.ws + WS_BR);
    int slo, shi; seq_bounds(t0, slo, shi);
    { u32x4 tv[6];
#pragma unroll
      for (int i = 0; i < 6; ++i) { const int idx = tid + 512 * i; const int row = idx >> 6, ch = idx & 63; const int tok = t0 - 8 + row; tv[i] = (u32x4){0u, 0u, 0u, 0u};
          if (tok >= slo && tok < shi) tv[i] = *(const u32x4*)(Z + (size_t)tok * 512 + ch * 8); }
#pragma unroll
      for (int i = 0; i < 6; ++i) { const int idx = tid + 512 * i; const int row = idx >> 6, ch = idx & 63; *(LAS u32x4*)(lds + row * 1024 + ch * 16) = tv[i]; } }
    __syncthreads();
    const int c = tid; const int gi = __builtin_amdgcn_readfirstlane(c >> 7); const LAS bf16_t* zs = (const LAS bf16_t*)lds;
    if (gi == 0) pool_compute<1>(zs, c, t0, slo, shi, BR); else if (gi == 1) pool_compute<2>(zs, c, t0, slo, shi, BR);
    else if (gi == 2) pool_compute<4>(zs, c, t0, slo, shi, BR); else pool_compute<8>(zs, c, t0, slo, shi, BR);
    __syncthreads();
}
DI void phase_mix(const Args& a, int l, LAS unsigned char* lds, int G, int c, const SchedInProj& SI, const EpiInProj& EI) {
    for (int u = c; u < 512; u += G) attn_unit(a, l, lds, 0, u >> 7, (u >> 2) & 31, (u >> 1) & 1, u & 1);
    const int ng = (SI.hi - SI.lo) < G ? (SI.hi - SI.lo) : G;
    const int nconv = l == 0 ? TT / 32 : TL / 32;
    const bool gblk = c < ng; const int nrest = G - ng;
    const int sg = nrest > 0 ? (l == 0 ? 130 : 40) : 256;
    const int ncg = ng > 0 ? (nconv * sg) >> 8 : 0;
    const int jb = gblk ? 0 : ncg, j1 = gblk ? ncg : nconv, js = gblk ? ng : nrest, ci = gblk ? c : c - ng;
    for (int j = jb + ci; j < j1; j += js) conv_unit(a, l, lds, j * 32);
    for (int j = jb + (js - 1 - ci); j < j1; j += js) pool_unit(a, lds, j * 32);
    if (l == 0) { const int x0 = nrest >= 32 ? c - ng : c;
        if (x0 >= 0) for (int x = x0; x < 32; x += (nrest >= 32 ? nrest : G)) attn_unit(a, l, lds, 1, x >> 3, (x >> 2) & 1, (x >> 1) & 1, x & 1); }
    if (ng > 0) pg8::gemm_phase(lds, SI, EI);
}

DI void topk_unit(const Args& a, LAS unsigned char* lds, int set, int e) {
    const int tid = threadIdx.x, lane = tid & 63, wid = tid >> 6; const bool lat = set < 4; const int b = set & 3;
    const int N = lat ? SEQ : CTXL, cap = N / 8, tok0 = lat ? b * SEQ : TL + b * CTXL, sbase = e * ESLOT + (lat ? b * 512 : 2048 + b * 32);
    const float* AFF = (const float*)(a.ws + WS_AFF); int* SLOTOF = (int*)(a.ws + WS_SLOTOF); int* TOKOF = (int*)(a.ws + WS_TOKOF);
    LAS unsigned* hist = (LAS unsigned*)lds; LAS unsigned* wtot = hist + 256; LAS unsigned* bc = hist + 272;
    int nvalid = N - tid * 8; nvalid = nvalid < 0 ? 0 : (nvalid > 8 ? 8 : nvalid);
    unsigned v[8];
#pragma unroll
    for (int j = 0; j < 8; ++j) v[j] = j < nvalid ? __float_as_uint(AFF[(size_t)(tok0 + tid * 8 + j) * 16 + e]) : 0u;
    unsigned prefix = 0u, pmask = 0u; unsigned need = (unsigned)cap;
#pragma unroll 1
    for (int r = 0; r < 4; ++r) {
        const int shift = 24 - 8 * r;
        if (tid < 256) hist[tid] = 0u;
        __syncthreads();
#pragma unroll
        for (int j = 0; j < 8; ++j) if (j < nvalid && (v[j] & pmask) == prefix) __hip_atomic_fetch_add(&hist[(v[j] >> shift) & 255u], 1u, __ATOMIC_RELAXED, __HIP_MEMORY_SCOPE_WORKGROUP);
        __syncthreads();
        unsigned hv = 0u, suf = 0u;
        if (tid < 256) { hv = hist[tid]; suf = hv;
#pragma unroll
            for (int o = 1; o < 64; o <<= 1) { const unsigned t = __shfl_down(suf, o); if (lane + o < 64) suf += t; }
            if (lane == 0) wtot[wid] = suf; }
        __syncthreads();
        if (tid < 256) { unsigned above = 0u; for (int w = wid + 1; w < 4; ++w) above += wtot[w];
            suf += above; const unsigned sn = suf - hv;
            if (suf >= need && sn < need) { bc[0] = (unsigned)tid; bc[1] = need - sn; } }
        __syncthreads();
        prefix |= bc[0] << shift; pmask |= 255u << shift; need = bc[1];
    }
    const unsigned T = prefix, need_eq = need, count_gt = (unsigned)cap - need_eq;
    unsigned cg = 0u, ce = 0u;
#pragma unroll
    for (int j = 0; j < 8; ++j) if (j < nvalid) { cg += v[j] > T ? 1u : 0u; ce += v[j] == T ? 1u : 0u; }
    const unsigned pk = cg | (ce << 16); unsigned inc = pk;
#pragma unroll
    for (int o = 1; o < 64; o <<= 1) { const unsigned t = __shfl_up(inc, o); if (lane >= o) inc += t; }
    if (lane == 63) wtot[wid] = inc;
    __syncthreads();
    unsigned basev = 0u; for (int w = 0; w < wid; ++w) basev += wtot[w];
    const unsigned ex = basev + inc - pk; unsigned rg = ex & 0xffffu, re = ex >> 16;
#pragma unroll
    for (int j = 0; j < 8; ++j) if (j < nvalid) { const int tok = tok0 + tid * 8 + j; int slot = -1;
        if (v[j] > T) { slot = sbase + (int)rg; ++rg; } else if (v[j] == T) { if (re < need_eq) slot = sbase + (int)(count_gt + re); ++re; }
        SLOTOF[(size_t)tok * 16 + e] = slot; if (slot >= 0) TOKOF[slot] = tok; }
    if (set == 4 && tid < 128) TOKOF[e * ESLOT + 2176 + tid] = 0;
    __syncthreads();
}

#define XB_TMO      128
#define XB_XCNT(j)  (256  + 64 * (j))
#define XB_XSUB(j)  (1280 + 64 * (j))
#define XB_XGEN(j)  (2304 + 64 * (j))
#define XB_TOP      3328
#define XB_TOPGEN   3392
#define XCD_BAR_WORDS 3456
#define XB_SPIN_CAP (1u << 22)
DI unsigned xb_ld(unsigned* p) { return __hip_atomic_load(p, __ATOMIC_RELAXED, __HIP_MEMORY_SCOPE_AGENT); }
DI unsigned xb_add(unsigned* p, unsigned v) { return __hip_atomic_fetch_add(p, v, __ATOMIC_RELAXED, __HIP_MEMORY_SCOPE_AGENT); }
DI unsigned xb_xcc_id() { return (unsigned)__builtin_amdgcn_s_getreg((3 << 11) | 20) & 0xFu; }
#define XB_SPIN(cond, bar) do { unsigned _sp = 0; while (cond) { __builtin_amdgcn_s_sleep(1); \
    if ((++_sp & 255u) == 0u) { if (xb_ld(&(bar)[XB_TMO])) break; if (_sp > XB_SPIN_CAP) { atomicAdd(&(bar)[XB_TMO], 1u); break; } } } } while (0)
struct XcdBarrier { unsigned* bar; unsigned x; volatile LAS unsigned* st; };
DI XcdBarrier xcd_barrier_post(unsigned* bar, volatile LAS unsigned* st) {
    XcdBarrier b; b.bar = bar; b.x = xb_xcc_id(); b.st = st;
    if (threadIdx.x == 0) (void)xb_add(&bar[XB_XCNT(b.x)], 1u);
    return b;
}
DI void xcd_barrier_complete(unsigned* bar, unsigned x, unsigned& nloc, unsigned& nx) {
    const unsigned G = gridDim.x * gridDim.y * gridDim.z;
    unsigned sum, cnt, mine, sp = 0u;
    for (;;) {
        sum = 0u; cnt = 0u; mine = 0u;
#pragma unroll
        for (unsigned j = 0; j < 16; ++j) { const unsigned c = xb_ld(&bar[XB_XCNT(j)]); sum += c; cnt += (c > 0u) ? 1u : 0u; mine = (j == x) ? c : mine; }
        if (sum == G) break;
        __builtin_amdgcn_s_sleep(1);
        if ((++sp & 255u) == 0u) { if (xb_ld(&bar[XB_TMO])) break; if (sp > XB_SPIN_CAP) { atomicAdd(&bar[XB_TMO], 1u); break; } }
    }
    nloc = mine > 0u ? mine : 1u; nx = cnt > 0u ? cnt : 1u;
}
DI void xcd_barrier(const XcdBarrier& b) {
    asm volatile("s_waitcnt vmcnt(0)" ::: "memory");
    __syncthreads();
    if (threadIdx.x == 0) {
        unsigned* bar = b.bar;
        __builtin_amdgcn_s_waitcnt(0);
        unsigned nloc = b.st[0], nx = b.st[1];
        if (nloc == 0u) { xcd_barrier_complete(bar, b.x, nloc, nx); b.st[0] = nloc; b.st[1] = nx; }
        const unsigned old = xb_add(&bar[XB_XSUB(b.x)], 1u);
        const unsigned gen = old / nloc;
        if (old + 1u == (gen + 1u) * nloc) {
            __builtin_amdgcn_fence(__ATOMIC_RELEASE, "agent");
            asm volatile("s_waitcnt vmcnt(0)" ::: "memory");
            const unsigned og = xb_add(&bar[XB_TOP], 1u);
            const unsigned tg = og / nx;
            if (og + 1u == (tg + 1u) * nx) xb_add(&bar[XB_TOPGEN], 1u);
            else XB_SPIN(xb_ld(&bar[XB_TOPGEN]) == tg, bar);
            __builtin_amdgcn_fence(__ATOMIC_ACQUIRE, "agent");
            xb_add(&bar[XB_XGEN(b.x)], 1u);
            asm volatile("s_waitcnt vmcnt(0)" ::: "memory");
        } else {
            XB_SPIN(xb_ld(&bar[XB_XGEN(b.x)]) == gen, bar);
            __builtin_amdgcn_fence(__ATOMIC_ACQUIRE, "agent");
            asm volatile("s_waitcnt vmcnt(0)" ::: "memory");
        }
    }
    __syncthreads();
}

#if !MK_PER_PHASE
#define GRID_BAR() xcd_barrier(bar)
#else
#define GRID_BAR() do {} while (0)
#endif
#ifndef PROBE_DUP
#define PROBE_DUP 0
#endif
#define REPS(bit) (1 + ((PROBE_DUP >> (bit)) & 1))
#define REP(bit) for (int _r = 0; _r < REPS(bit); ++_r)
#define REPU(bit) _Pragma("unroll") for (int _r = 0; _r < REPS(bit); ++_r)
#define REPBAR() do { if (_r) GRID_BAR(); } while (0)
#define IN(k) (lo <= (k) && (k) < hi)
#ifndef PROBE_SPIN
#define PROBE_SPIN (-1)
#endif
#ifndef PROBE_SPIN_END
#define PROBE_SPIN_END (PROBE_SPIN + 1)
#endif
#ifndef PROBE_MULT
#define PROBE_MULT 4
#endif
#define STAMP(k) do { if (PROBE_SPIN >= 0 && blockIdx.x == 0 && threadIdx.x == 0) ((volatile LAS unsigned long long*)(lds + LDS_MISC_OFF + 256))[k] = __builtin_amdgcn_s_memrealtime(); } while (0)
#define SEAM(k) do { if (lo < (k) && (k) < hi) GRID_BAR(); STAMP(k); } while (0)

DI void gu_run(const Args& a, int l, LAS unsigned char* lds, int G, int c, int lo, int hi, int c0) {
    unsigned char* ws = a.ws; const int tid = threadIdx.x;
    const int* TOKOF = (const int*)(ws + WS_TOKOF); LAS int* idx = (LAS int*)(lds + LDS_IDX_OFF);
    if (c0 < 0) return;
    for (int ibase = 0; lo + ibase * G + c0 < hi; ibase += 8) {
        __syncthreads();
        for (int q = tid; q < 8 * 256; q += 512) { const int i = q >> 8; const int Lu = lo + (ibase + i) * G + c0;
            if (Lu < hi) { int e, mt, n8; gu_decode(Lu, e, mt, n8); idx[q] = TOKOF[e * ESLOT + mt * 256 + (q & 255)]; } }
        __syncthreads();
        SchedGU S; S.nt = 16; S.ldb_b = 2048; S.lda_b = 2048; S.G = G; S.c = c; S.A = (const char*)(ws + WS_H); S.B = (const char*)(ws + ws_wgu(l)); S.lo = lo; S.hi = hi; S.c0 = c0; S.ibase = ibase; S.idx = idx;
        EpiGU E{(bf16_t*)(ws + WS_ACT)};
        pg8::gemm_phase(lds, S, E);
    }
}

template <int L> DI void run_layer(const Args& a, LAS unsigned char* lds, int G, int c, int lo, int hi, const XcdBarrier& bar) {
    unsigned char* ws = a.ws;
    constexpr int l = L, base = 1 + 9 * L, nM = L == 0 ? 68 : 64, nmt = L == 0 ? 9 : 8;
    const int tid = threadIdx.x;
    SEAM(base + 0);
    if (IN(base + 0)) { if (L == 0) { REP(0) { REPBAR(); norm_phase<0>(a, 0, lds, G, c); } } else norm_phase<1>(a, 1, lds, G, c); }
    SEAM(base + 1);
#define MK_INPROJ_SCHED(SI, EI) \
    SchedInProj SI; SI.nt = 16; SI.ldb_b = 2048; SI.lda_b = 2048; SI.G = G; SI.c = c; SI.A = (const char*)(ws + WS_H); SI.B = (const char*)(ws + WS_WIN) + (size_t)l * INW * 2048; \
    SI.init_counts(nM, l == 0 ? 0 : 4); \
    const int np2 = (SI.ntot / G) * G > 0 ? (SI.ntot / G) * G : SI.ntot;      \
    const EpiInProj EI{(bf16_t*)(ws + WS_Q), (bf16_t*)(ws + WS_K), (bf16_t*)(ws + WS_VT), (bf16_t*)(ws + WS_U), (bf16_t*)(ws + WS_Z), (bf16_t*)(ws + WS_G), (const float*)(ws + WS_ROPE)};
    if (IN(base + 1)) REPU(1) { REPBAR();
        MK_INPROJ_SCHED(SI, EI)
        SI.lo = 0; SI.hi = np2;
        pg8::gemm_phase(lds, SI, EI);
    }
    SEAM(base + 2);
    if (IN(base + 2)) REP(2) { REPBAR(); MK_INPROJ_SCHED(SI, EI) SI.lo = np2; SI.hi = SI.ntot; phase_mix(a, l, lds, G, c, SI, EI); }
    SEAM(base + 3);
    if (IN(base + 3)) REP(3) { REPBAR();
        SchedMerge S; S.nt = 24; S.ldb_b = 3072; S.lda_b = 3072; S.G = G; S.c = c; S.A = (const char*)(ws + WS_BR); S.B = (const char*)(ws + WS_WMERGE) + (size_t)l * 1024 * 3072; S.nM = nM;
        EpiMerge E{(const bf16_t*)(ws + WS_G), (bf16_t*)(ws + WS_MERGED)};
        pg8::gemm_phase(lds, S, E);
        if (L == 0) convert_pull(a, 0, tid & 63);
    }
    SEAM(base + 4);
    if (IN(base + 4)) for (int _r = 0; _r < (L == 0 ? REPS(4) : 1); ++_r) { REPBAR();
        SchedOut S; S.nt = 16; S.ldb_b = 2048; S.lda_b = 2048; S.G = G; S.c = c; S.A = (const char*)(ws + WS_MERGED); S.B = (const char*)(ws + WS_WOUT) + (size_t)l * 1024 * 2048; S.nM = nM;
        EpiOut E{(bf16_t*)(ws + WS_DELTA), (const float*)(ws + WS_MOD), l};
        pg8::gemm_phase(lds, S, E);
        if (L == 0) convert_pull(a, 0, tid & 63);
    }
    SEAM(base + 5);
    if (IN(base + 5)) REP(5) { REPBAR(); norm2_phase(a, l, lds, G, c); }
    SEAM(base + 6);
    if (IN(base + 6)) REP(6) { REPBAR();
        const int nu = l == 0 ? 128 : 64;
        for (int u = c; u < nu; u += G) topk_unit(a, lds, u >> 4, u & 15);
        if (l == 1) {
            const int wid = __builtin_amdgcn_readfirstlane(tid >> 6);
            convert_experts(a, 1, c * 8 + wid, G * 8, tid & 63);
        }
    }
    SEAM(base + 7);
    if (IN(base + 7)) REP(7) { REPBAR();
        gu_run(a, l, lds, G, c, 0, NE * 64, c);
    }
    SEAM(base + 8);
    if (IN(base + 8)) REP(8) { REPBAR();
        unsigned* dep = (unsigned*)(ws + WS_BAR) + CTR_WORD0 + 4 * CTR_STRIDE;
        const int nctx = nmt > 8 ? NE * 8 : 0;
        if (nctx > 0) {
            gu_run(a, l, lds, G, c, NE * 64, NE * 64 + nctx, c < nctx ? c : -1);
            if (c < nctx && tid == 0) {
                __builtin_amdgcn_fence(__ATOMIC_RELEASE, "agent"); asm volatile("s_waitcnt vmcnt(0)" ::: "memory");
                __hip_atomic_fetch_add(dep, 1u, __ATOMIC_RELAXED, __HIP_MEMORY_SCOPE_AGENT); }
        }
        { SchedDown S; S.nt = 16; S.ldb_b = 2048; S.lda_b = 2048; S.G = G; S.c = c; S.A = (const char*)(ws + WS_ACT); S.B = (const char*)(ws + ws_wdn(l)); S.lo = 0; S.hi = NE * 32; S.c0 = c;
          EpiDown E{(bf16_t*)(ws + WS_Y)};
          pg8::gemm_phase(lds, S, E); }
        if (nctx > 0) {
            const int cd = (c >= nctx && G >= nctx + NE * 4) ? c - nctx : (G < nctx + NE * 4 ? c : -1);
            if (cd >= 0 && cd < NE * 4) {
                if (tid == 0) { unsigned sp = 0; while (__hip_atomic_load(dep, __ATOMIC_RELAXED, __HIP_MEMORY_SCOPE_AGENT) < (unsigned)nctx) { __builtin_amdgcn_s_sleep(8); if (++sp > (1u << 22)) break; }
                    __builtin_amdgcn_fence(__ATOMIC_ACQUIRE, "agent"); asm volatile("s_waitcnt vmcnt(0)" ::: "memory"); }
                __syncthreads();
            }
            SchedDown S; S.nt = 16; S.ldb_b = 2048; S.lda_b = 2048; S.G = G; S.c = c; S.A = (const char*)(ws + WS_ACT); S.B = (const char*)(ws + ws_wdn(l)); S.lo = NE * 32; S.hi = NE * 36; S.c0 = (cd >= 0 && cd < NE * 4) ? cd : -1;
            EpiDown E{(bf16_t*)(ws + WS_Y)};
            pg8::gemm_phase(lds, S, E);
        }
    }
}

__global__ void __launch_bounds__(512, 2) fwd_kernel(Args a) {
    extern __shared__ __attribute__((aligned(16))) unsigned char lds_raw[];
    LAS unsigned char* lds = (LAS unsigned char*)lds_raw;
    const int tid = threadIdx.x; const int G = gridDim.x, c = blockIdx.x;
    volatile LAS unsigned* MISC = (volatile LAS unsigned*)(lds + LDS_MISC_OFF);
    if (tid < 32) MISC[tid] = 0u;
    __syncthreads();
#if !MK_PER_PHASE
    XcdBarrier bar = xcd_barrier_post((unsigned*)(a.ws + WS_BAR), MISC + 8);
#else
    XcdBarrier bar; bar.bar = nullptr; bar.x = 0; bar.st = MISC + 8;
#endif
    const int lo = a.ph_lo, hi = a.ph_hi;
    STAMP(0);
    if (IN(0)) REP(9) { REPBAR(); phase_prep(a, lds, G, c); }
    run_layer<0>(a, lds, G, c, lo, hi, bar);
    run_layer<1>(a, lds, G, c, lo, hi, bar);
    SEAM(NPHASE - 1);
    if (IN(NPHASE - 1)) REP(10) { REPBAR(); norm_phase<3>(a, 1, lds, G, c); }
    if (PROBE_SPIN >= 0) {
        GRID_BAR(); STAMP(NPHASE);
        if (blockIdx.x == 0 && threadIdx.x == 0) { volatile LAS unsigned long long* st = (volatile LAS unsigned long long*)(lds + LDS_MISC_OFF + 256);
            const unsigned long long dur = (st[PROBE_SPIN_END] - st[PROBE_SPIN]) * PROBE_MULT, t0 = __builtin_amdgcn_s_memrealtime();
            while (__builtin_amdgcn_s_memrealtime() - t0 < dur) __builtin_amdgcn_s_sleep(8); }
    }
}

extern "C" void kernel_launch(void* const* d_in, const int* in_sizes, int n_in, void* d_out, int out_size, void* d_ws, size_t ws_size, hipStream_t stream) {
    static int grid = 0;
    if (grid == 0) {
        if (n_in != 25 || out_size != TL * DM || ws_size < WS_END) { fprintf(stderr, "kernel_launch: unexpected shapes (n_in %d out %d ws %zu)\n", n_in, out_size, ws_size); grid = -1; return; }
        int dev = 0, cus = 0, per_cu = 0;
        if (hipGetDevice(&dev) != hipSuccess || hipDeviceGetAttribute(&cus, hipDeviceAttributeMultiprocessorCount, dev) != hipSuccess) { grid = -1; return; }
        if (hipFuncSetAttribute((const void*)fwd_kernel, hipFuncAttributeMaxDynamicSharedMemorySize, LDS_BYTES) != hipSuccess) { fprintf(stderr, "kernel_launch: hipFuncSetAttribute failed\n"); grid = -1; return; }
        if (hipOccupancyMaxActiveBlocksPerMultiprocessor(&per_cu, (const void*)fwd_kernel, 512, LDS_BYTES) != hipSuccess || per_cu < 1) { fprintf(stderr, "kernel_launch: occupancy query says %d blocks per CU\n", per_cu); (void)hipGetLastError(); grid = -1; return; }
        grid = cus;
    }
    if (grid < 0) return;
    (void)hipMemsetAsync((char*)d_ws + WS_BAR, 0, 65536, stream);
    Args a{};
    for (int i = 0; i < 25; ++i) a.in[i] = (const float*)d_in[i];
    a.out = (float*)d_out; a.ws = (unsigned char*)d_ws;
#if MK_PER_PHASE
    for (int ph = 0; ph < NPHASE; ++ph) { a.ph_lo = ph; a.ph_hi = ph + 1; hipLaunchKernelGGL(fwd_kernel, dim3(grid), dim3(512), LDS_BYTES, stream, a); }
#else
    a.ph_lo = 0; a.ph_hi = NPHASE;
    hipLaunchKernelGGL(fwd_kernel, dim3(grid), dim3(512), LDS_BYTES, stream, a);
#endif
}
```

```cpp
#include <hip/hip_runtime.h>
#include <hip/hip_cooperative_groups.h>
#include <cstdio>
#include <cstdint>
namespace cg = cooperative_groups;

#ifndef MK_PER_PHASE
#define MK_PER_PHASE 0
#endif

#define LAS __attribute__((address_space(3)))
#define DI __device__ __forceinline__
typedef unsigned short bf16_t;
typedef short bf16x8 __attribute__((ext_vector_type(8)));
typedef short s16x4 __attribute__((ext_vector_type(4)));
typedef float f32x4 __attribute__((ext_vector_type(4)));
typedef float f32x16 __attribute__((ext_vector_type(16)));
typedef unsigned u32x4 __attribute__((ext_vector_type(4)));
typedef unsigned u32x2 __attribute__((ext_vector_type(2)));

constexpr int DM = 1024, NBATCH = 4, SEQ = 4096, CTXL = 256;
constexpr int TL = NBATCH * SEQ, TC = NBATCH * CTXL, TT = TL + TC;
constexpr int INW = 5376;
constexpr int NE = 16, ESLOT = 2304;
constexpr float LOG2E = 1.4426950408889634f;
constexpr float QSC = 0.125f * LOG2E;
constexpr int NPHASE = 20;

constexpr size_t MiB = (size_t)1 << 20;
constexpr size_t WS_BAR = 0;
constexpr size_t WS_MOD = 1 * MiB, WS_ROPE = 1 * MiB + 512 * 1024;
constexpr size_t WS_AFF = 2 * MiB, WS_SLOTOF = 4 * MiB, WS_TOKOF = 6 * MiB;
constexpr size_t WS_WIN = 8 * MiB, WS_WMERGE = 29 * MiB, WS_WOUT = 35 * MiB, WS_WGU = 40 * MiB, WS_WDN = 104 * MiB;
constexpr size_t WS_X = 136 * MiB, WS_H = 204 * MiB;
constexpr size_t WS_Q = 238 * MiB, WS_K = 255 * MiB, WS_VT = 260 * MiB, WS_U = 265 * MiB, WS_Z = 282 * MiB, WS_G = 299 * MiB, WS_BR = 401 * MiB;
constexpr size_t WS_DELTA = 401 * MiB;
constexpr size_t WS_MERGED = 238 * MiB;
constexpr size_t WS_ACT = 238 * MiB, WS_Y = 310 * MiB;
constexpr size_t WS_WGU1 = 452 * MiB, WS_WDN1 = 516 * MiB;
constexpr size_t WS_END = 548 * MiB;
DI size_t ws_wgu(int l) { return l == 0 ? WS_WGU : WS_WGU1; }
DI size_t ws_wdn(int l) { return l == 0 ? WS_WDN : WS_WDN1; }

constexpr int LDS_BYTES = 147456;
constexpr int RING_BYTES = 131072;
constexpr int LDS_IDX_OFF = RING_BYTES;
constexpr int LDS_MISC_OFF = RING_BYTES + 8192;

struct Args { const float* in[25]; float* out; unsigned char* ws; int ph_lo, ph_hi; };
enum { I_X = 0, I_C, I_CTX, I_CCTX, I_N1G, I_N2G, I_WMOD, I_BMOD, I_WIN, I_SINK, I_WAO, I_CDW, I_CDWB, I_CLNG, I_CLNB, I_WCO, I_WPOOL, I_PSCALE, I_WPO, I_WOUT, I_WR, I_WEG, I_WEU, I_WED, I_FNG };

DI unsigned pk_bf16(float lo, float hi) {
    typedef float f2 __attribute__((ext_vector_type(2))); typedef __bf16 b2 __attribute__((ext_vector_type(2)));
    f2 v = {lo, hi}; b2 b = __builtin_convertvector(v, b2); return __builtin_bit_cast(unsigned, b);
}
DI bf16_t f2bf(float f) { return (bf16_t)(pk_bf16(f, 0.f) & 0xffffu); }
DI float bf_lo(unsigned u) { return __uint_as_float(u << 16); }
DI float bf_hi(unsigned u) { return __uint_as_float(u & 0xffff0000u); }
DI float bf2f(bf16_t b) { return __uint_as_float(((unsigned)b) << 16); }
DI float sigm(float x) { return __builtin_amdgcn_rcpf(1.f + __builtin_amdgcn_exp2f(x * -LOG2E)); }
DI float wave_sum(float v) {
#pragma unroll
    for (int o = 1; o < 64; o <<= 1) v += __shfl_xor(v, o);
    return v;
}
DI float max3f(float a, float b, float c) { float r; asm("v_max3_f32 %0, %1, %2, %3" : "=v"(r) : "v"(a), "v"(b), "v"(c)); return r; }
DI int crow(int r, int hi) { return (r & 3) + 8 * (r >> 2) + 4 * hi; }
#define LDS_WAIT() asm volatile("s_waitcnt lgkmcnt(0)" ::: "memory")

namespace pg8 {
constexpr int BM = 256, BK = 64, HALF = 128, HTB = HALF * BK * 2;
DI int lds_byte(int r, int c) { const int st = (r >> 4) * 2 + (c >> 5), rr = r & 15, cc = c & 31, ob = rr * 64 + cc * 2; return st * 1024 + (ob ^ (((ob >> 9) & 1) << 5)); }
DI void stage_rc(int b, int& R, int& C) { const int st = b / 1024, sb = b % 1024, swz = sb ^ (((sb >> 9) & 1) << 5); R = (st >> 1) * 16 + swz / 64; C = (st & 1) * 32 + (swz % 64) / 2; }

struct Unit { const char* a; const char* b; int i0, i1, i2, ui; int half; };

DI void tile_order(int L, int nM, int nN, int& pm, int& pn) {
    const int nwg = nM * nN; int wgid = L;
    { const int q = nwg / 8, r = nwg % 8, xcd = wgid % 8, off = wgid / 8; wgid = (xcd < r ? xcd * (q + 1) : r * (q + 1) + (xcd - r) * q) + off; }
    const int nig = 8 * nN, gid = wgid / nig, fm = gid * 8, gsz = (nM - fm) < 8 ? (nM - fm) : 8;
    pm = fm + ((wgid % nig) % gsz); pn = (wgid % nig) / gsz;
}

template <class Epi, class Sched>
DI void gemm_phase(LAS unsigned char* lds, const Sched& S, const Epi& E) {
    const int tid = threadIdx.x, wid = __builtin_amdgcn_readfirstlane(tid >> 6), lane = tid & 63, wr = wid >> 2, wc = wid & 3, fr = lane & 15, fq = lane >> 4;
    const int nt = S.nt;
    int R0, C0, R1, C1; stage_rc(tid * 16, R0, C0); stage_rc(tid * 16 + 8192, R1, C1);
    unsigned voffB[2][2];
#pragma unroll
    for (int h = 0; h < 2; ++h) { voffB[h][0] = (unsigned)((h * HALF + R0) * S.ldb_b + C0 * 2); voffB[h][1] = (unsigned)((h * HALF + R1) * S.ldb_b + C1 * 2); }
    const size_t kstep = (size_t)(BK * 2);
    const unsigned ldsw = (unsigned)wid * 1024u;
    const int aoff = lds_byte(wr * 64 + fr, fq * 8), boff = lds_byte(wc * 32 + fr, fq * 8);
#define PG8_SA(b, h) (((b) * 2 + (h)) * HTB)
#define PG8_SB(b, h) ((4 + (b) * 2 + (h)) * HTB)
#define PG8_STAGE(bufoff, gbase, voff) do { _Pragma("unroll") for (int _i = 0; _i < 2; ++_i) \
        __builtin_amdgcn_global_load_lds((const unsigned*)((const char*)(gbase) + (voff)[_i]), (LAS unsigned*)(lds + (bufoff) + ldsw + _i * 8192), 16, 0, 0); } while (0)
#define PG8_LDA(dst, b, h) do { _Pragma("unroll") for (int m = 0; m < 4; ++m) _Pragma("unroll") for (int k = 0; k < 2; ++k) dst[m][k] = *(const LAS bf16x8*)(lds + PG8_SA(b, h) + aoff + m * 2048 + k * 1024); } while (0)
#define PG8_LDB(dst, b, h) do { _Pragma("unroll") for (int n = 0; n < 2; ++n) _Pragma("unroll") for (int k = 0; k < 2; ++k) dst[n][k] = *(const LAS bf16x8*)(lds + PG8_SB(b, h) + boff + n * 2048 + k * 1024); } while (0)
#define PG8_MMA(ai, bj, At, Bt) do { __builtin_amdgcn_s_setprio(1); _Pragma("unroll") for (int m = 0; m < 4; ++m) _Pragma("unroll") for (int n = 0; n < 2; ++n) _Pragma("unroll") for (int k = 0; k < 2; ++k) \
        acc[ai][bj][m][n] = __builtin_amdgcn_mfma_f32_16x16x32_bf16(Bt[n][k], At[m][k], acc[ai][bj][m][n], 0, 0, 0); __builtin_amdgcn_s_setprio(0); } while (0)
#define PG8_WAIT_V(n) asm volatile("s_waitcnt vmcnt(" #n ")" ::: "memory")
#define PG8_WAIT_L(n) asm volatile("s_waitcnt lgkmcnt(" #n ")" ::: "memory")
#define PG8_BAR __builtin_amdgcn_s_barrier()
#define PG8_SCHED __builtin_amdgcn_sched_barrier(0)
    Unit cur, nxt; int ui = 0;
    if (!S.next(0, cur)) return;
    f32x4 acc[2][2][4][2];
#pragma unroll
    for (int a = 0; a < 2; ++a)
#pragma unroll
        for (int b = 0; b < 2; ++b)
#pragma unroll
            for (int m = 0; m < 4; ++m)
#pragma unroll
                for (int n = 0; n < 2; ++n) acc[a][b][m][n] = (f32x4){0.f, 0.f, 0.f, 0.f};
    bf16x8 At[4][2], B0[2][2], B1[2][2];
    unsigned cvA[2][2], nvA[2][2];
    S.voff(cur, R0, C0, R1, C1, cvA);
    const char* cA = cur.a; const char* cB = cur.b;
    PG8_STAGE(PG8_SB(0, 0), cB, voffB[0]); PG8_STAGE(PG8_SB(0, 1), cB, voffB[1]); PG8_STAGE(PG8_SA(0, 0), cA, cvA[0]); PG8_STAGE(PG8_SA(0, 1), cA, cvA[1]);
    if (wr == 1) PG8_BAR;
    PG8_WAIT_V(2); PG8_BAR;
    PG8_STAGE(PG8_SB(1, 0), cB + kstep, voffB[0]); PG8_STAGE(PG8_SA(1, 0), cA + kstep, cvA[0]); PG8_STAGE(PG8_SB(1, 1), cB + kstep, voffB[1]);
    PG8_WAIT_V(6); PG8_BAR;
    for (;;) {
        const bool has_next = S.next(ui + 1, nxt);
        const char* nA = has_next ? nxt.a : cA; const char* nB = has_next ? nxt.b : cB;
        if (has_next) S.voff(nxt, R0, C0, R1, C1, nvA);
        else {
#pragma unroll
            for (int h = 0; h < 2; ++h) { nvA[h][0] = cvA[h][0]; nvA[h][1] = cvA[h][1]; }
        }
        const bool hf = cur.half != 0;
        for (int t = 0; t < nt; t += 2) {
            if constexpr (Epi::HOOK) { if (t == 8 || t == 16) E.hook(acc, cur, t >> 4, wr, wc, fr, fq); }
            const bool last = (t == nt - 2);
            const char* a1 = cA + (size_t)(t + 1) * kstep;
            const char* a2 = last ? nA : cA + (size_t)(t + 2) * kstep; const char* b2 = last ? nB : cB + (size_t)(t + 2) * kstep;
            const char* a3 = a2 + kstep; const char* b3 = b2 + kstep;
            unsigned v2[2][2];
#pragma unroll
            for (int h = 0; h < 2; ++h) { v2[h][0] = last ? nvA[h][0] : cvA[h][0]; v2[h][1] = last ? nvA[h][1] : cvA[h][1]; }
            PG8_LDB(B0, 0, 0); PG8_LDB(B1, 0, 1); PG8_SCHED; PG8_LDA(At, 0, 0); PG8_STAGE(PG8_SA(1, 1), a1, cvA[1]);
            PG8_WAIT_V(8); PG8_WAIT_L(0); PG8_BAR; PG8_MMA(0, 0, At, B0); PG8_MMA(0, 1, At, B1); PG8_BAR; PG8_SCHED;
            PG8_LDA(At, 0, 1); PG8_STAGE(PG8_SB(0, 0), b2, voffB[0]); PG8_STAGE(PG8_SB(0, 1), b2, voffB[1]); PG8_STAGE(PG8_SA(0, 0), a2, v2[0]);
            PG8_WAIT_V(8); PG8_WAIT_L(0); PG8_BAR; if (!hf) { PG8_MMA(1, 0, At, B0); PG8_MMA(1, 1, At, B1); } PG8_BAR; PG8_SCHED;
            PG8_LDB(B0, 1, 0); PG8_LDB(B1, 1, 1); PG8_SCHED; PG8_LDA(At, 1, 0); PG8_STAGE(PG8_SA(0, 1), a2, v2[1]);
            PG8_WAIT_V(8); PG8_WAIT_L(0); PG8_BAR; PG8_MMA(0, 0, At, B0); PG8_MMA(0, 1, At, B1); PG8_BAR; PG8_SCHED;
            PG8_LDA(At, 1, 1); PG8_STAGE(PG8_SB(1, 0), b3, voffB[0]); PG8_STAGE(PG8_SB(1, 1), b3, voffB[1]); PG8_STAGE(PG8_SA(1, 0), a3, v2[0]);
            PG8_WAIT_V(8); PG8_WAIT_L(0); PG8_BAR; if (!hf) { PG8_MMA(1, 0, At, B0); PG8_MMA(1, 1, At, B1); } PG8_BAR; PG8_SCHED;
        }
        if (wr == 0) PG8_BAR;
        E(acc, cur, wr, wc, fr, fq);
        if (!has_next) break;
#pragma unroll
        for (int a = 0; a < 2; ++a)
#pragma unroll
            for (int b = 0; b < 2; ++b)
#pragma unroll
                for (int m = 0; m < 4; ++m)
#pragma unroll
                    for (int n = 0; n < 2; ++n) acc[a][b][m][n] = (f32x4){0.f, 0.f, 0.f, 0.f};
        cur = nxt; cA = nA; cB = nB; ++ui;
#pragma unroll
        for (int h = 0; h < 2; ++h) { cvA[h][0] = nvA[h][0]; cvA[h][1] = nvA[h][1]; }
        if (wr == 1) PG8_BAR;
    }
    PG8_WAIT_V(0);
    PG8_BAR;
#undef PG8_SA
#undef PG8_SB
#undef PG8_STAGE
#undef PG8_LDA
#undef PG8_LDB
#undef PG8_MMA
#undef PG8_WAIT_V
#undef PG8_WAIT_L
#undef PG8_BAR
#undef PG8_SCHED
}
}
using pg8::Unit;
typedef f32x4 Acc[2][2][4][2];

struct SchedBase {
    int nt, ldb_b, lda_b, G, c;
    DI void voff_contig(int R0, int C0, int R1, int C1, unsigned (&vo)[2][2]) const {
#pragma unroll
        for (int h = 0; h < 2; ++h) { vo[h][0] = (unsigned)((h * 128 + R0) * lda_b + C0 * 2); vo[h][1] = (unsigned)((h * 128 + R1) * lda_b + C1 * 2); }
    }
};
struct SchedInProj : SchedBase {
    const char* A; const char* B; int nM, n1, n1p, ntot, lo, hi;
    DI void init_counts(int nM_, int extra) { nM = nM_; n1 = nM * 9 + extra; n1p = (n1 + 7) & ~7; ntot = n1p + nM * 12; }
    DI bool next(int i, Unit& u) const {
        const int L = lo + i * G + c; if (L >= hi) return false; int pm, pn;
        if (L < n1p) { const int L1 = L < n1 ? L : L - n1; if (L1 < nM * 9) pg8::tile_order(L1, nM, 9, pm, pn); else { pm = 64 + (L1 - nM * 9); pn = 2; } }
        else { pg8::tile_order(L - n1p, nM, 12, pm, pn); pn += 9; }
        u.a = A + (size_t)pm * 256 * 2048; u.b = B + (size_t)pn * 256 * 2048; u.i0 = pm; u.i1 = pn; u.i2 = 0; u.ui = i; u.half = 0; return true;
    }
    DI void voff(const Unit&, int R0, int C0, int R1, int C1, unsigned (&vo)[2][2]) const { voff_contig(R0, C0, R1, C1, vo); }
};
struct SchedMerge : SchedBase {
    const char* A; const char* B; int nM;
    DI bool next(int i, Unit& u) const {
        const int L = i * G + c; if (L >= nM * 4) return false;
        int pm, pn; pg8::tile_order(L, nM, 4, pm, pn);
        u.a = A + (size_t)pm * 256 * 3072; u.b = B + (size_t)pn * 256 * 3072; u.i0 = pm; u.i1 = pn; u.i2 = 0; u.ui = i; u.half = 0; return true;
    }
    DI void voff(const Unit&, int R0, int C0, int R1, int C1, unsigned (&vo)[2][2]) const { voff_contig(R0, C0, R1, C1, vo); }
};
struct SchedOut : SchedBase {
    const char* A; const char* B; int nM;
    DI bool next(int i, Unit& u) const {
        const int L = i * G + c; if (L >= nM * 4) return false;
        int pm, pn; pg8::tile_order(L, nM, 4, pm, pn);
        u.a = A + (size_t)pm * 256 * 2048; u.b = B + (size_t)pn * 256 * 2048; u.i0 = pm; u.i1 = pn; u.i2 = 0; u.ui = i; u.half = 0; return true;
    }
    DI void voff(const Unit&, int R0, int C0, int R1, int C1, unsigned (&vo)[2][2]) const { voff_contig(R0, C0, R1, C1, vo); }
};
DI void gu_decode(int L, int& e, int& mt, int& n8) { if (L < NE * 64) { n8 = L & 7; mt = (L >> 3) & 7; e = L >> 6; } else { const int x = L - NE * 64; n8 = x & 7; e = x >> 3; mt = 8; } }
DI void dn_decode(int L, int& e, int& mt, int& n4) { if (L < NE * 32) { n4 = L & 3; mt = (L >> 2) & 7; e = L >> 5; } else { const int x = L - NE * 32; n4 = x & 3; e = x >> 2; mt = 8; } }
struct SchedGU : SchedBase {
    const char* A; const char* B; int lo, hi, c0, ibase; const LAS int* idx;
    DI int unit(int i) const { return lo + (ibase + i) * G + c0; }
    DI bool next(int i, Unit& u) const {
        if (i >= 8 || c0 < 0) return false;
        const int L = unit(i); if (L >= hi) return false;
        int e, mt, n8; gu_decode(L, e, mt, n8);
        u.a = A; u.b = B + ((size_t)e * 2048 + n8 * 256) * 2048; u.i0 = e; u.i1 = mt; u.i2 = n8; u.ui = i; u.half = mt == 8; return true;
    }
    DI void voff(const Unit& u, int R0, int C0, int R1, int C1, unsigned (&vo)[2][2]) const {
#pragma unroll
        for (int h = 0; h < 2; ++h) { vo[h][0] = (unsigned)(idx[u.ui * 256 + h * 128 + R0] * 2048 + C0 * 2); vo[h][1] = (unsigned)(idx[u.ui * 256 + h * 128 + R1] * 2048 + C1 * 2); }
    }
};
struct SchedDown : SchedBase {
    const char* A; const char* B; int lo, hi, c0;
    DI bool next(int i, Unit& u) const {
        if (c0 < 0) return false;
        const int L = lo + i * G + c0; if (L >= hi) return false;
        int e, mt, n4; dn_decode(L, e, mt, n4);
        u.a = A + ((size_t)e * ESLOT + mt * 256) * 2048; u.b = B + ((size_t)e * 1024 + n4 * 256) * 2048; u.i0 = e; u.i1 = mt; u.i2 = n4; u.ui = i; u.half = mt == 8; return true;
    }
    DI void voff(const Unit&, int R0, int C0, int R1, int C1, unsigned (&vo)[2][2]) const { voff_contig(R0, C0, R1, C1, vo); }
};

DI void st16_wt(void* p, u32x4 v) { asm volatile("global_store_dwordx4 %0, %1, off sc1\n\ts_nop 1" :: "v"(p), "v"(v) : "memory"); }
DI void st_bf4(bf16_t* p, f32x4 v) { u32x2 w; w.x = pk_bf16(v[0], v[1]); w.y = pk_bf16(v[2], v[3]); *(u32x2*)p = w; }
DI float gatef(float x) { return fminf(1.f + __builtin_amdgcn_exp2f(x * -LOG2E), 1e18f); }
DI f32x4 gate4(f32x4 v) { return (f32x4){gatef(v[0]), gatef(v[1]), gatef(v[2]), gatef(v[3])}; }
DI void st_pair(bf16_t* p0, f32x4 v0, bf16_t* p1, f32x4 v1, int fq) {
    const unsigned a0 = pk_bf16(v0[0], v0[1]), a1 = pk_bf16(v0[2], v0[3]), b0 = pk_bf16(v1[0], v1[1]), b1 = pk_bf16(v1[2], v1[3]);
    const bool odd = fq & 1;
    const unsigned r0 = __shfl_xor(odd ? a0 : b0, 16), r1 = __shfl_xor(odd ? a1 : b1, 16);
    u32x4 o; bf16_t* p;
    if (odd) { o = (u32x4){r0, r1, b0, b1}; p = p1 - 4; } else { o = (u32x4){a0, a1, r0, r1}; p = p0; }
    *(u32x4*)p = o;
}
DI f32x4 sig4(f32x4 v) { return (f32x4){sigm(v[0]), sigm(v[1]), sigm(v[2]), sigm(v[3])}; }

struct EpiInProj {
    static constexpr bool HOOK = false;
    bf16_t *Q, *K, *VT, *U, *Z, *G; const float* rope;
    DI void operator()(const Acc& acc, const Unit& u, int wr, int wc, int fr, int fq) const {
        const int pm = u.i0, pn = u.i1;
#pragma unroll
        for (int bj = 0; bj < 2; ++bj) {
            const int gc = 256 * pn + 128 * bj + 32 * wc;
#pragma unroll
            for (int ai = 0; ai < 2; ++ai)
#pragma unroll
                for (int m = 0; m < 4; ++m) {
                    const int t = 256 * pm + 128 * ai + 64 * wr + 16 * m + fr;
                    const f32x4 v0 = acc[ai][bj][m][0], v1 = acc[ai][bj][m][1];
                    if (gc < 640) {
                        f32x4 o0 = v0, o1 = v1;
                        if (t < TL) {
                            const int s = t & (SEQ - 1); const int p = ((gc >> 5) & 1) ? (s & 63) : (s >> 6);
                            const f32x4 cs = *(const f32x4*)(rope + p * 16 + 4 * fq), sn = *(const f32x4*)(rope + 1024 + p * 16 + 4 * fq);
                            o0 = v0 * cs - v1 * sn; o1 = v1 * cs + v0 * sn;
                        }
                        bf16_t* dst;
                        if (gc < 512) { o0 = o0 * QSC; o1 = o1 * QSC; dst = Q + (size_t)t * 512 + gc + 4 * fq; } else dst = K + (size_t)t * 128 + (gc - 512) + 4 * fq;
                        st_pair(dst, o0, dst + 16, o1, fq);
                    } else if (gc < 768) {
                        const int c0 = gc - 640 + 4 * fq;
#pragma unroll
                        for (int j = 0; j < 4; ++j) { VT[(size_t)(c0 + j) * TT + t] = f2bf(v0[j]); VT[(size_t)(c0 + 16 + j) * TT + t] = f2bf(v1[j]); }
                    } else if (gc < 1792) {
                        if (bj == 0) {
                            const int ch = ((gc - 768) >> 1) + 4 * fq;
                            st_pair(U + (size_t)t * 512 + ch, v0 * sig4(v1), U + (size_t)t * 512 + ch + 64, acc[ai][1][m][0] * sig4(acc[ai][1][m][1]), fq); }
                    } else if (gc < 2304) {
                        bf16_t* dst = Z + (size_t)t * 512 + (gc - 1792) + 4 * fq; st_pair(dst, v0, dst + 16, v1, fq);
                    } else {
                        const int gt = pn - 9; const size_t gb = ((((size_t)(pm * 3 + (gt >> 2)) * 4 + (gt & 3)) * 8 + (wr * 4 + wc)) * 16 + ((ai * 4 + m) * 2 + bj)) * 64 + (fq * 16 + fr);
                        const f32x4 g0 = gate4(v0), g1 = gate4(v1); u32x4 gw; gw.x = pk_bf16(g0[0], g0[1]); gw.y = pk_bf16(g0[2], g0[3]); gw.z = pk_bf16(g1[0], g1[1]); gw.w = pk_bf16(g1[2], g1[3]);
                        st16_wt(G + gb * 8, gw);
                    }
                }
        }
    }
};
struct EpiMerge {
    static constexpr bool HOOK = true;
    const bf16_t* G; bf16_t* M;
    DI static f32x4 lo4(u32x4 w) { return (f32x4){bf_lo(w.x), bf_hi(w.x), bf_lo(w.y), bf_hi(w.y)}; }
    DI static f32x4 hi4(u32x4 w) { return (f32x4){bf_lo(w.z), bf_hi(w.z), bf_lo(w.w), bf_hi(w.w)}; }
    DI static f32x4 rcp4(f32x4 v) { return (f32x4){__builtin_amdgcn_rcpf(v[0]), __builtin_amdgcn_rcpf(v[1]), __builtin_amdgcn_rcpf(v[2]), __builtin_amdgcn_rcpf(v[3])}; }
    DI void hook(Acc& acc, const Unit& u, int which, int wr, int wc, int fr, int fq) const {
        int lofs = fq * 16 + fr; asm volatile("" : "+v"(lofs));
        const u32x4* pa = (const u32x4*)G + ((((size_t)(u.i0 * 3 + which) * 4 + u.i1) * 8 + (wr * 4 + wc)) * 16) * 64 + lofs;
        const u32x4* pb = pa + (size_t)4 * 8 * 16 * 64;
        u32x4 ba[4][2], bb[4][2];
#pragma unroll
        for (int h = 0; h < 2; ++h) {
#pragma unroll
            for (int g = 0; g < 4; ++g)
#pragma unroll
                for (int q = 0; q < 2; ++q) { ba[g][q] = pa[((4 * h + g) * 2 + q) * 64]; bb[g][q] = pb[((4 * h + g) * 2 + q) * 64]; }
#pragma unroll
            for (int g = 0; g < 4; ++g)
#pragma unroll
                for (int q = 0; q < 2; ++q) {
                    acc[h][q][g][0] = acc[h][q][g][0] * (lo4(bb[g][q]) * rcp4(lo4(ba[g][q])));
                    acc[h][q][g][1] = acc[h][q][g][1] * (hi4(bb[g][q]) * rcp4(hi4(ba[g][q]))); }
            asm volatile("" ::: "memory");
        }
    }
    DI void operator()(const Acc& acc, const Unit& u, int wr, int wc, int fr, int fq) const {
        const int pm = u.i0, pn = u.i1;
        const u32x4* pc = (const u32x4*)G + ((((size_t)(pm * 3 + 2) * 4 + pn) * 8 + (wr * 4 + wc)) * 16) * 64 + (fq * 16 + fr);
#pragma unroll
        for (int ai = 0; ai < 2; ++ai)
#pragma unroll
            for (int m = 0; m < 4; ++m) {
                const int t = 256 * pm + 128 * ai + 64 * wr + 16 * m + fr;
#pragma unroll
                for (int bj = 0; bj < 2; ++bj) {
                    const u32x4 gw = pc[((ai * 4 + m) * 2 + bj) * 64];
                    const int cc = 256 * pn + 128 * bj + 32 * wc + 4 * fq;
                    st_pair(M + (size_t)t * 1024 + cc, acc[ai][bj][m][0] * rcp4(lo4(gw)), M + (size_t)t * 1024 + cc + 16, acc[ai][bj][m][1] * rcp4(hi4(gw)), fq);
                }
            }
    }
};
struct EpiOut {
    static constexpr bool HOOK = false;
    bf16_t* D; const float* mod; int layer;
    DI void operator()(const Acc& acc, const Unit& u, int wr, int wc, int fr, int fq) const {
        const int pm = u.i0, pn = u.i1; const int row0 = 256 * pm;
        const int mr = row0 < TL ? (row0 >> 12) : 4;
        const float* g1 = mod + (size_t)(layer * 5 + mr) * 6144 + 2048;
#pragma unroll
        for (int bj = 0; bj < 2; ++bj) {
            const int cc = 256 * pn + 128 * bj + 32 * wc + 4 * fq;
            const f32x4 g0 = *(const f32x4*)(g1 + cc), gv1 = *(const f32x4*)(g1 + cc + 16);
#pragma unroll
            for (int ai = 0; ai < 2; ++ai)
#pragma unroll
                for (int m = 0; m < 4; ++m) {
                    const int t = row0 + 128 * ai + 64 * wr + 16 * m + fr;
                    st_pair(D + (size_t)t * DM + cc, g0 * acc[ai][bj][m][0], D + (size_t)t * DM + cc + 16, gv1 * acc[ai][bj][m][1], fq);
                }
        }
    }
};
struct EpiGU {
    static constexpr bool HOOK = false;
    bf16_t* ACT;
    DI void operator()(const Acc& acc, const Unit& u, int wr, int wc, int fr, int fq) const {
        const int e = u.i0, mt = u.i1, n8 = u.i2;
#pragma unroll
        for (int ai = 0; ai < 2; ++ai) if (ai == 0 || !u.half)
#pragma unroll
            for (int m = 0; m < 4; ++m) {
                const size_t slot = (size_t)e * ESLOT + mt * 256 + 128 * ai + 64 * wr + 16 * m + fr;
                const int col = ((256 * n8 + 32 * wc) >> 1) + 4 * fq;
                const f32x4 g0 = acc[ai][0][m][0], u0 = acc[ai][0][m][1], g1 = acc[ai][1][m][0], u1 = acc[ai][1][m][1];
                st_pair(ACT + slot * 1024 + col, g0 * sig4(g0) * u0, ACT + slot * 1024 + col + 64, g1 * sig4(g1) * u1, fq);
            }
    }
};
struct EpiDown {
    static constexpr bool HOOK = false;
    bf16_t* Y;
    DI void operator()(const Acc& acc, const Unit& u, int wr, int wc, int fr, int fq) const {
        const int e = u.i0, mt = u.i1, n4 = u.i2;
#pragma unroll
        for (int ai = 0; ai < 2; ++ai) if (ai == 0 || !u.half)
#pragma unroll
            for (int m = 0; m < 4; ++m) {
                const size_t slot = (size_t)e * ESLOT + mt * 256 + 128 * ai + 64 * wr + 16 * m + fr;
#pragma unroll
                for (int bj = 0; bj < 2; ++bj) { bf16_t* yp = Y + slot * 1024 + 256 * n4 + 128 * bj + 32 * wc + 4 * fq; st_pair(yp, acc[ai][bj][m][0], yp + 16, acc[ai][bj][m][1], fq); }
            }
    }
};

DI int maprow(int mode, int n) {
    if (mode == 1) {
        if (n >= 768 && n < 1280) { const int ch = n - 768; return 768 + 32 * (ch >> 4) + (ch & 15); }
        if (n >= 1280 && n < 1792) { const int ch = n - 1280; return 768 + 32 * (ch >> 4) + 16 + (ch & 15); }
        return n;
    }
    if (mode == 2) return 32 * (n >> 4) + (n & 15);
    if (mode == 3) return 32 * (n >> 4) + 16 + (n & 15);
    return n;
}
struct ConvTile { const float* W; bf16_t* WT; int N, dpitch, dcol0, mode, kb, nb; };
DI void tile_load(const ConvTile& t, int lane, f32x4 (&x)[8]) {
    const float* p = t.W + (size_t)(64 * t.kb + 8 * (lane & 7)) * t.N + 32 * t.nb + 4 * (lane >> 3);
#pragma unroll
    for (int r = 0; r < 8; ++r) x[r] = __builtin_nontemporal_load((const f32x4*)(p + (size_t)r * t.N));
}
DI void tile_store(const ConvTile& t, int lane, const f32x4 (&x)[8]) {
    const int n = 32 * t.nb + 4 * (lane >> 3);
#pragma unroll
    for (int i = 0; i < 4; ++i) { u32x4 o; o.x = pk_bf16(x[0][i], x[1][i]); o.y = pk_bf16(x[2][i], x[3][i]); o.z = pk_bf16(x[4][i], x[5][i]); o.w = pk_bf16(x[6][i], x[7][i]);
        st16_wt(t.WT + (size_t)maprow(t.mode, n + i) * t.dpitch + t.dcol0 + 64 * t.kb + 8 * (lane & 7), o); }
}
DI ConvTile small_tile(const Args& a, int it) {
    unsigned char* ws = a.ws; ConvTile t;
    constexpr int I_A = 16 * 168, I_B = 8 * 32, I_C = 8 * 32, I_D = 16 * 32, PER = I_A + I_B + I_C + I_D;
    const int l = it / PER; int r = it % PER;
    if (r < I_A) { t.W = a.in[I_WIN] + (size_t)l * 1024 * INW; t.N = INW; t.WT = (bf16_t*)(ws + WS_WIN) + (size_t)l * INW * 1024; t.dpitch = 1024; t.dcol0 = 0; t.mode = 1; }
    else if ((r -= I_A) < I_B) { t.W = a.in[I_WAO] + (size_t)l * 512 * 1024; t.N = 1024; t.WT = (bf16_t*)(ws + WS_WMERGE) + (size_t)l * 1024 * 1536; t.dpitch = 1536; t.dcol0 = 0; t.mode = 0; }
    else if ((r -= I_B) < I_C) { t.W = a.in[I_WCO] + (size_t)l * 512 * 1024; t.N = 1024; t.WT = (bf16_t*)(ws + WS_WMERGE) + (size_t)l * 1024 * 1536; t.dpitch = 1536; t.dcol0 = 512; t.mode = 0; }
    else { r -= I_C; t.W = a.in[I_WOUT] + (size_t)l * 1024 * 1024; t.N = 1024; t.WT = (bf16_t*)(ws + WS_WOUT) + (size_t)l * 1024 * 1024; t.dpitch = 1024; t.dcol0 = 0; t.mode = 0; }
    const int nblk = t.N / 32; t.kb = r / nblk; t.nb = r % nblk; return t;
}
constexpr int N_SMALL_TILES = 2 * (16 * 168 + 8 * 32 + 8 * 32 + 16 * 32);
DI ConvTile expert_tile(const Args& a, int l, int it) {
    unsigned char* ws = a.ws; ConvTile t;
    const int m = it >> 9, r = it & 511, e = m / 3, kind = m % 3; const size_t wo = ((size_t)l * NE + e) * 1024 * 1024;
    t.N = 1024; t.dpitch = 1024; t.dcol0 = 0; t.kb = r >> 5; t.nb = r & 31;
    const long long d1 = (const char*)a.in[I_WEU] - (const char*)a.in[I_WEG], d2 = (const char*)a.in[I_WED] - (const char*)a.in[I_WEG];
    const long long dsel = kind == 0 ? 0ll : (kind == 1 ? d1 : d2);
    t.W = (const float*)((const char*)a.in[I_WEG] + dsel) + wo;
    t.WT = kind == 2 ? (bf16_t*)(ws + ws_wdn(l)) + (size_t)e * 1024 * 1024 : (bf16_t*)(ws + ws_wgu(l)) + (size_t)e * 2048 * 1024;
    t.mode = kind == 0 ? 2 : (kind == 1 ? 3 : 0);
    return t;
}
constexpr int N_EXPERT_TILES = NE * 3 * 512;
template <class F> DI void convert_loop(int ntiles, int gw, int NGW, int lane, F&& get) {
    for (int it = gw; it < ntiles; it += 2 * NGW) {
        const ConvTile t0 = get(it); const bool two = it + NGW < ntiles; const ConvTile t1 = get(two ? it + NGW : it);
        f32x4 x0[8], x1[8];
        tile_load(t0, lane, x0); if (two) tile_load(t1, lane, x1);
        tile_store(t0, lane, x0); if (two) tile_store(t1, lane, x1);
    }
}
constexpr int CTR_WORD0 = 8192, CTR_STRIDE = 64;
DI void convert_pull(const Args& a, int l, int lane, const unsigned* done = nullptr, unsigned G = 0u) {
    unsigned* ctr = (unsigned*)(a.ws + WS_BAR) + CTR_WORD0 + l * CTR_STRIDE;
    for (;;) {
        if (done) { unsigned d = 0u; if (lane == 0) d = __hip_atomic_load(done, __ATOMIC_RELAXED, __HIP_MEMORY_SCOPE_AGENT); if ((unsigned)__builtin_amdgcn_readfirstlane((int)d) >= G) break; }
        unsigned itu = 0u; if (lane == 0) itu = __hip_atomic_fetch_add(ctr, 16u, __ATOMIC_RELAXED, __HIP_MEMORY_SCOPE_AGENT);
        const int it0 = __builtin_amdgcn_readfirstlane((int)itu);
        if (it0 >= N_EXPERT_TILES) break;
#pragma unroll 1
        for (int it = it0; it < it0 + 16; it += 2) {
            const ConvTile t0 = expert_tile(a, l, it), t1 = expert_tile(a, l, it + 1);
            f32x4 x0[8], x1[8];
            tile_load(t0, lane, x0); tile_load(t1, lane, x1);
            tile_store(t0, lane, x0); tile_store(t1, lane, x1);
        }
    }
}
DI void convert_small(const Args& a, int gw, int NGW, int lane) { convert_loop(N_SMALL_TILES, gw, NGW, lane, [&](int it) __attribute__((always_inline)) { return small_tile(a, it); }); }
DI void convert_experts(const Args& a, int l, int gw, int NGW, int lane) { convert_loop(N_EXPERT_TILES, gw, NGW, lane, [&](int it) __attribute__((always_inline)) { return expert_tile(a, l, it); }); }
DI void mod_item(const Args& a, LAS unsigned char* lds, int item) {
    const int tid = threadIdx.x, l = item / 96, cb = item % 96;
    LAS float* sc = (LAS float*)lds; LAS float* red = (LAS float*)(lds + 20480);
    for (int idx = tid; idx < 5120; idx += 512) { const int r = idx >> 10, k = idx & 1023; const float v = r < 4 ? a.in[I_C][r * 1024 + k] : a.in[I_CCTX][k]; sc[idx] = v / (1.f + expf(-v)); }
    __syncthreads();
    const int c4 = tid & 15, kg = tid >> 4; const float* w = a.in[I_WMOD] + (size_t)l * 1024 * 6144 + cb * 64 + c4 * 4 + (size_t)(kg * 32) * 6144;
    f32x4 acc[5];
#pragma unroll
    for (int r = 0; r < 5; ++r) acc[r] = (f32x4){0.f, 0.f, 0.f, 0.f};
#pragma unroll
    for (int k8 = 0; k8 < 32; k8 += 8) { f32x4 wv[8];
#pragma unroll
        for (int i = 0; i < 8; ++i) wv[i] = __builtin_nontemporal_load((const f32x4*)(w + (size_t)(k8 + i) * 6144));
#pragma unroll
        for (int i = 0; i < 8; ++i)
#pragma unroll
            for (int r = 0; r < 5; ++r) acc[r] = acc[r] + sc[r * 1024 + kg * 32 + k8 + i] * wv[i]; }
#pragma unroll
    for (int r = 0; r < 5; ++r) *(LAS f32x4*)(red + (kg * 5 + r) * 64 + c4 * 4) = acc[r];
    __syncthreads();
    if (tid < 320) { const int r = tid >> 6, col = tid & 63; float s = a.in[I_BMOD][l * 6144 + cb * 64 + col];
#pragma unroll 8
        for (int g = 0; g < 32; ++g) s += red[(g * 5 + r) * 64 + col];
        ((float*)(a.ws + WS_MOD))[(size_t)(l * 5 + r) * 6144 + cb * 64 + col] = s; }
    __syncthreads();
}
DI void rope_item(const Args& a) {
    float* rp = (float*)(a.ws + WS_ROPE);
    for (int idx = threadIdx.x; idx < 1024; idx += 512) { const int p = idx >> 4, i = idx & 15; const float fr = powf(10000.f, -(float)i / 16.f); const float ang = (float)p * fr; rp[idx] = cosf(ang); rp[1024 + idx] = sinf(ang); }
}
DI void fold_item(const Args& a, LAS unsigned char* lds, int item) {
    const int tid = threadIdx.x; const int nh = item & 1, kb = (item >> 1) & 15, gi = (item >> 5) & 3, l = item >> 7;
    LAS float* wp = (LAS float*)lds; LAS float* psv = (LAS float*)(lds + 4096);
    for (int idx = tid; idx < 1024; idx += 512) wp[idx] = a.in[I_WPOOL][(((size_t)l * 4 + gi) * 128 + kb * 8 + (idx >> 7)) * 128 + (idx & 127)];
    if (tid < 128) psv[tid] = a.in[I_PSCALE][l * 512 + gi * 128 + tid];
    __syncthreads();
    const int n = nh * 512 + tid; const float* wo = a.in[I_WPO] + ((size_t)l * 512 + gi * 128) * 1024 + n;
    float acc[8] = {0.f, 0.f, 0.f, 0.f, 0.f, 0.f, 0.f, 0.f};
#pragma unroll 16
    for (int j = 0; j < 128; ++j) { const float v = wo[(size_t)j * 1024] * psv[j];
#pragma unroll
        for (int kk = 0; kk < 8; ++kk) acc[kk] += wp[kk * 128 + j] * v; }
    u32x4 o; o.x = pk_bf16(acc[0], acc[1]); o.y = pk_bf16(acc[2], acc[3]); o.z = pk_bf16(acc[4], acc[5]); o.w = pk_bf16(acc[6], acc[7]);
    *(u32x4*)((bf16_t*)(a.ws + WS_WMERGE) + ((size_t)l * 1024 + n) * 1536 + 1024 + gi * 128 + kb * 8) = o;
    __syncthreads();
}
DI void phase_prep(const Args& a, LAS unsigned char* lds, int G, int c) {
    constexpr int NBI = 192 + 1 + 256;
    for (int it = c; it < NBI; it += G) { if (it < 192) mod_item(a, lds, it); else if (it == 192) rope_item(a); else fold_item(a, lds, it - 193); }
    __syncthreads();
    const int wid = __builtin_amdgcn_readfirstlane(threadIdx.x >> 6), lane = threadIdx.x & 63;
    convert_small(a, c * 8 + wid, G * 8, lane);
}

template <int MODE> DI void norm_phase(const Args& a, int l, LAS unsigned char* lds, int G, int c) {
    const int tid = threadIdx.x, wid = __builtin_amdgcn_readfirstlane(tid >> 6), lane = tid & 63;
    unsigned char* ws = a.ws;
    float* X = (float*)(ws + WS_X); bf16_t* H = (bf16_t*)(ws + WS_H); const float* MOD = (const float*)(ws + WS_MOD);
    float* AFF = (float*)(ws + WS_AFF); const int* SLOTOF = (const int*)(ws + WS_SLOTOF); const bf16_t* Y = (const bf16_t*)(ws + WS_Y);
    LAS float* wr_l = (LAS float*)lds;
    constexpr int WRP = 1028;
    if (MODE == 2) {
        const f32x4* wsrc = (const f32x4*)(a.in[I_WR] + (size_t)l * 16384); f32x4 wv[8];
#pragma unroll
        for (int i = 0; i < 8; ++i) wv[i] = wsrc[tid + 512 * i];
#pragma unroll
        for (int i = 0; i < 8; ++i) { const int q = tid + 512 * i, k = q >> 2, e0 = (q & 3) * 4;
            wr_l[(e0 + 0) * WRP + k] = wv[i].x; wr_l[(e0 + 1) * WRP + k] = wv[i].y; wr_l[(e0 + 2) * WRP + k] = wv[i].z; wr_l[(e0 + 3) * WRP + k] = wv[i].w; }
        __syncthreads(); }
    constexpr bool COMB = (MODE == 1 || MODE == 3);
    const int nrows = (MODE == 3) ? TL : TT; const int rpb = (nrows + G - 1) / G; const int r0 = c * rpb; const int r1 = (r0 + rpb) < nrows ? (r0 + rpb) : nrows;
    f32x4 vn[2][4]; u32x2 dln[2][4]; int son[2] = {-1, -1}; float afn[2] = {0.f, 0.f};
    auto load_pair = [&](int base) __attribute__((always_inline)) {
#pragma unroll
        for (int r = 0; r < 2; ++r) { const int row = (base + r < r1) ? base + r : base;
            const float* src = (MODE == 0 || MODE == 1) ? (row < TL ? a.in[I_X] + (size_t)row * DM : a.in[I_CTX] + (size_t)(row - TL) * DM) : X + (size_t)row * DM;
#pragma unroll
            for (int j = 0; j < 4; ++j) vn[r][j] = *(const f32x4*)(src + 256 * j + 4 * lane);
            if (COMB) {
#pragma unroll
                for (int j = 0; j < 4; ++j) dln[r][j] = *(const u32x2*)((const bf16_t*)(ws + WS_DELTA) + (size_t)row * DM + 256 * j + 4 * lane); }
            if (COMB) { son[r] = lane < 16 ? SLOTOF[(size_t)row * 16 + lane] : -1; afn[r] = lane < 16 ? AFF[(size_t)row * 16 + lane] : 0.f; } }
    };
    constexpr bool PREF = (MODE != 2);
    f32x4 gsc[4], shf[4], g2c[4], fng[4]; int mr_c = -1;
    if (MODE == 3) {
#pragma unroll
        for (int j = 0; j < 4; ++j) fng[j] = *(const f32x4*)(a.in[I_FNG] + 256 * j + 4 * lane); }
    if (PREF && r0 + 2 * wid < r1) load_pair(r0 + 2 * wid);
    for (int base = r0 + 2 * wid; base < r1; base += 16) {
        const bool two = base + 1 < r1;
        if (!PREF) load_pair(base);
        f32x4 v[2][4]; int so[2]; float af[2]; int mr[2];
#pragma unroll
        for (int r = 0; r < 2; ++r) { const int row = (r == 1 && !two) ? base : base + r; mr[r] = row < TL ? (row >> 12) : 4; so[r] = son[r]; af[r] = afn[r];
#pragma unroll
            for (int j = 0; j < 4; ++j) { v[r][j] = vn[r][j]; if (COMB) v[r][j] = v[r][j] + (f32x4){bf_lo(dln[r][j].x), bf_hi(dln[r][j].x), bf_lo(dln[r][j].y), bf_hi(dln[r][j].y)}; } }
        if (PREF && base + 16 < r1) load_pair(base + 16);
        if (mr[0] != mr_c) { mr_c = mr[0];
            if (MODE != 3) { const float* gvv = (MODE == 2 ? a.in[I_N2G] : a.in[I_N1G]) + (size_t)l * DM; const float* mb = MOD + (size_t)(l * 5 + mr_c) * 6144 + (MODE == 2 ? 3072 : 0);
#pragma unroll
                for (int j = 0; j < 4; ++j) { const int k = 256 * j + 4 * lane; gsc[j] = *(const f32x4*)(gvv + k) * (1.f + *(const f32x4*)(mb + 1024 + k)); shf[j] = *(const f32x4*)(mb + k); } }
            if (COMB) { const float* g2p = MOD + (size_t)(((MODE == 1) ? 0 : 1) * 5 + mr_c) * 6144 + 5120;
#pragma unroll
                for (int j = 0; j < 4; ++j) g2c[j] = *(const f32x4*)(g2p + 256 * j + 4 * lane); } }
        if (COMB) {
            const int lp = (MODE == 1) ? 0 : 1;
            f32x4 cacc[2][4]; unsigned mask[2];
            int s1[2], s2[2]; float w1[2], w2[2];
#pragma unroll
            for (int r = 0; r < 2; ++r) {
#pragma unroll
                for (int j = 0; j < 4; ++j) cacc[r][j] = (f32x4){0.f, 0.f, 0.f, 0.f};
                mask[r] = (r == 0 || two) ? ((unsigned)__ballot(so[r] >= 0) & 0xffffu) : 0u;
                const bool h1 = mask[r] != 0u; const int e1 = h1 ? __builtin_ctz(mask[r]) : 0; if (h1) mask[r] &= mask[r] - 1;
                const bool h2 = mask[r] != 0u; const int e2 = h2 ? __builtin_ctz(mask[r]) : e1; if (h2) mask[r] &= mask[r] - 1;
                const int t1 = __builtin_amdgcn_readlane(so[r], e1), t2 = __builtin_amdgcn_readlane(so[r], e2);
                s1[r] = h1 ? t1 : 0; s2[r] = h2 ? t2 : s1[r];
                w1[r] = h1 ? __uint_as_float(__builtin_amdgcn_readlane(__float_as_uint(af[r]), e1)) : 0.f;
                w2[r] = h2 ? __uint_as_float(__builtin_amdgcn_readlane(__float_as_uint(af[r]), e2)) : 0.f; }
            { u32x2 ya[2][4], yb[2][4];
#pragma unroll
              for (int r = 0; r < 2; ++r)
#pragma unroll
                for (int j = 0; j < 4; ++j) { ya[r][j] = *(const u32x2*)(Y + (size_t)s1[r] * 1024 + 4 * lane + 256 * j); yb[r][j] = *(const u32x2*)(Y + (size_t)s2[r] * 1024 + 4 * lane + 256 * j); }
#pragma unroll
              for (int r = 0; r < 2; ++r)
#pragma unroll
                for (int j = 0; j < 4; ++j) cacc[r][j] = cacc[r][j] + w1[r] * (f32x4){bf_lo(ya[r][j].x), bf_hi(ya[r][j].x), bf_lo(ya[r][j].y), bf_hi(ya[r][j].y)} + w2[r] * (f32x4){bf_lo(yb[r][j].x), bf_hi(yb[r][j].x), bf_lo(yb[r][j].y), bf_hi(yb[r][j].y)}; }
#pragma unroll
            for (int r = 0; r < 2; ++r) if (r == 0 || two) { const int row = base + r;
                unsigned mk = mask[r];
                while (mk) {
                    const int e1 = __builtin_ctz(mk); mk &= mk - 1;
                    const int t1 = __builtin_amdgcn_readlane(so[r], e1); const float ww = __uint_as_float(__builtin_amdgcn_readlane(__float_as_uint(af[r]), e1));
                    const bf16_t* y1 = Y + (size_t)t1 * 1024 + 4 * lane;
#pragma unroll
                    for (int j = 0; j < 4; ++j) { const u32x2 yv = *(const u32x2*)(y1 + 256 * j); cacc[r][j] = cacc[r][j] + ww * (f32x4){bf_lo(yv.x), bf_hi(yv.x), bf_lo(yv.y), bf_hi(yv.y)}; }
                }
                if (mr[r] == mr_c) {
#pragma unroll
                    for (int j = 0; j < 4; ++j) v[r][j] = v[r][j] + g2c[j] * cacc[r][j];
                } else { const float* g2 = MOD + (size_t)(lp * 5 + mr[r]) * 6144 + 5120;
#pragma unroll
                    for (int j = 0; j < 4; ++j) v[r][j] = v[r][j] + *(const f32x4*)(g2 + 256 * j + 4 * lane) * cacc[r][j]; }
                if (MODE == 1) {
#pragma unroll
                    for (int j = 0; j < 4; ++j) st16_wt(X + (size_t)row * DM + 256 * j + 4 * lane, __builtin_bit_cast(u32x4, v[r][j]));
                }
            }
        }
        float rms[2];
#pragma unroll
        for (int r = 0; r < 2; ++r) { float ss = 0.f;
#pragma unroll
            for (int j = 0; j < 4; ++j) ss += (v[r][j].x * v[r][j].x + v[r][j].y * v[r][j].y) + (v[r][j].z * v[r][j].z + v[r][j].w * v[r][j].w);
            rms[r] = 1.0f / sqrtf(wave_sum(ss) * (1.f / DM) + 1e-6f); }
        if (MODE == 3) {
#pragma unroll
            for (int r = 0; r < 2; ++r) if (r == 0 || two) {
#pragma unroll
                for (int j = 0; j < 4; ++j) *(f32x4*)(a.out + (size_t)(base + r) * DM + 256 * j + 4 * lane) = v[r][j] * rms[r] * fng[j]; }
        } else {
            const float* gv = (MODE == 2 ? a.in[I_N2G] : a.in[I_N1G]) + (size_t)l * DM;
#pragma unroll
            for (int r = 0; r < 2; ++r) {
                if (mr[r] == mr_c) {
#pragma unroll
                    for (int j = 0; j < 4; ++j) v[r][j] = (v[r][j] * rms[r]) * gsc[j] + shf[j];
                } else { const float* mb = MOD + (size_t)(l * 5 + mr[r]) * 6144 + (MODE == 2 ? 3072 : 0);
#pragma unroll
                    for (int j = 0; j < 4; ++j) { const int k = 256 * j + 4 * lane; v[r][j] = (v[r][j] * rms[r] * *(const f32x4*)(gv + k)) * (1.f + *(const f32x4*)(mb + 1024 + k)) + *(const f32x4*)(mb + k); } }
#pragma unroll
                for (int j = 0; j < 4; ++j) if (r == 0 || two) st_bf4(H + (size_t)(base + r) * DM + 256 * j + 4 * lane, v[r][j]); }
            if (MODE == 2) {
                float lg[2][16];
#pragma unroll
                for (int e = 0; e < 16; ++e) { float s0 = 0.f, s1 = 0.f;
#pragma unroll
                    for (int j = 0; j < 4; ++j) { const f32x4 w4 = *(const LAS f32x4*)(wr_l + e * WRP + 256 * j + 4 * lane);
                        s0 += (v[0][j].x * w4.x + v[0][j].y * w4.y) + (v[0][j].z * w4.z + v[0][j].w * w4.w);
                        s1 += (v[1][j].x * w4.x + v[1][j].y * w4.y) + (v[1][j].z * w4.z + v[1][j].w * w4.w); }
                    if (e & 1) asm volatile("" : "+v"(s0), "+v"(s1) :: "memory");
                    lg[0][e] = s0; lg[1][e] = s1; }
#pragma unroll
                for (int r = 0; r < 2; ++r) {
                    float a8[8], a4[4], a2[2], a1;
                    const bool b0 = lane & 1, b1 = lane & 2, b2 = lane & 4, b3 = lane & 8;
#pragma unroll
                    for (int i = 0; i < 8; ++i) { const float snd = b0 ? lg[r][i] : lg[r][i + 8], kp = b0 ? lg[r][i + 8] : lg[r][i]; a8[i] = kp + __shfl_xor(snd, 1); }
#pragma unroll
                    for (int i = 0; i < 4; ++i) { const float snd = b1 ? a8[i] : a8[i + 4], kp = b1 ? a8[i + 4] : a8[i]; a4[i] = kp + __shfl_xor(snd, 2); }
#pragma unroll
                    for (int i = 0; i < 2; ++i) { const float snd = b2 ? a4[i] : a4[i + 2], kp = b2 ? a4[i + 2] : a4[i]; a2[i] = kp + __shfl_xor(snd, 4); }
                    { const float snd = b3 ? a2[0] : a2[1], kp = b3 ? a2[1] : a2[0]; a1 = kp + __shfl_xor(snd, 8); }
                    a1 += __shfl_xor(a1, 16); a1 += __shfl_xor(a1, 32);
                    float mx = a1;
#pragma unroll
                    for (int o = 1; o < 16; o <<= 1) mx = fmaxf(mx, __shfl_xor(mx, o));
                    const float ex = expf(a1 - mx); float sum = ex;
#pragma unroll
                    for (int o = 1; o < 16; o <<= 1) sum += __shfl_xor(sum, o);
                    const int e = (b0 ? 8 : 0) + (b1 ? 4 : 0) + (b2 ? 2 : 0) + (b3 ? 1 : 0);
                    if (lane < 16 && (r == 0 || two)) AFF[(size_t)(base + r) * 16 + e] = ex / sum;
                }
            }
        }
    }
    __syncthreads();
}

DI void norm2_phase(const Args& a, int l, LAS unsigned char* lds, int G, int c) {
    const int tid = threadIdx.x, wid = __builtin_amdgcn_readfirstlane(tid >> 6), lane = tid & 63;
    unsigned char* ws = a.ws;
    const float* X = (const float*)(ws + WS_X); bf16_t* H = (bf16_t*)(ws + WS_H); const float* MOD = (const float*)(ws + WS_MOD); float* AFF = (float*)(ws + WS_AFF);
    const bf16_t* DL = (const bf16_t*)(ws + WS_DELTA);
    auto xrow = [&](int row) __attribute__((always_inline)) -> const float* { return l == 0 ? (row < TL ? a.in[I_X] + (size_t)row * DM : a.in[I_CTX] + (size_t)(row - TL) * DM) : X + (size_t)row * DM; };
    LAS float* wr_l = (LAS float*)lds;
    constexpr int WRP = 1028;
    { const f32x4* wsrc = (const f32x4*)(a.in[I_WR] + (size_t)l * 16384); f32x4 wv[8];
#pragma unroll
      for (int i = 0; i < 8; ++i) wv[i] = wsrc[tid + 512 * i];
#pragma unroll
      for (int i = 0; i < 8; ++i) { const int q = tid + 512 * i, k = q >> 2, e0 = (q & 3) * 4;
          wr_l[(e0 + 0) * WRP + k] = wv[i].x; wr_l[(e0 + 1) * WRP + k] = wv[i].y; wr_l[(e0 + 2) * WRP + k] = wv[i].z; wr_l[(e0 + 3) * WRP + k] = wv[i].w; }
      __syncthreads(); }
    const int rpb = (TT + G - 1) / G; const int r0 = c * rpb; const int r1 = (r0 + rpb) < TT ? (r0 + rpb) : TT;
    const float* gv = a.in[I_N2G] + (size_t)l * DM;
    f32x4 gsc[4], shf[4]; int mr_c = -1;
    f32x4 vn[4]; u32x2 dn[4];
    if (r0 + wid < r1) { const float* xr = xrow(r0 + wid);
#pragma unroll
        for (int j = 0; j < 4; ++j) { vn[j] = *(const f32x4*)(xr + 256 * j + 4 * lane); dn[j] = *(const u32x2*)(DL + (size_t)(r0 + wid) * DM + 256 * j + 4 * lane); } }
    for (int row = r0 + wid; row < r1; row += 8) {
        f32x4 v[4];
#pragma unroll
        for (int j = 0; j < 4; ++j) v[j] = vn[j] + (f32x4){bf_lo(dn[j].x), bf_hi(dn[j].x), bf_lo(dn[j].y), bf_hi(dn[j].y)};
        if (row + 8 < r1) { const float* xr = xrow(row + 8);
#pragma unroll
            for (int j = 0; j < 4; ++j) { vn[j] = *(const f32x4*)(xr + 256 * j + 4 * lane); dn[j] = *(const u32x2*)(DL + (size_t)(row + 8) * DM + 256 * j + 4 * lane); } }
        const int mr = row < TL ? (row >> 12) : 4;
        float ss = 0.f;
#pragma unroll
        for (int j = 0; j < 4; ++j) ss += (v[j].x * v[j].x + v[j].y * v[j].y) + (v[j].z * v[j].z + v[j].w * v[j].w);
        const float rms = 1.0f / sqrtf(wave_sum(ss) * (1.f / DM) + 1e-6f);
        if (mr != mr_c) { mr_c = mr; const float* mb = MOD + (size_t)(l * 5 + mr) * 6144 + 3072;
#pragma unroll
            for (int j = 0; j < 4; ++j) { const int k = 256 * j + 4 * lane; gsc[j] = *(const f32x4*)(gv + k) * (1.f + *(const f32x4*)(mb + 1024 + k)); shf[j] = *(const f32x4*)(mb + k); } }
#pragma unroll
        for (int j = 0; j < 4; ++j) { const int k = 256 * j + 4 * lane;
            v[j] = (v[j] * rms) * gsc[j] + shf[j];
            st_bf4(H + (size_t)row * DM + k, v[j]); }
        float lg[16];
#pragma unroll
        for (int e = 0; e < 16; ++e) { float s0 = 0.f;
#pragma unroll
            for (int j = 0; j < 4; ++j) { const f32x4 w4 = *(const LAS f32x4*)(wr_l + e * WRP + 256 * j + 4 * lane); s0 += (v[j].x * w4.x + v[j].y * w4.y) + (v[j].z * w4.z + v[j].w * w4.w); }
            if ((e & 3) == 3) asm volatile("" : "+v"(s0) :: "memory");
            lg[e] = s0; }
        float a8[8], a4[4], a2[2], a1;
        const bool b0 = lane & 1, b1 = lane & 2, b2 = lane & 4, b3 = lane & 8;
#pragma unroll
        for (int i = 0; i < 8; ++i) { const float snd = b0 ? lg[i] : lg[i + 8], kp = b0 ? lg[i + 8] : lg[i]; a8[i] = kp + __shfl_xor(snd, 1); }
#pragma unroll
        for (int i = 0; i < 4; ++i) { const float snd = b1 ? a8[i] : a8[i + 4], kp = b1 ? a8[i + 4] : a8[i]; a4[i] = kp + __shfl_xor(snd, 2); }
#pragma unroll
        for (int i = 0; i < 2; ++i) { const float snd = b2 ? a4[i] : a4[i + 2], kp = b2 ? a4[i + 2] : a4[i]; a2[i] = kp + __shfl_xor(snd, 4); }
        { const float snd = b3 ? a2[0] : a2[1], kp = b3 ? a2[1] : a2[0]; a1 = kp + __shfl_xor(snd, 8); }
        a1 += __shfl_xor(a1, 16); a1 += __shfl_xor(a1, 32);
        float mx = a1;
#pragma unroll
        for (int o = 1; o < 16; o <<= 1) mx = fmaxf(mx, __shfl_xor(mx, o));
        const float ex = expf(a1 - mx); float sum = ex;
#pragma unroll
        for (int o = 1; o < 16; o <<= 1) sum += __shfl_xor(sum, o);
        const int e = (b0 ? 8 : 0) + (b1 ? 4 : 0) + (b2 ? 2 : 0) + (b3 ? 1 : 0);
        if (lane < 16) AFF[(size_t)row * 16 + e] = ex / sum;
    }
    __syncthreads();
}

constexpr int KPITCH = 144, VPITCH = 272;
constexpr int ATT_K = 0, ATT_V = 128 * KPITCH, ATT_WS = ATT_V + 64 * VPITCH;

DI void attn_seg(int kind, int qb, int tq0, int ctx0, int i, int& tok0, int& mode) {
    mode = 0;
    if (kind == 1) { tok0 = ctx0 + i * 128; return; }
    if (i == 0) tok0 = tq0;
    else if (i < 3) tok0 = ctx0 + (i - 1) * 128;
    else if (i == 3 && qb > 0) { tok0 = tq0 - 128; mode = 1; }
    else { tok0 = tq0 + 128; mode = 2; }
}
DI void attn_unit(const Args& a, int l, LAS unsigned char* lds, int kind, int b, int qb, int kh, int hh) {
    const int tid = threadIdx.x, lane = tid & 63, r32 = lane & 31, hi = lane >> 5; const int wid = __builtin_amdgcn_readfirstlane(tid >> 6);
    unsigned char* ws = a.ws;
    const bf16_t* Q = (const bf16_t*)(ws + WS_Q); const bf16_t* Kb = (const bf16_t*)(ws + WS_K); const bf16_t* VT = (const bf16_t*)(ws + WS_VT); bf16_t* BR = (bf16_t*)(ws + WS_BR);
    const int tq0 = kind == 0 ? b * SEQ + qb * 128 : TL + b * CTXL + qb * 128;
    const int ctx0 = TL + b * CTXL;
    const int h = kh * 4 + hh * 2 + (wid >> 2), qs = (wid & 3) * 32;
    const int qi = qs + r32;
    LAS float* wsf = (LAS float*)(lds + ATT_WS) + wid * 64;
    const int nseg = kind == 0 ? 3 + (qb > 0 ? 1 : 0) + (qb < 31 ? 1 : 0) : 2;
    const int krow = tid >> 3, kch = tid & 7, vrow = tid >> 4, vch = tid & 15;
    u32x4 kreg[2], vreg[2];
    { int tok0, mode; attn_seg(kind, qb, tq0, ctx0, 0, tok0, mode);
#pragma unroll
      for (int i = 0; i < 2; ++i) { kreg[i] = *(const u32x4*)(Kb + (size_t)(tok0 + krow + 64 * i) * 128 + kh * 64 + kch * 8); vreg[i] = *(const u32x4*)(VT + (size_t)(kh * 64 + vrow + 32 * i) * TT + tok0 + vch * 8); } }
    bf16x8 qf[4];
#pragma unroll
    for (int s = 0; s < 4; ++s) qf[s] = *(const bf16x8*)(Q + (size_t)(tq0 + qi) * 512 + h * 64 + s * 16 + hi * 8);
    float mrun = -1e30f, lrun = 0.f;
    f32x16 o[2];
#pragma unroll
    for (int d0 = 0; d0 < 2; ++d0)
#pragma unroll
        for (int r = 0; r < 16; ++r) o[d0][r] = 0.f;
    for (int sg = 0; sg < nseg; ++sg) {
        int tok0, mode; attn_seg(kind, qb, tq0, ctx0, sg, tok0, mode);
        int lo_lim = mode == 1 ? qi : -100000, hi_lim = mode == 2 ? qi : 100000;
        asm volatile("" : "+v"(lo_lim), "+v"(hi_lim));
        __syncthreads();
#pragma unroll
        for (int i = 0; i < 2; ++i) { *(LAS u32x4*)(lds + ATT_K + (krow + 64 * i) * KPITCH + kch * 16) = kreg[i]; *(LAS u32x4*)(lds + ATT_V + (vrow + 32 * i) * VPITCH + vch * 16) = vreg[i]; }
        __syncthreads();
        if (sg + 1 < nseg) { int tn, mn; attn_seg(kind, qb, tq0, ctx0, sg + 1, tn, mn);
#pragma unroll
            for (int i = 0; i < 2; ++i) { kreg[i] = *(const u32x4*)(Kb + (size_t)(tn + krow + 64 * i) * 128 + kh * 64 + kch * 8); vreg[i] = *(const u32x4*)(VT + (size_t)(kh * 64 + vrow + 32 * i) * TT + tn + vch * 8); } }
#pragma unroll 1
        for (int tk = 0; tk < 2; ++tk) {
            if (mode == 1 && tk * 64 + 63 < qs) continue;
            if (mode == 2 && tk * 64 > qs + 31) continue;
            f32x16 s0, s1;
#pragma unroll
            for (int r = 0; r < 16; ++r) { s0[r] = 0.f; s1[r] = 0.f; }
            const LAS unsigned char* kp = lds + ATT_K + (tk * 64 + r32) * KPITCH + hi * 16;
#pragma unroll
            for (int s = 0; s < 4; ++s) {
                const bf16x8 k0 = *(const LAS bf16x8*)(kp + s * 32);
                const bf16x8 k1 = *(const LAS bf16x8*)(kp + 32 * KPITCH + s * 32);
                s0 = __builtin_amdgcn_mfma_f32_32x32x16_bf16(k0, qf[s], s0, 0, 0, 0);
                s1 = __builtin_amdgcn_mfma_f32_32x32x16_bf16(k1, qf[s], s1, 0, 0, 0);
            }
            asm volatile("s_nop 15\n\ts_nop 7" : "+v"(s0), "+v"(s1));
            if (mode != 0) {
                const int kb0 = tk * 64 + 4 * hi;
#pragma unroll
                for (int r = 0; r < 16; ++r) { const int kj = kb0 + (r & 3) + 8 * (r >> 2);
                    if (kj < lo_lim || kj > hi_lim) s0[r] = -1e30f;
                    if (kj + 32 < lo_lim || kj + 32 > hi_lim) s1[r] = -1e30f; }
            }
            float tm = mrun;
            float tm2 = s0[0];
#pragma unroll
            for (int r = 0; r < 16; r += 2) { tm = max3f(tm, s0[r], s1[r]); tm2 = max3f(tm2, s0[r + 1], s1[r + 1]); }
            tm = max3f(tm, tm2, __shfl_xor(max3f(tm, tm2, tm2), 32));
            const float mnew = tm;
            typedef float f32x2 __attribute__((ext_vector_type(2)));
            f32x2 ls2 = {0.f, 0.f}; const f32x2 m2 = {mnew, mnew};
#pragma unroll
            for (int r = 0; r < 16; r += 2) {
                f32x2 a = (f32x2){s0[r], s0[r + 1]} - m2, b = (f32x2){s1[r], s1[r + 1]} - m2;
                a.x = __builtin_amdgcn_exp2f(a.x); a.y = __builtin_amdgcn_exp2f(a.y); b.x = __builtin_amdgcn_exp2f(b.x); b.y = __builtin_amdgcn_exp2f(b.y);
                s0[r] = a.x; s0[r + 1] = a.y; s1[r] = b.x; s1[r + 1] = b.y; ls2 = ls2 + a + b; }
            const float ls = ls2.x + ls2.y;
            if (__any(mnew > mrun)) {
                const float alpha = __builtin_amdgcn_exp2f(mrun - mnew);
                lrun *= alpha;
                if (hi == 0) wsf[r32] = alpha;
#pragma unroll
                for (int r = 0; r < 16; ++r) { const float f = wsf[crow(r, hi)]; o[0][r] *= f; o[1][r] *= f; }
            }
            mrun = mnew; lrun += ls;
            const LAS unsigned char* vp0 = lds + ATT_V + r32 * VPITCH + (tk * 64 + 4 * hi) * 2;
#pragma unroll
            for (int cc = 0; cc < 2; ++cc)
#pragma unroll
                for (int s = 0; s < 2; ++s) {
                    u32x4 pw;
                    if (cc == 0) { pw.x = pk_bf16(s0[8 * s], s0[8 * s + 1]); pw.y = pk_bf16(s0[8 * s + 2], s0[8 * s + 3]); pw.z = pk_bf16(s0[8 * s + 4], s0[8 * s + 5]); pw.w = pk_bf16(s0[8 * s + 6], s0[8 * s + 7]); }
                    else { pw.x = pk_bf16(s1[8 * s], s1[8 * s + 1]); pw.y = pk_bf16(s1[8 * s + 2], s1[8 * s + 3]); pw.z = pk_bf16(s1[8 * s + 4], s1[8 * s + 5]); pw.w = pk_bf16(s1[8 * s + 6], s1[8 * s + 7]); }
                    const bf16x8 pa = __builtin_bit_cast(bf16x8, pw);
#pragma unroll
                    for (int d0 = 0; d0 < 2; ++d0) {
                        const LAS unsigned char* vp = vp0 + d0 * 32 * VPITCH + (cc * 32 + s * 16) * 2;
                        const s16x4 lo = *(const LAS s16x4*)vp, hh2 = *(const LAS s16x4*)(vp + 16);
                        const bf16x8 vb = (bf16x8){lo[0], lo[1], lo[2], lo[3], hh2[0], hh2[1], hh2[2], hh2[3]};
                        o[d0] = __builtin_amdgcn_mfma_f32_32x32x16_bf16(pa, vb, o[d0], 0, 0, 0);
                    }
                }
        }
    }
    const float sk = a.in[I_SINK][l * 8 + h] * LOG2E;
    {
        const float lt = lrun + __shfl_xor(lrun, 32) + __builtin_amdgcn_exp2f(sk - mrun);
        if (hi == 0) wsf[r32] = 1.f / lt;
#pragma unroll
        for (int r = 0; r < 16; ++r) { const float f = wsf[crow(r, hi)]; bf16_t* op = BR + (size_t)(tq0 + qs + crow(r, hi)) * 1536 + h * 64 + r32;
            op[0] = f2bf(o[0][r] * f); op[32] = f2bf(o[1][r] * f); }
    }
    __syncthreads();
}

DI void seq_bounds(int t0, int& lo, int& hi) { if (t0 < TL) { lo = t0 & ~(SEQ - 1); hi = lo + SEQ; } else { lo = TL + ((t0 - TL) & ~(CTXL - 1)); hi = lo + CTXL; } }

DI void conv_unit(const Args& a, int l, LAS unsigned char* lds, int t0) {
    const int tid = threadIdx.x, lane = tid & 63; const int wid = __builtin_amdgcn_readfirstlane(tid >> 6);
    const bf16_t* U = (const bf16_t*)(a.ws + WS_U); bf16_t* BR = (bf16_t*)(a.ws + WS_BR);
    int slo, shi; seq_bounds(t0, slo, shi);
    const int c = tid; float w[31];
#pragma unroll
    for (int k = 0; k < 31; ++k) w[k] = a.in[I_CDW][((size_t)l * 31 + k) * 512 + c];
    const float bias = a.in[I_CDWB][l * 512 + c];
    { u32x4 tv[8];
#pragma unroll
      for (int i = 0; i < 8; ++i) { const int idx = tid + 512 * i; const int row = idx >> 6, ch = idx & 63; const int tok = t0 - 15 + row; tv[i] = (u32x4){0u, 0u, 0u, 0u};
          if (row < 62 && tok >= slo && tok < shi) tv[i] = *(const u32x4*)(U + (size_t)tok * 512 + ch * 8); }
#pragma unroll
      for (int i = 0; i < 8; ++i) { const int idx = tid + 512 * i; const int row = idx >> 6, ch = idx & 63; if (row < 62) *(LAS u32x4*)(lds + row * 1024 + ch * 16) = tv[i]; } }
    __syncthreads();
    float xin[62];
#pragma unroll
    for (int i = 0; i < 62; ++i) xin[i] = bf2f(((const LAS bf16_t*)lds)[i * 512 + c]);
    LAS float* cs = (LAS float*)(lds + 65536);
#pragma unroll
    for (int t = 0; t < 32; ++t) { float acc = bias;
#pragma unroll
        for (int k = 0; k < 31; ++k) acc = fmaf(xin[t + k], w[k], acc);
        cs[t * 512 + c] = acc; }
    __syncthreads();
    const float* lg = a.in[I_CLNG] + l * 512; const float* lb = a.in[I_CLNB] + l * 512;
#pragma unroll
    for (int tt = 0; tt < 4; ++tt) { const int t = 4 * wid + tt; float v[8]; float s = 0.f;
#pragma unroll
        for (int i = 0; i < 8; ++i) { v[i] = cs[t * 512 + lane + 64 * i]; s += v[i]; }
        const float mean = wave_sum(s) * (1.f / 512.f); float q = 0.f;
#pragma unroll
        for (int i = 0; i < 8; ++i) { v[i] -= mean; q += v[i] * v[i]; }
        const float rstd = 1.0f / sqrtf(wave_sum(q) * (1.f / 512.f) + 1e-6f);
#pragma unroll
        for (int i = 0; i < 8; ++i) { const int c2 = lane + 64 * i; const float y = v[i] * rstd * lg[c2] + lb[c2]; BR[(size_t)(t0 + t) * 1536 + 512 + c2] = f2bf(y * sigm(y)); } }
    __syncthreads();
}
template <int HALF> DI void pool_compute(const LAS bf16_t* zs, int c, int t0, int slo, int shi, bf16_t* BR) {
    float P[49];
    float zc[32];
    P[0] = 0.f;
#pragma unroll
    for (int r = 0; r < 48; ++r) { const float z = bf2f(zs[r * 512 + c]); P[r + 1] = P[r] + z; if (r >= 8 && r < 40) zc[r - 8] = z; }
#pragma unroll
    for (int t = 0; t < 32; ++t) { const int tt = t0 + t; const int lo = (tt - HALF) > slo ? (tt - HALF) : slo, hi = (tt + HALF) < shi ? (tt + HALF) : shi;
        const float d = (P[t + 8 + HALF] - P[t + 8 - HALF]) * __builtin_amdgcn_rcpf((float)(hi - lo)) - zc[t];
        BR[(size_t)tt * 1536 + 1024 + c] = f2bf(d); }
}
DI void pool_unit(const Args& a, LAS unsigned char* lds, int t0) {
    const int tid = threadIdx.x;
    const bf16_t* Z = (const bf16_t*)(a.ws + WS_Z); bf16_t* BR = (bf16_t*)(a.ws + WS_BR);
    int slo, shi; seq_bounds(t0, slo, shi);
    { u32x4 tv[6];
#pragma unroll
      for (int i = 0; i < 6; ++i) { const int idx = tid + 512 * i; const int row = idx >> 6, ch = idx & 63; const int tok = t0 - 8 + row; tv[i] = (u32x4){0u, 0u, 0u, 0u};
          if (tok >= slo && tok < shi) tv[i] = *(const u32x4*)(Z + (size_t)tok * 512 + ch * 8); }
#pragma unroll
      for (int i = 0; i < 6; ++i) { const int idx = tid + 512 * i; const int row = idx >> 6, ch = idx & 63; *(LAS u32x4*)(lds + row * 1024 + ch * 16) = tv[i]; } }
    __syncthreads();
    const int c = tid; const int gi = __builtin_amdgcn_readfirstlane(c >> 7); const LAS bf16_t* zs = (const LAS bf16_t*)lds;
    if (gi == 0) pool_compute<1>(zs, c, t0, slo, shi, BR); else if (gi == 1) pool_compute<2>(zs, c, t0, slo, shi, BR);
    else if (gi == 2) pool_compute<4>(zs, c, t0, slo, shi, BR); else pool_compute<8>(zs, c, t0, slo, shi, BR);
    __syncthreads();
}
DI void phase_mix(const Args& a, int l, LAS unsigned char* lds, int G, int c, const SchedInProj& SI, const EpiInProj& EI) {
    for (int u = c; u < 512; u += G) attn_unit(a, l, lds, 0, u >> 7, (u >> 2) & 31, (u >> 1) & 1, u & 1);
    const int ng = (SI.hi - SI.lo) < G ? (SI.hi - SI.lo) : G;
    const int nconv = l == 0 ? TT / 32 : TL / 32;
    const bool gblk = c < ng; const int nrest = G - ng;
    const int sg = nrest > 0 ? (l == 0 ? 130 : 40) : 256;
    const int ncg = ng > 0 ? (nconv * sg) >> 8 : 0;
    const int jb = gblk ? 0 : ncg, j1 = gblk ? ncg : nconv, js = gblk ? ng : nrest, ci = gblk ? c : c - ng;
    for (int j = jb + ci; j < j1; j += js) conv_unit(a, l, lds, j * 32);
    for (int j = jb + (js - 1 - ci); j < j1; j += js) pool_unit(a, lds, j * 32);
    if (l == 0) { const int x0 = nrest >= 32 ? c - ng : c;
        if (x0 >= 0) for (int x = x0; x < 32; x += (nrest >= 32 ? nrest : G)) attn_unit(a, l, lds, 1, x >> 3, (x >> 2) & 1, (x >> 1) & 1, x & 1); }
    if (ng > 0) pg8::gemm_phase(lds, SI, EI);
}

DI void topk_unit(const Args& a, LAS unsigned char* lds, int set, int e) {
    const int tid = threadIdx.x, lane = tid & 63, wid = tid >> 6; const bool lat = set < 4; const int b = set & 3;
    const int N = lat ? SEQ : CTXL, cap = N / 8, tok0 = lat ? b * SEQ : TL + b * CTXL, sbase = e * ESLOT + (lat ? b * 512 : 2048 + b * 32);
    const float* AFF = (const float*)(a.ws + WS_AFF); int* SLOTOF = (int*)(a.ws + WS_SLOTOF); int* TOKOF = (int*)(a.ws + WS_TOKOF);
    LAS unsigned* hist = (LAS unsigned*)lds; LAS unsigned* wtot = hist + 256; LAS unsigned* bc = hist + 272;
    int nvalid = N - tid * 8; nvalid = nvalid < 0 ? 0 : (nvalid > 8 ? 8 : nvalid);
    unsigned v[8];
#pragma unroll
    for (int j = 0; j < 8; ++j) v[j] = j < nvalid ? __float_as_uint(AFF[(size_t)(tok0 + tid * 8 + j) * 16 + e]) : 0u;
    unsigned prefix = 0u, pmask = 0u; unsigned need = (unsigned)cap;
#pragma unroll 1
    for (int r = 0; r < 4; ++r) {
        const int shift = 24 - 8 * r;
        if (tid < 256) hist[tid] = 0u;
        __syncthreads();
#pragma unroll
        for (int j = 0; j < 8; ++j) if (j < nvalid && (v[j] & pmask) == prefix) __hip_atomic_fetch_add(&hist[(v[j] >> shift) & 255u], 1u, __ATOMIC_RELAXED, __HIP_MEMORY_SCOPE_WORKGROUP);
        __syncthreads();
        unsigned hv = 0u, suf = 0u;
        if (tid < 256) { hv = hist[tid]; suf = hv;
#pragma unroll
            for (int o = 1; o < 64; o <<= 1) { const unsigned t = __shfl_down(suf, o); if (lane + o < 64) suf += t; }
            if (lane == 0) wtot[wid] = suf; }
        __syncthreads();
        if (tid < 256) { unsigned above = 0u; for (int w = wid + 1; w < 4; ++w) above += wtot[w];
            suf += above; const unsigned sn = suf - hv;
            if (suf >= need && sn < need) { bc[0] = (unsigned)tid; bc[1] = need - sn; } }
        __syncthreads();
        prefix |= bc[0] << shift; pmask |= 255u << shift; need = bc[1];
    }
    const unsigned T = prefix, need_eq = need, count_gt = (unsigned)cap - need_eq;
    unsigned cg = 0u, ce = 0u;
#pragma unroll
    for (int j = 0; j < 8; ++j) if (j < nvalid) { cg += v[j] > T ? 1u : 0u; ce += v[j] == T ? 1u : 0u; }
    const unsigned pk = cg | (ce << 16); unsigned inc = pk;
#pragma unroll
    for (int o = 1; o < 64; o <<= 1) { const unsigned t = __shfl_up(inc, o); if (lane >= o) inc += t; }
    if (lane == 63) wtot[wid] = inc;
    __syncthreads();
    unsigned basev = 0u; for (int w = 0; w < wid; ++w) basev += wtot[w];
    const unsigned ex = basev + inc - pk; unsigned rg = ex & 0xffffu, re = ex >> 16;
#pragma unroll
    for (int j = 0; j < 8; ++j) if (j < nvalid) { const int tok = tok0 + tid * 8 + j; int slot = -1;
        if (v[j] > T) { slot = sbase + (int)rg; ++rg; } else if (v[j] == T) { if (re < need_eq) slot = sbase + (int)(count_gt + re); ++re; }
        SLOTOF[(size_t)tok * 16 + e] = slot; if (slot >= 0) TOKOF[slot] = tok; }
    if (set == 4 && tid < 128) TOKOF[e * ESLOT + 2176 + tid] = 0;
    __syncthreads();
}

#define XB_TMO      128
#define XB_XCNT(j)  (256  + 64 * (j))
#define XB_XSUB(j)  (1280 + 64 * (j))
#define XB_XGEN(j)  (2304 + 64 * (j))
#define XB_TOP      3328
#define XB_TOPGEN   3392
#define XCD_BAR_WORDS 3456
#define XB_SPIN_CAP (1u << 22)
DI unsigned xb_ld(unsigned* p) { return __hip_atomic_load(p, __ATOMIC_RELAXED, __HIP_MEMORY_SCOPE_AGENT); }
DI unsigned xb_add(unsigned* p, unsigned v) { return __hip_atomic_fetch_add(p, v, __ATOMIC_RELAXED, __HIP_MEMORY_SCOPE_AGENT); }
DI unsigned xb_xcc_id() { return (unsigned)__builtin_amdgcn_s_getreg((3 << 11) | 20) & 0xFu; }
#define XB_SPIN(cond, bar) do { unsigned _sp = 0; while (cond) { __builtin_amdgcn_s_sleep(1); \
    if ((++_sp & 255u) == 0u) { if (xb_ld(&(bar)[XB_TMO])) break; if (_sp > XB_SPIN_CAP) { atomicAdd(&(bar)[XB_TMO], 1u); break; } } } } while (0)
struct XcdBarrier { unsigned* bar; unsigned x; volatile LAS unsigned* st; };
DI XcdBarrier xcd_barrier_post(unsigned* bar, volatile LAS unsigned* st) {
    XcdBarrier b; b.bar = bar; b.x = xb_xcc_id(); b.st = st;
    if (threadIdx.x == 0) (void)xb_add(&bar[XB_XCNT(b.x)], 1u);
    return b;
}
DI void xcd_barrier_complete(unsigned* bar, unsigned x, unsigned& nloc, unsigned& nx) {
    const unsigned G = gridDim.x * gridDim.y * gridDim.z;
    unsigned sum, cnt, mine, sp = 0u;
    for (;;) {
        sum = 0u; cnt = 0u; mine = 0u;
#pragma unroll
        for (unsigned j = 0; j < 16; ++j) { const unsigned c = xb_ld(&bar[XB_XCNT(j)]); sum += c; cnt += (c > 0u) ? 1u : 0u; mine = (j == x) ? c : mine; }
        if (sum == G) break;
        __builtin_amdgcn_s_sleep(1);
        if ((++sp & 255u) == 0u) { if (xb_ld(&bar[XB_TMO])) break; if (sp > XB_SPIN_CAP) { atomicAdd(&bar[XB_TMO], 1u); break; } }
    }
    nloc = mine > 0u ? mine : 1u; nx = cnt > 0u ? cnt : 1u;
}
DI void xcd_barrier(const XcdBarrier& b) {
    asm volatile("s_waitcnt vmcnt(0)" ::: "memory");
    __syncthreads();
    if (threadIdx.x == 0) {
        unsigned* bar = b.bar;
        __builtin_amdgcn_s_waitcnt(0);
        unsigned nloc = b.st[0], nx = b.st[1];
        if (nloc == 0u) { xcd_barrier_complete(bar, b.x, nloc, nx); b.st[0] = nloc; b.st[1] = nx; }
        const unsigned old = xb_add(&bar[XB_XSUB(b.x)], 1u);
        const unsigned gen = old / nloc;
        if (old + 1u == (gen + 1u) * nloc) {
            __builtin_amdgcn_fence(__ATOMIC_RELEASE, "agent");
            asm volatile("s_waitcnt vmcnt(0)" ::: "memory");
            const unsigned og = xb_add(&bar[XB_TOP], 1u);
            const unsigned tg = og / nx;
            if (og + 1u == (tg + 1u) * nx) xb_add(&bar[XB_TOPGEN], 1u);
            else XB_SPIN(xb_ld(&bar[XB_TOPGEN]) == tg, bar);
            __builtin_amdgcn_fence(__ATOMIC_ACQUIRE, "agent");
            xb_add(&bar[XB_XGEN(b.x)], 1u);
            asm volatile("s_waitcnt vmcnt(0)" ::: "memory");
        } else {
            XB_SPIN(xb_ld(&bar[XB_XGEN(b.x)]) == gen, bar);
            __builtin_amdgcn_fence(__ATOMIC_ACQUIRE, "agent");
            asm volatile("s_waitcnt vmcnt(0)" ::: "memory");
        }
    }
    __syncthreads();
}

#if !MK_PER_PHASE
#define GRID_BAR() xcd_barrier(bar)
#else
#define GRID_BAR() do {} while (0)
#endif
#ifndef PROBE_DUP
#define PROBE_DUP 0
#endif
#define REPS(bit) (1 + ((PROBE_DUP >> (bit)) & 1))
#define REP(bit) for (int _r = 0; _r < REPS(bit); ++_r)
#define REPU(bit) _Pragma("unroll") for (int _r = 0; _r < REPS(bit); ++_r)
#define REPBAR() do { if (_r) GRID_BAR(); } while (0)
#define IN(k) (lo <= (k) && (k) < hi)
#ifndef PROBE_SPIN
#define PROBE_SPIN (-1)
#endif
#ifndef PROBE_SPIN_END
#define PROBE_SPIN_END (PROBE_SPIN + 1)
#endif
#ifndef PROBE_MULT
#define PROBE_MULT 4
#endif
#define STAMP(k) do { if (PROBE_SPIN >= 0 && blockIdx.x == 0 && threadIdx.x == 0) ((volatile LAS unsigned long long*)(lds + LDS_MISC_OFF + 256))[k] = __builtin_amdgcn_s_memrealtime(); } while (0)
#define SEAM(k) do { if (lo < (k) && (k) < hi) GRID_BAR(); STAMP(k); } while (0)

DI void gu_run(const Args& a, int l, LAS unsigned char* lds, int G, int c, int lo, int hi, int c0) {
    unsigned char* ws = a.ws; const int tid = threadIdx.x;
    const int* TOKOF = (const int*)(ws + WS_TOKOF); LAS int* idx = (LAS int*)(lds + LDS_IDX_OFF);
    if (c0 < 0) return;
    for (int ibase = 0; lo + ibase * G + c0 < hi; ibase += 8) {
        __syncthreads();
        for (int q = tid; q < 8 * 256; q += 512) { const int i = q >> 8; const int Lu = lo + (ibase + i) * G + c0;
            if (Lu < hi) { int e, mt, n8; gu_decode(Lu, e, mt, n8); idx[q] = TOKOF[e * ESLOT + mt * 256 + (q & 255)]; } }
        __syncthreads();
        SchedGU S; S.nt = 16; S.ldb_b = 2048; S.lda_b = 2048; S.G = G; S.c = c; S.A = (const char*)(ws + WS_H); S.B = (const char*)(ws + ws_wgu(l)); S.lo = lo; S.hi = hi; S.c0 = c0; S.ibase = ibase; S.idx = idx;
        EpiGU E{(bf16_t*)(ws + WS_ACT)};
        pg8::gemm_phase(lds, S, E);
    }
}

template <int L> DI void run_layer(const Args& a, LAS unsigned char* lds, int G, int c, int lo, int hi, const XcdBarrier& bar) {
    unsigned char* ws = a.ws;
    constexpr int l = L, base = 1 + 9 * L, nM = L == 0 ? 68 : 64, nmt = L == 0 ? 9 : 8;
    const int tid = threadIdx.x;
    SEAM(base + 0);
    if (IN(base + 0)) { if (L == 0) { REP(0) { REPBAR(); norm_phase<0>(a, 0, lds, G, c); } } else norm_phase<1>(a, 1, lds, G, c); }
    SEAM(base + 1);
#define MK_INPROJ_SCHED(SI, EI) \
    SchedInProj SI; SI.nt = 16; SI.ldb_b = 2048; SI.lda_b = 2048; SI.G = G; SI.c = c; SI.A = (const char*)(ws + WS_H); SI.B = (const char*)(ws + WS_WIN) + (size_t)l * INW * 2048; \
    SI.init_counts(nM, l == 0 ? 0 : 4); \
    const int np2 = (SI.ntot / G) * G > 0 ? (SI.ntot / G) * G : SI.ntot;      \
    const EpiInProj EI{(bf16_t*)(ws + WS_Q), (bf16_t*)(ws + WS_K), (bf16_t*)(ws + WS_VT), (bf16_t*)(ws + WS_U), (bf16_t*)(ws + WS_Z), (bf16_t*)(ws + WS_G), (const float*)(ws + WS_ROPE)};
    if (IN(base + 1)) REPU(1) { REPBAR();
        MK_INPROJ_SCHED(SI, EI)
        SI.lo = 0; SI.hi = np2;
        pg8::gemm_phase(lds, SI, EI);
    }
    SEAM(base + 2);
    if (IN(base + 2)) REP(2) { REPBAR(); MK_INPROJ_SCHED(SI, EI) SI.lo = np2; SI.hi = SI.ntot; phase_mix(a, l, lds, G, c, SI, EI); }
    SEAM(base + 3);
    if (IN(base + 3)) REP(3) { REPBAR();
        SchedMerge S; S.nt = 24; S.ldb_b = 3072; S.lda_b = 3072; S.G = G; S.c = c; S.A = (const char*)(ws + WS_BR); S.B = (const char*)(ws + WS_WMERGE) + (size_t)l * 1024 * 3072; S.nM = nM;
        EpiMerge E{(const bf16_t*)(ws + WS_G), (bf16_t*)(ws + WS_MERGED)};
        pg8::gemm_phase(lds, S, E);
        if (L == 0) convert_pull(a, 0, tid & 63);
    }
    SEAM(base + 4);
    if (IN(base + 4)) for (int _r = 0; _r < (L == 0 ? REPS(4) : 1); ++_r) { REPBAR();
        SchedOut S; S.nt = 16; S.ldb_b = 2048; S.lda_b = 2048; S.G = G; S.c = c; S.A = (const char*)(ws + WS_MERGED); S.B = (const char*)(ws + WS_WOUT) + (size_t)l * 1024 * 2048; S.nM = nM;
        EpiOut E{(bf16_t*)(ws + WS_DELTA), (const float*)(ws + WS_MOD), l};
        pg8::gemm_phase(lds, S, E);
        if (L == 0) convert_pull(a, 0, tid & 63);
    }
    SEAM(base + 5);
    if (IN(base + 5)) REP(5) { REPBAR(); norm2_phase(a, l, lds, G, c); }
    SEAM(base + 6);
    if (IN(base + 6)) REP(6) { REPBAR();
        const int nu = l == 0 ? 128 : 64;
        for (int u = c; u < nu; u += G) topk_unit(a, lds, u >> 4, u & 15);
        if (l == 1) {
            const int wid = __builtin_amdgcn_readfirstlane(tid >> 6);
            convert_experts(a, 1, c * 8 + wid, G * 8, tid & 63);
        }
    }
    SEAM(base + 7);
    if (IN(base + 7)) REP(7) { REPBAR();
        gu_run(a, l, lds, G, c, 0, NE * 64, c);
    }
    SEAM(base + 8);
    if (IN(base + 8)) REP(8) { REPBAR();
        unsigned* dep = (unsigned*)(ws + WS_BAR) + CTR_WORD0 + 4 * CTR_STRIDE;
        const int nctx = nmt > 8 ? NE * 8 : 0;
        if (nctx > 0) {
            gu_run(a, l, lds, G, c, NE * 64, NE * 64 + nctx, c < nctx ? c : -1);
            if (c < nctx && tid == 0) {
                __builtin_amdgcn_fence(__ATOMIC_RELEASE, "agent"); asm volatile("s_waitcnt vmcnt(0)" ::: "memory");
                __hip_atomic_fetch_add(dep, 1u, __ATOMIC_RELAXED, __HIP_MEMORY_SCOPE_AGENT); }
        }
        { SchedDown S; S.nt = 16; S.ldb_b = 2048; S.lda_b = 2048; S.G = G; S.c = c; S.A = (const char*)(ws + WS_ACT); S.B = (const char*)(ws + ws_wdn(l)); S.lo = 0; S.hi = NE * 32; S.c0 = c;
          EpiDown E{(bf16_t*)(ws + WS_Y)};
          pg8::gemm_phase(lds, S, E); }
        if (nctx > 0) {
            const int cd = (c >= nctx && G >= nctx + NE * 4) ? c - nctx : (G < nctx + NE * 4 ? c : -1);
            if (cd >= 0 && cd < NE * 4) {
                if (tid == 0) { unsigned sp = 0; while (__hip_atomic_load(dep, __ATOMIC_RELAXED, __HIP_MEMORY_SCOPE_AGENT) < (unsigned)nctx) { __builtin_amdgcn_s_sleep(8); if (++sp > (1u << 22)) break; }
                    __builtin_amdgcn_fence(__ATOMIC_ACQUIRE, "agent"); asm volatile("s_waitcnt vmcnt(0)" ::: "memory"); }
                __syncthreads();
            }
            SchedDown S; S.nt = 16; S.ldb_b = 2048; S.lda_b = 2048; S.G = G; S.c = c; S.A = (const char*)(ws + WS_ACT); S.B = (const char*)(ws + ws_wdn(l)); S.lo = NE * 32; S.hi = NE * 36; S.c0 = (cd >= 0 && cd < NE * 4) ? cd : -1;
            EpiDown E{(bf16_t*)(ws + WS_Y)};
            pg8::gemm_phase(lds, S, E);
        }
    }
}

__global__ void __launch_bounds__(512, 2) fwd_kernel(Args a) {
    extern __shared__ __attribute__((aligned(16))) unsigned char lds_raw[];
    LAS unsigned char* lds = (LAS unsigned char*)lds_raw;
    const int tid = threadIdx.x; const int G = gridDim.x, c = blockIdx.x;
    volatile LAS unsigned* MISC = (volatile LAS unsigned*)(lds + LDS_MISC_OFF);
    if (tid < 32) MISC[tid] = 0u;
    __syncthreads();
#if !MK_PER_PHASE
    XcdBarrier bar = xcd_barrier_post((unsigned*)(a.ws + WS_BAR), MISC + 8);
#else
    XcdBarrier bar; bar.bar = nullptr; bar.x = 0; bar.st = MISC + 8;
#endif
    const int lo = a.ph_lo, hi = a.ph_hi;
    STAMP(0);
    if (IN(0)) REP(9) { REPBAR(); phase_prep(a, lds, G, c); }
    run_layer<0>(a, lds, G, c, lo, hi, bar);
    run_layer<1>(a, lds, G, c, lo, hi, bar);
    SEAM(NPHASE - 1);
    if (IN(NPHASE - 1)) REP(10) { REPBAR(); norm_phase<3>(a, 1, lds, G, c); }
    if (PROBE_SPIN >= 0) {
        GRID_BAR(); STAMP(NPHASE);
        if (blockIdx.x == 0 && threadIdx.x == 0) { volatile LAS unsigned long long* st = (volatile LAS unsigned long long*)(lds + LDS_MISC_OFF + 256);
            const unsigned long long dur = (st[PROBE_SPIN_END] - st[PROBE_SPIN]) * PROBE_MULT, t0 = __builtin_amdgcn_s_memrealtime();
            while (__builtin_amdgcn_s_memrealtime() - t0 < dur) __builtin_amdgcn_s_sleep(8); }
    }
}

extern "C" void kernel_launch(void* const* d_in, const int* in_sizes, int n_in, void* d_out, int out_size, void* d_ws, size_t ws_size, hipStream_t stream) {
    static int grid = 0;
    if (grid == 0) {
        if (n_in != 25 || out_size != TL * DM || ws_size < WS_END) { fprintf(stderr, "kernel_launch: unexpected shapes (n_in %d out %d ws %zu)\n", n_in, out_size, ws_size); grid = -1; return; }
        int dev = 0, cus = 0, per_cu = 0;
        if (hipGetDevice(&dev) != hipSuccess || hipDeviceGetAttribute(&cus, hipDeviceAttributeMultiprocessorCount, dev) != hipSuccess) { grid = -1; return; }
        if (hipFuncSetAttribute((const void*)fwd_kernel, hipFuncAttributeMaxDynamicSharedMemorySize, LDS_BYTES) != hipSuccess) { fprintf(stderr, "kernel_launch: hipFuncSetAttribute failed\n"); grid = -1; return; }
        if (hipOccupancyMaxActiveBlocksPerMultiprocessor(&per_cu, (const void*)fwd_kernel, 512, LDS_BYTES) != hipSuccess || per_cu < 1) { fprintf(stderr, "kernel_launch: occupancy query says %d blocks per CU\n", per_cu); (void)hipGetLastError(); grid = -1; return; }
        grid = cus;
    }
    if (grid < 0) return;
    (void)hipMemsetAsync((char*)d_ws + WS_BAR, 0, 65536, stream);
    Args a{};
    for (int i = 0; i < 25; ++i) a.in[i] = (const float*)d_in[i];
    a.out = (float*)d_out; a.ws = (unsigned char*)d_ws;
#if MK_PER_PHASE
    for (int ph = 0; ph < NPHASE; ++ph) { a.ph_lo = ph; a.ph_hi = ph + 1; hipLaunchKernelGGL(fwd_kernel, dim3(grid), dim3(512), LDS_BYTES, stream, a); }
#else
    a.ph_lo = 0; a.ph_hi = NPHASE;
    hipLaunchKernelGGL(fwd_kernel, dim3(grid), dim3(512), LDS_BYTES, stream, a);
#endif
}
```

```cpp
#define PULLW 4
#ifndef RELAX
#define RELAX 1
#endif
#include <hip/hip_runtime.h>
#include <hip/hip_cooperative_groups.h>
#include <cstdio>
#include <cstdint>
namespace cg = cooperative_groups;

#ifndef MK_PER_PHASE
#define MK_PER_PHASE 0
#endif

#define LAS __attribute__((address_space(3)))
#define DI __device__ __forceinline__
typedef unsigned short bf16_t;
typedef short bf16x8 __attribute__((ext_vector_type(8)));
typedef short s16x4 __attribute__((ext_vector_type(4)));
typedef float f32x4 __attribute__((ext_vector_type(4)));
typedef float f32x16 __attribute__((ext_vector_type(16)));
typedef unsigned u32x4 __attribute__((ext_vector_type(4)));
typedef unsigned u32x2 __attribute__((ext_vector_type(2)));

constexpr int DM = 1024, NBATCH = 4, SEQ = 4096, CTXL = 256;
constexpr int TL = NBATCH * SEQ, TC = NBATCH * CTXL, TT = TL + TC;
constexpr int INW = 5376;
constexpr int NE = 16, ESLOT = 2304;
constexpr float LOG2E = 1.4426950408889634f;
constexpr float QSC = 0.125f * LOG2E;
constexpr int NPHASE = 20;

constexpr size_t MiB = (size_t)1 << 20;
constexpr size_t WS_BAR = 0;
constexpr size_t WS_MOD = 1 * MiB, WS_ROPE = 1 * MiB + 512 * 1024;
constexpr size_t WS_AFF = 2 * MiB, WS_SLOTOF = 4 * MiB, WS_TOKOF = 6 * MiB;
constexpr size_t WS_WIN = 8 * MiB, WS_WMERGE = 29 * MiB, WS_WOUT = 35 * MiB, WS_WGU = 40 * MiB, WS_WDN = 104 * MiB;
constexpr size_t WS_X = 136 * MiB, WS_H = 204 * MiB;
constexpr size_t WS_Q = 238 * MiB, WS_K = 255 * MiB, WS_VT = 260 * MiB, WS_U = 265 * MiB, WS_Z = 282 * MiB, WS_G = 299 * MiB, WS_BR = 401 * MiB;
constexpr size_t WS_DELTA = 401 * MiB;
constexpr size_t WS_MERGED = 238 * MiB;
constexpr size_t WS_ACT = 238 * MiB, WS_Y = 310 * MiB;
constexpr size_t WS_WGU1 = 452 * MiB, WS_WDN1 = 516 * MiB;
constexpr size_t WS_END = 548 * MiB;
DI size_t ws_wgu(int l) { return l == 0 ? WS_WGU : WS_WGU1; }
DI size_t ws_wdn(int l) { return l == 0 ? WS_WDN : WS_WDN1; }

constexpr int LDS_BYTES = 147456;
constexpr int RING_BYTES = 131072;
constexpr int LDS_IDX_OFF = RING_BYTES;
constexpr int LDS_MISC_OFF = RING_BYTES + 8192;

struct Args { const float* in[25]; float* out; unsigned char* ws; int ph_lo, ph_hi; };
enum { I_X = 0, I_C, I_CTX, I_CCTX, I_N1G, I_N2G, I_WMOD, I_BMOD, I_WIN, I_SINK, I_WAO, I_CDW, I_CDWB, I_CLNG, I_CLNB, I_WCO, I_WPOOL, I_PSCALE, I_WPO, I_WOUT, I_WR, I_WEG, I_WEU, I_WED, I_FNG };

DI unsigned pk_bf16(float lo, float hi) {
    typedef float f2 __attribute__((ext_vector_type(2))); typedef __bf16 b2 __attribute__((ext_vector_type(2)));
    f2 v = {lo, hi}; b2 b = __builtin_convertvector(v, b2); return __builtin_bit_cast(unsigned, b);
}
DI bf16_t f2bf(float f) { return (bf16_t)(pk_bf16(f, 0.f) & 0xffffu); }
DI float bf_lo(unsigned u) { return __uint_as_float(u << 16); }
DI float bf_hi(unsigned u) { return __uint_as_float(u & 0xffff0000u); }
DI float bf2f(bf16_t b) { return __uint_as_float(((unsigned)b) << 16); }
DI float sigm2(float y) { return __builtin_amdgcn_rcpf(1.f + __builtin_amdgcn_exp2f(y)); }
DI float sigm(float x) { return __builtin_amdgcn_rcpf(1.f + __builtin_amdgcn_exp2f(x * -LOG2E)); }
template <int N> DI float lane_xor(float x) {
    const int xi = __float_as_int(x);
    if constexpr (N == 1) return __int_as_float(__builtin_amdgcn_update_dpp(xi, xi, 0xB1, 0xF, 0xF, false));
    else if constexpr (N == 2) return __int_as_float(__builtin_amdgcn_update_dpp(xi, xi, 0x4E, 0xF, 0xF, false));
    else if constexpr (N == 4) { int r = __builtin_amdgcn_update_dpp(xi, xi, 0x104, 0xF, 0x5, false);
        r = __builtin_amdgcn_update_dpp(r, xi, 0x114, 0xF, 0xA, false); return __int_as_float(r); }
    else if constexpr (N == 8) return __int_as_float(__builtin_amdgcn_update_dpp(xi, xi, 0x128, 0xF, 0xF, false));
    else static_assert(N == 1 || N == 2 || N == 4 || N == 8, "across 16-lane rows use pair_sum16 / pair_sum32");
}
DI float pair_sum16(float x) { const auto r = __builtin_amdgcn_permlane16_swap(__float_as_uint(x), __float_as_uint(x), false, false); return __uint_as_float(r[0]) + __uint_as_float(r[1]); }
DI float pair_sum32(float x) { const auto r = __builtin_amdgcn_permlane32_swap(__float_as_uint(x), __float_as_uint(x), false, false); return __uint_as_float(r[0]) + __uint_as_float(r[1]); }
DI float wave_sum(float v) {
    v += lane_xor<1>(v); v += lane_xor<2>(v); v += lane_xor<4>(v); v += lane_xor<8>(v);
    return pair_sum32(pair_sum16(v));
}
DI float max3f(float a, float b, float c) { float r; asm("v_max3_f32 %0, %1, %2, %3" : "=v"(r) : "v"(a), "v"(b), "v"(c)); return r; }
DI int crow(int r, int hi) { return (r & 3) + 8 * (r >> 2) + 4 * hi; }
#define LDS_WAIT() asm volatile("s_waitcnt lgkmcnt(0)" ::: "memory")

namespace pg8 {
constexpr int BM = 256, BK = 64, HALF = 128, HTB = HALF * BK * 2;
DI int lds_byte(int r, int c) { const int st = (r >> 4) * 2 + (c >> 5), rr = r & 15, cc = c & 31, ob = rr * 64 + cc * 2; return st * 1024 + (ob ^ (((ob >> 9) & 1) << 5)); }
DI void stage_rc(int b, int& R, int& C) { const int st = b / 1024, sb = b % 1024, swz = sb ^ (((sb >> 9) & 1) << 5); R = (st >> 1) * 16 + swz / 64; C = (st & 1) * 32 + (swz % 64) / 2; }

#ifndef SADDR_GLDS
#define SADDR_GLDS 1
#endif
DI const char* pg8_uni(const char* p) { const unsigned long long v = (unsigned long long)p; const unsigned lo = (unsigned)__builtin_amdgcn_readfirstlane((int)(unsigned)v), hi = (unsigned)__builtin_amdgcn_readfirstlane((int)(unsigned)(v >> 32)); return (const char*)(((unsigned long long)hi << 32) | lo); }
struct Unit { const char* a; const char* b; int i0, i1, i2, ui; int half; };

DI void tile_order(int L, int nM, int nN, int& pm, int& pn) {
    const int nwg = nM * nN; int wgid = L;
    { const int q = nwg / 8, r = nwg % 8, xcd = wgid % 8, off = wgid / 8; wgid = (xcd < r ? xcd * (q + 1) : r * (q + 1) + (xcd - r) * q) + off; }
    const int nig = 8 * nN, gid = wgid / nig, fm = gid * 8, gsz = (nM - fm) < 8 ? (nM - fm) : 8;
    pm = fm + ((wgid % nig) % gsz); pn = (wgid % nig) / gsz;
}

template <class Epi, class Sched>
DI void gemm_phase(LAS unsigned char* lds, const Sched& S, const Epi& E) {
    const int tid = threadIdx.x, wid = __builtin_amdgcn_readfirstlane(tid >> 6), lane = tid & 63, wr = wid >> 2, wc = wid & 3, fr = lane & 15, fq = lane >> 4;
    const int nt = S.nt;
    int R0, C0, R1, C1; stage_rc(tid * 16, R0, C0); stage_rc(tid * 16 + 8192, R1, C1);
    unsigned voffB[2][2];
#pragma unroll
    for (int h = 0; h < 2; ++h) { voffB[h][0] = (unsigned)(S.brow(h * HALF + R0) * S.ldb_b + C0 * 2); voffB[h][1] = (unsigned)(S.brow(h * HALF + R1) * S.ldb_b + C1 * 2); }
    const size_t kstep = (size_t)(BK * 2);
    const unsigned ldsw = (unsigned)wid * 1024u;
    const unsigned ldsb = (unsigned)__builtin_amdgcn_readfirstlane((int)((unsigned)(unsigned long long)(lds) + ldsw));
    const int aoff = lds_byte(wr * 64 + fr, fq * 8), boff = lds_byte(wc * 32 + fr, fq * 8);
#define PG8_SA(b, h) (((b) * 2 + (h)) * HTB)
#define PG8_SB(b, h) ((4 + (b) * 2 + (h)) * HTB)
#if SADDR_GLDS
#define PG8_STAGE(bufoff, gbase, voff) do { const char* _gb = pg8_uni((const char*)(gbase)); _Pragma("unroll") for (int _i = 0; _i < 2; ++_i) \
        asm volatile("s_mov_b32 m0, %2\n\ts_nop 0\n\tglobal_load_lds_dwordx4 %1, %0" :: "s"(_gb), "v"((voff)[_i]), "s"(ldsb + (unsigned)((bufoff) + _i * 8192)) : "memory"); } while (0)
#else
#define PG8_STAGE(bufoff, gbase, voff) do { _Pragma("unroll") for (int _i = 0; _i < 2; ++_i) \
        __builtin_amdgcn_global_load_lds((const unsigned*)((const char*)(gbase) + (voff)[_i]), (LAS unsigned*)(lds + (bufoff) + ldsw + _i * 8192), 16, 0, 0); } while (0)
#endif
#define PG8_LDA(dst, b, h) do { _Pragma("unroll") for (int m = 0; m < 4; ++m) _Pragma("unroll") for (int k = 0; k < 2; ++k) dst[m][k] = *(const LAS bf16x8*)(lds + PG8_SA(b, h) + aoff + m * 2048 + k * 1024); } while (0)
#define PG8_LDB(dst, b, h) do { _Pragma("unroll") for (int n = 0; n < 2; ++n) _Pragma("unroll") for (int k = 0; k < 2; ++k) dst[n][k] = *(const LAS bf16x8*)(lds + PG8_SB(b, h) + boff + n * 2048 + k * 1024); } while (0)
#ifndef PRIO_MODE
#define PRIO_MODE 0
#endif
#define PG8_MMA(ai, bj, At, Bt) do { if (PRIO_MODE == 0) __builtin_amdgcn_s_setprio(1); _Pragma("unroll") for (int m = 0; m < 4; ++m) _Pragma("unroll") for (int n = 0; n < 2; ++n) _Pragma("unroll") for (int k = 0; k < 2; ++k) \
        acc[ai][bj][m][n] = __builtin_amdgcn_mfma_f32_16x16x32_bf16(Bt[n][k], At[m][k], acc[ai][bj][m][n], 0, 0, 0); if (PRIO_MODE == 0) __builtin_amdgcn_s_setprio(0); } while (0)
#define PG8_WAIT_V(n) asm volatile("s_waitcnt vmcnt(" #n ")" ::: "memory")
#define PG8_WAIT_L(n) asm volatile("s_waitcnt lgkmcnt(" #n ")" ::: "memory")
#define PG8_WAIT_VR_(rel, N) asm volatile("s_waitcnt vmcnt(" #N ")\n\ts_cmp_lg_u32 %0, 0\n\ts_cbranch_scc1 .Lpg8r%=\n\ts_waitcnt vmcnt(8)\n.Lpg8r%=:" :: "s"(rel) : "memory", "scc")
#define PG8_WAIT_VR(rel) do { if constexpr (Epi::NST >= 16) PG8_WAIT_VR_(rel, 24); else if constexpr (Epi::NST >= 8) PG8_WAIT_VR_(rel, 16); else PG8_WAIT_VR_(rel, 12); } while (0)
#define PG8_BAR __builtin_amdgcn_s_barrier()
#define PG8_SCHED __builtin_amdgcn_sched_barrier(0)
    Unit cur, nxt; int ui = 0;
    if (!S.next(0, cur)) return;
    if (PRIO_MODE == 2 && wr == 1) __builtin_amdgcn_s_setprio(1);
#ifndef PG8_STAGGER
#define PG8_STAGGER 0
#endif
    if (PG8_STAGGER > 0 && S.next(1, nxt)) { const int g = (blockIdx.x >> 3) & 3; for (int i = 0; i < g; ++i) __builtin_amdgcn_s_sleep(PG8_STAGGER); }
    f32x4 acc[2][2][4][2];
#pragma unroll
    for (int a = 0; a < 2; ++a)
#pragma unroll
        for (int b = 0; b < 2; ++b)
#pragma unroll
            for (int m = 0; m < 4; ++m)
#pragma unroll
                for (int n = 0; n < 2; ++n) acc[a][b][m][n] = (f32x4){0.f, 0.f, 0.f, 0.f};
    bf16x8 At[4][2], B0[2][2], B1[2][2];
    unsigned cvA[2][2], nvA[2][2];
    S.voff(cur, R0, C0, R1, C1, cvA);
    const char* cA = cur.a; const char* cB = cur.b;
    PG8_STAGE(PG8_SB(0, 0), cB, voffB[0]); PG8_STAGE(PG8_SB(0, 1), cB, voffB[1]); PG8_STAGE(PG8_SA(0, 0), cA, cvA[0]); PG8_STAGE(PG8_SA(0, 1), cA, cvA[1]);
    if (wr == 1) PG8_BAR;
    PG8_WAIT_V(2); PG8_BAR;
    PG8_STAGE(PG8_SB(1, 0), cB + kstep, voffB[0]); PG8_STAGE(PG8_SA(1, 0), cA + kstep, cvA[0]); PG8_STAGE(PG8_SB(1, 1), cB + kstep, voffB[1]);
    PG8_WAIT_V(6); PG8_BAR;
    for (;;) {
        const bool has_next = S.next(ui + 1, nxt);
        const char* nA = has_next ? nxt.a : cA; const char* nB = has_next ? nxt.b : cB;
        if (has_next) S.voff(nxt, R0, C0, R1, C1, nvA);
        else {
#pragma unroll
            for (int h = 0; h < 2; ++h) { nvA[h][0] = cvA[h][0]; nvA[h][1] = cvA[h][1]; }
        }
        const bool hf = cur.half != 0;
#ifdef PROBE_KLOOP
        unsigned long long pk_t0 = 0; if (blockIdx.x == 0 && tid == 0) pk_t0 = __builtin_amdgcn_s_memrealtime();
#endif
        for (int t = 0; t < nt; t += 2) {
            if constexpr (Epi::HOOK) { if (t == 8 || t == 16) E.hook(acc, cur, t >> 4, wr, wc, fr, fq); }
            const bool last = (t == nt - 2); const int first = __builtin_amdgcn_readfirstlane((RELAX && t == 0 && ui > 0) ? 1 : 0);
            const char* a1 = cA + (size_t)(t + 1) * kstep;
            const char* a2 = last ? nA : cA + (size_t)(t + 2) * kstep; const char* b2 = last ? nB : cB + (size_t)(t + 2) * kstep;
            const char* a3 = a2 + kstep; const char* b3 = b2 + kstep;
            unsigned v2[2][2];
#pragma unroll
            for (int h = 0; h < 2; ++h) { v2[h][0] = last ? nvA[h][0] : cvA[h][0]; v2[h][1] = last ? nvA[h][1] : cvA[h][1]; }
            PG8_LDB(B0, 0, 0); PG8_LDB(B1, 0, 1); PG8_SCHED; PG8_LDA(At, 0, 0); PG8_STAGE(PG8_SA(1, 1), a1, cvA[1]);
            PG8_WAIT_VR(first); PG8_WAIT_L(0); PG8_BAR; PG8_MMA(0, 0, At, B0); PG8_MMA(0, 1, At, B1); PG8_BAR; PG8_SCHED;
            PG8_LDA(At, 0, 1); PG8_STAGE(PG8_SB(0, 0), b2, voffB[0]); PG8_STAGE(PG8_SB(0, 1), b2, voffB[1]); PG8_STAGE(PG8_SA(0, 0), a2, v2[0]);
            PG8_WAIT_VR(first); PG8_WAIT_L(0); PG8_BAR; if (!hf) { PG8_MMA(1, 0, At, B0); PG8_MMA(1, 1, At, B1); } PG8_BAR; PG8_SCHED;
            PG8_LDB(B0, 1, 0); PG8_LDB(B1, 1, 1); PG8_SCHED; PG8_LDA(At, 1, 0); PG8_STAGE(PG8_SA(0, 1), a2, v2[1]);
            PG8_WAIT_V(8); PG8_WAIT_L(0); PG8_BAR; PG8_MMA(0, 0, At, B0); PG8_MMA(0, 1, At, B1); PG8_BAR; PG8_SCHED;
            PG8_LDA(At, 1, 1); PG8_STAGE(PG8_SB(1, 0), b3, voffB[0]); PG8_STAGE(PG8_SB(1, 1), b3, voffB[1]); PG8_STAGE(PG8_SA(1, 0), a3, v2[0]);
            PG8_WAIT_V(8); PG8_WAIT_L(0); PG8_BAR; if (!hf) { PG8_MMA(1, 0, At, B0); PG8_MMA(1, 1, At, B1); } PG8_BAR; PG8_SCHED;
        }
#ifdef PROBE_KLOOP
        if (blockIdx.x == 0 && tid == 0) ((volatile LAS unsigned long long*)(lds + LDS_MISC_OFF + 256))[40] += __builtin_amdgcn_s_memrealtime() - pk_t0;
#endif
        if (wr == 0) PG8_BAR;
        { int efr = fr, efq = fq; asm volatile("" : "+v"(efr), "+v"(efq));
          E(acc, cur, wr, wc, efr, efq); }
        if (!has_next) break;
#pragma unroll
        for (int a = 0; a < 2; ++a)
#pragma unroll
            for (int b = 0; b < 2; ++b)
#pragma unroll
                for (int m = 0; m < 4; ++m)
#pragma unroll
                    for (int n = 0; n < 2; ++n) acc[a][b][m][n] = (f32x4){0.f, 0.f, 0.f, 0.f};
        cur = nxt; cA = nA; cB = nB; ++ui;
#pragma unroll
        for (int h = 0; h < 2; ++h) { cvA[h][0] = nvA[h][0]; cvA[h][1] = nvA[h][1]; }
        if (wr == 1) PG8_BAR;
    }
    PG8_WAIT_V(0);
    if (PRIO_MODE == 2) __builtin_amdgcn_s_setprio(0);
    PG8_BAR;
#undef PG8_SA
#undef PG8_SB
#undef PG8_STAGE
#undef PG8_LDA
#undef PG8_LDB
#undef PG8_MMA
#undef PG8_WAIT_V
#undef PG8_WAIT_L
#undef PG8_WAIT_VR
#undef PG8_WAIT_VR_
#undef PG8_BAR
#undef PG8_SCHED
}
}
using pg8::Unit;
typedef f32x4 Acc[2][2][4][2];

struct SchedBase {
    int nt, ldb_b, lda_b, G, c;
    DI int brow(int r) const { return r; }
    DI void voff_contig(int R0, int C0, int R1, int C1, unsigned (&vo)[2][2]) const {
#pragma unroll
        for (int h = 0; h < 2; ++h) { vo[h][0] = (unsigned)((h * 128 + R0) * lda_b + C0 * 2); vo[h][1] = (unsigned)((h * 128 + R1) * lda_b + C1 * 2); }
    }
};
struct SchedInProj : SchedBase {
    const char* A; const char* B; int nM, n1, n1p, ntot, lo, hi;
    DI void init_counts(int nM_, int extra) { nM = nM_; n1 = nM * 9 + extra; n1p = (n1 + 7) & ~7; ntot = n1p + nM * 12; }
    DI bool next(int i, Unit& u) const {
        const int L = lo + i * G + c; if (L >= hi) return false; int pm, pn;
        if (L < n1p) { const int L1 = L < n1 ? L : L - n1; if (L1 < nM * 9) pg8::tile_order(L1, nM, 9, pm, pn); else { pm = 64 + (L1 - nM * 9); pn = 2; } }
        else { pg8::tile_order(L - n1p, nM, 12, pm, pn); pn += 9; }
        u.a = A + (size_t)pm * 256 * 2048; u.b = B + (size_t)pn * 256 * 2048; u.i0 = pm; u.i1 = pn; u.i2 = 0; u.ui = i; u.half = 0; return true;
    }
    DI void voff(const Unit&, int R0, int C0, int R1, int C1, unsigned (&vo)[2][2]) const { voff_contig(R0, C0, R1, C1, vo); }
};
struct SchedMerge : SchedBase {
    const char* A; const char* B; int nM;
    DI bool next(int i, Unit& u) const {
        const int L = i * G + c; int pm, pn;
        if (nM == 68 && G == 256) {
            if (L >= 288) return false;
            if (L >= 256) { const int x = L - 256, h = x & 1; pm = 64 + ((x & 7) >> 1); pn = x >> 3;
                u.a = A + ((size_t)pm * 256 + h * 128) * 3072; u.b = B + (size_t)pn * 256 * 3072; u.i0 = pm; u.i1 = pn; u.i2 = h; u.ui = i; u.half = 1; return true; }
            pg8::tile_order(L, 64, 4, pm, pn);
        } else { if (L >= nM * 4) return false; pg8::tile_order(L, nM, 4, pm, pn); }
        u.a = A + (size_t)pm * 256 * 3072; u.b = B + (size_t)pn * 256 * 3072; u.i0 = pm; u.i1 = pn; u.i2 = 0; u.ui = i; u.half = 0; return true;
    }
    DI void voff(const Unit&, int R0, int C0, int R1, int C1, unsigned (&vo)[2][2]) const { voff_contig(R0, C0, R1, C1, vo); }
};
struct SchedOut : SchedBase {
    const char* A; const char* B; int nM, mode, c0;
    DI bool next(int i, Unit& u) const {
        int pm, pn;
        if (mode == 2) { if (i > 0 || c0 < 0 || c0 >= 16) return false; pm = 64 + (c0 >> 2); pn = c0 & 3; }
        else { const int nm = mode == 1 ? 64 : nM; const int L = i * G + c; if (L >= nm * 4) return false; pg8::tile_order(L, nm, 4, pm, pn); }
        u.a = A + (size_t)pm * 256 * 2048; u.b = B + (size_t)pn * 256 * 2048; u.i0 = pm; u.i1 = pn; u.i2 = 0; u.ui = i; u.half = 0; return true;
    }
    DI void voff(const Unit&, int R0, int C0, int R1, int C1, unsigned (&vo)[2][2]) const { voff_contig(R0, C0, R1, C1, vo); }
};
DI void gu_decode(int L, int& e, int& mt, int& n8) {
    if (L < NE * 64) { const int i = L >> 8, x = L & 7, j = (L >> 3) & 31; e = 4 * i + (x >> 1); mt = 4 * (x & 1) + (j >> 3); n8 = j & 7; }
    else { const int y = L - NE * 64, x = y & 7, j = y >> 3; e = 2 * x + (j >> 3); n8 = j & 7; mt = 8; } }
DI void dn_decode(int L, int& e, int& mt, int& n4) {
    if (L < NE * 32) { const int i = L >> 8, x = L & 7, j = (L >> 3) & 31; e = 8 * i + x; mt = j >> 2; n4 = j & 3; }
    else { const int y = L - NE * 32, x = y & 7, j = y >> 3; e = 2 * x + (j >> 2); n4 = j & 3; mt = 8; } }
struct SchedGU : SchedBase {
    const char* A; const char* B; int lo, hi, c0, ibase; const LAS int* idx;
    DI int brow(int r) const { const int bj = r >> 7, wc = (r >> 5) & 3; return 128 * (wc >> 1) + 32 * (bj + 2 * (wc & 1)) + (r & 31); }
    DI int unit(int i) const { return lo + (ibase + i) * G + c0; }
    DI bool next(int i, Unit& u) const {
        if (i >= 8 || c0 < 0) return false;
        const int L = unit(i); if (L >= hi) return false;
        int e, mt, n8; gu_decode(L, e, mt, n8);
        u.a = A; u.b = B + ((size_t)e * 2048 + n8 * 256) * 2048; u.i0 = e; u.i1 = mt; u.i2 = n8; u.ui = i; u.half = mt == 8; return true;
    }
    DI void voff(const Unit& u, int R0, int C0, int R1, int C1, unsigned (&vo)[2][2]) const {
#pragma unroll
        for (int h = 0; h < 2; ++h) { vo[h][0] = (unsigned)(idx[u.ui * 256 + h * 128 + R0] * 2048 + C0 * 2); vo[h][1] = (unsigned)(idx[u.ui * 256 + h * 128 + R1] * 2048 + C1 * 2); }
    }
};
struct SchedDown : SchedBase {
    const char* A; const char* B; int lo, hi, c0;
    DI bool next(int i, Unit& u) const {
        if (c0 < 0) return false;
        const int L = lo + i * G + c0; if (L >= hi) return false;
        int e, mt, n4; dn_decode(L, e, mt, n4);
        u.a = A + ((size_t)e * ESLOT + mt * 256) * 2048; u.b = B + ((size_t)e * 1024 + n4 * 256) * 2048; u.i0 = e; u.i1 = mt; u.i2 = n4; u.ui = i; u.half = mt == 8; return true;
    }
    DI void voff(const Unit&, int R0, int C0, int R1, int C1, unsigned (&vo)[2][2]) const { voff_contig(R0, C0, R1, C1, vo); }
};

DI void st16_wt(void* p, u32x4 v) { asm volatile("global_store_dwordx4 %0, %1, off sc1\n\ts_nop 1" :: "v"(p), "v"(v) : "memory"); }
DI void st_bf4(bf16_t* p, f32x4 v) { u32x2 w; w.x = pk_bf16(v[0], v[1]); w.y = pk_bf16(v[2], v[3]); *(u32x2*)p = w; }
DI float gatef(float y) { return fminf(1.f + __builtin_amdgcn_exp2f(y), 1e18f); }
DI f32x4 gate4(f32x4 v) { return (f32x4){gatef(v[0]), gatef(v[1]), gatef(v[2]), gatef(v[3])}; }
DI void st_pair(bf16_t* p0, f32x4 v0, bf16_t* p1, f32x4 v1, int fq) {
    const unsigned a0 = pk_bf16(v0[0], v0[1]), a1 = pk_bf16(v0[2], v0[3]), b0 = pk_bf16(v1[0], v1[1]), b1 = pk_bf16(v1[2], v1[3]);
    const auto r0 = __builtin_amdgcn_permlane16_swap(a0, b0, false, false), r1 = __builtin_amdgcn_permlane16_swap(a1, b1, false, false);
    *(u32x4*)((fq & 1) ? p1 - 4 : p0) = (u32x4){r0[0], r1[0], r0[1], r1[1]};
}
DI f32x4 sig4(f32x4 v) { return (f32x4){sigm2(v[0]), sigm2(v[1]), sigm2(v[2]), sigm2(v[3])}; }

struct EpiInProj {
    static constexpr bool HOOK = false;
    bf16_t *Q, *K, *VT, *U, *Z, *G; const float* rope;
    static constexpr int NST = 8;
    DI void operator()(const Acc& acc, const Unit& u, int wr, int wc, int fr, int fq) const {
        const int pm = u.i0, pn = u.i1;
#pragma unroll
        for (int bj = 0; bj < 2; ++bj) {
            const int gc = 256 * pn + 128 * bj + 32 * wc;
#pragma unroll
            for (int ai = 0; ai < 2; ++ai)
#pragma unroll
                for (int m = 0; m < 4; ++m) {
                    const int t = 256 * pm + 128 * ai + 64 * wr + 16 * m + fr;
                    const f32x4 v0 = acc[ai][bj][m][0], v1 = acc[ai][bj][m][1];
                    if (gc < 640) {
                        f32x4 o0 = v0, o1 = v1;
                        if (t < TL) {
                            const int s = t & (SEQ - 1); const int p = ((gc >> 5) & 1) ? (s & 63) : (s >> 6);
                            const f32x4 cs = *(const f32x4*)(rope + p * 16 + 4 * fq), sn = *(const f32x4*)(rope + 1024 + p * 16 + 4 * fq);
                            o0 = v0 * cs - v1 * sn; o1 = v1 * cs + v0 * sn;
                        }
                        bf16_t* dst;
                        if (gc < 512) { o0 = o0 * QSC; o1 = o1 * QSC; dst = Q + (size_t)t * 512 + gc + 4 * fq; } else dst = K + (size_t)t * 128 + (gc - 512) + 4 * fq;
                        st_pair(dst, o0, dst + 16, o1, fq);
                    } else if (gc < 768) {
                        const int c0 = gc - 640 + 4 * fq;
#pragma unroll
                        for (int j = 0; j < 4; ++j) { VT[(size_t)(c0 + j) * TT + t] = f2bf(v0[j]); VT[(size_t)(c0 + 16 + j) * TT + t] = f2bf(v1[j]); }
                    } else if (gc < 1792) {
                        if (bj == 0) {
                            const int ch = ((gc - 768) >> 1) + 4 * fq;
                            st_pair(U + (size_t)t * 512 + ch, v0 * sig4(v1), U + (size_t)t * 512 + ch + 64, acc[ai][1][m][0] * sig4(acc[ai][1][m][1]), fq); }
                    } else if (gc < 2304) {
                        bf16_t* dst = Z + (size_t)t * 512 + (gc - 1792) + 4 * fq; st_pair(dst, v0, dst + 16, v1, fq);
                    } else {
                        const int gt = pn - 9; const size_t gb = ((((size_t)(pm * 3 + (gt >> 2)) * 4 + (gt & 3)) * 8 + (wr * 4 + wc)) * 16 + ((ai * 4 + m) * 2 + bj)) * 64 + (fq * 16 + fr);
                        const f32x4 g0 = gate4(v0), g1 = gate4(v1); u32x4 gw; gw.x = pk_bf16(g0[0], g0[1]); gw.y = pk_bf16(g0[2], g0[3]); gw.z = pk_bf16(g1[0], g1[1]); gw.w = pk_bf16(g1[2], g1[3]);
                        st16_wt(G + gb * 8, gw);
                    }
                }
        }
    }
};
struct EpiMerge {
    static constexpr bool HOOK = true;
    const bf16_t* G; bf16_t* M;
    static constexpr int NST = 16;
    DI static f32x4 lo4(u32x4 w) { return (f32x4){bf_lo(w.x), bf_hi(w.x), bf_lo(w.y), bf_hi(w.y)}; }
    DI static f32x4 hi4(u32x4 w) { return (f32x4){bf_lo(w.z), bf_hi(w.z), bf_lo(w.w), bf_hi(w.w)}; }
    DI static f32x4 rcp4(f32x4 v) { return (f32x4){__builtin_amdgcn_rcpf(v[0]), __builtin_amdgcn_rcpf(v[1]), __builtin_amdgcn_rcpf(v[2]), __builtin_amdgcn_rcpf(v[3])}; }
    DI void hook(Acc& acc, const Unit& u, int which, int wr, int wc, int fr, int fq) const {
        int lofs = fq * 16 + fr; asm volatile("" : "+v"(lofs));
        const u32x4* pa = (const u32x4*)G + ((((size_t)(u.i0 * 3 + which) * 4 + u.i1) * 8 + (wr * 4 + wc)) * 16 + u.i2 * 8) * 64 + lofs;
        const u32x4* pb = pa + (size_t)4 * 8 * 16 * 64;
        u32x4 ba[2][2][2], bb[2][2][2];
#pragma unroll
        for (int g = 0; g < 2; ++g)
#pragma unroll
            for (int q = 0; q < 2; ++q) { ba[0][g][q] = pa[(g * 2 + q) * 64]; bb[0][g][q] = pb[(g * 2 + q) * 64]; }
#pragma unroll
        for (int k = 0; k < 4; ++k) {
            asm volatile("" ::: "memory");
            if (k < 3) {
#pragma unroll
                for (int g = 0; g < 2; ++g)
#pragma unroll
                    for (int q = 0; q < 2; ++q) { ba[(k + 1) & 1][g][q] = pa[((2 * (k + 1) + g) * 2 + q) * 64]; bb[(k + 1) & 1][g][q] = pb[((2 * (k + 1) + g) * 2 + q) * 64]; } }
#pragma unroll
            for (int g = 0; g < 2; ++g)
#pragma unroll
                for (int q = 0; q < 2; ++q) {
                    const int h = k >> 1, m = 2 * (k & 1) + g;
                    acc[h][q][m][0] = acc[h][q][m][0] * (lo4(bb[k & 1][g][q]) * rcp4(lo4(ba[k & 1][g][q])));
                    acc[h][q][m][1] = acc[h][q][m][1] * (hi4(bb[k & 1][g][q]) * rcp4(hi4(ba[k & 1][g][q]))); }
        }
    }
    DI void operator()(const Acc& acc, const Unit& u, int wr, int wc, int fr, int fq) const {
        const int pm = u.i0, pn = u.i1;
        const int ap = u.i2;
        const u32x4* pc = (const u32x4*)G + ((((size_t)(pm * 3 + 2) * 4 + pn) * 8 + (wr * 4 + wc)) * 16 + ap * 8) * 64 + (fq * 16 + fr);
#pragma unroll
        for (int ai = 0; ai < 2; ++ai) if (ai == 0 || !u.half)
#pragma unroll
            for (int m = 0; m < 4; ++m) {
                const int t = 256 * pm + 128 * (ai + ap) + 64 * wr + 16 * m + fr;
#pragma unroll
                for (int bj = 0; bj < 2; ++bj) {
                    const u32x4 gw = pc[((ai * 4 + m) * 2 + bj) * 64];
                    const int cc = 256 * pn + 128 * bj + 32 * wc + 4 * fq;
                    st_pair(M + (size_t)t * 1024 + cc, acc[ai][bj][m][0] * rcp4(lo4(gw)), M + (size_t)t * 1024 + cc + 16, acc[ai][bj][m][1] * rcp4(hi4(gw)), fq);
                }
            }
    }
};
struct EpiOut {
    static constexpr bool HOOK = false;
    bf16_t* D; const float* mod; int layer;
    static constexpr int NST = 16;
    DI void operator()(const Acc& acc, const Unit& u, int wr, int wc, int fr, int fq) const {
        const int pm = u.i0, pn = u.i1; const int row0 = 256 * pm;
        const int mr = row0 < TL ? (row0 >> 12) : 4;
        const float* g1 = mod + (size_t)(layer * 5 + mr) * 6144 + 2048;
#pragma unroll
        for (int bj = 0; bj < 2; ++bj) {
            const int cc = 256 * pn + 128 * bj + 32 * wc + 4 * fq;
            const f32x4 g0 = *(const f32x4*)(g1 + cc), gv1 = *(const f32x4*)(g1 + cc + 16);
#pragma unroll
            for (int ai = 0; ai < 2; ++ai)
#pragma unroll
                for (int m = 0; m < 4; ++m) {
                    const int t = row0 + 128 * ai + 64 * wr + 16 * m + fr;
                    st_pair(D + (size_t)t * DM + cc, g0 * acc[ai][bj][m][0], D + (size_t)t * DM + cc + 16, gv1 * acc[ai][bj][m][1], fq);
                }
        }
    }
};
struct EpiGU {
    static constexpr bool HOOK = false;
    bf16_t* ACT;
    static constexpr int NST = 4;
    DI void operator()(const Acc& acc, const Unit& u, int wr, int wc, int fr, int fq) const {
        const int e = u.i0, mt = u.i1, n8 = u.i2;
#pragma unroll
        for (int ai = 0; ai < 2; ++ai) if (ai == 0 || !u.half)
#pragma unroll
            for (int m = 0; m < 4; ++m) {
                const size_t slot = (size_t)e * ESLOT + mt * 256 + 128 * ai + 64 * wr + 16 * m + fr;
                const int col = 128 * n8 + 32 * wc + 4 * fq;
                const f32x4 g0 = acc[ai][0][m][0], u0 = acc[ai][0][m][1], g1 = acc[ai][1][m][0], u1 = acc[ai][1][m][1];
                st_pair(ACT + slot * 1024 + col, g0 * sig4(g0) * u0, ACT + slot * 1024 + col + 16, g1 * sig4(g1) * u1, fq);
            }
    }
};
struct EpiDown {
    static constexpr bool HOOK = false;
    bf16_t* Y;
    static constexpr int NST = 8;
    DI void operator()(const Acc& acc, const Unit& u, int wr, int wc, int fr, int fq) const {
        const int e = u.i0, mt = u.i1, n4 = u.i2;
#pragma unroll
        for (int ai = 0; ai < 2; ++ai) if (ai == 0 || !u.half)
#pragma unroll
            for (int m = 0; m < 4; ++m) {
                const size_t slot = (size_t)e * ESLOT + mt * 256 + 128 * ai + 64 * wr + 16 * m + fr;
#pragma unroll
                for (int bj = 0; bj < 2; ++bj) { bf16_t* yp = Y + slot * 1024 + 256 * n4 + 128 * bj + 32 * wc + 4 * fq; st_pair(yp, acc[ai][bj][m][0], yp + 16, acc[ai][bj][m][1], fq); }
            }
    }
};

DI int maprow(int mode, int n) {
    if (mode == 1) {
        if (n >= 768 && n < 1280) { const int ch = n - 768; return 768 + 32 * (ch >> 4) + (ch & 15); }
        if (n >= 1280 && n < 1792) { const int ch = n - 1280; return 768 + 32 * (ch >> 4) + 16 + (ch & 15); }
        return n;
    }
    if (mode == 2) return 32 * (n >> 4) + (n & 15);
    if (mode == 3) return 32 * (n >> 4) + 16 + (n & 15);
    return n;
}
struct ConvTile { const float* W; bf16_t* WT; int N, dpitch, dcol0, mode, kb, nb; float scale; };
DI void tile_load(const ConvTile& t, int lane, f32x4 (&x)[8]) {
    const float* p = t.W + (size_t)(64 * t.kb + 8 * (lane & 7)) * t.N + 32 * t.nb + 4 * (lane >> 3);
#pragma unroll
    for (int r = 0; r < 8; ++r) x[r] = __builtin_nontemporal_load((const f32x4*)(p + (size_t)r * t.N));
}
DI void tile_store(const ConvTile& t, int lane, const f32x4 (&x)[8]) {
    const int n = 32 * t.nb + 4 * (lane >> 3);
#pragma unroll
    for (int i = 0; i < 4; ++i) { const float sc = t.scale; u32x4 o; o.x = pk_bf16(x[0][i] * sc, x[1][i] * sc); o.y = pk_bf16(x[2][i] * sc, x[3][i] * sc); o.z = pk_bf16(x[4][i] * sc, x[5][i] * sc); o.w = pk_bf16(x[6][i] * sc, x[7][i] * sc);
        st16_wt(t.WT + (size_t)maprow(t.mode, n + i) * t.dpitch + t.dcol0 + 64 * t.kb + 8 * (lane & 7), o); }
}
DI ConvTile small_tile(const Args& a, int it) {
    unsigned char* ws = a.ws; ConvTile t;
    constexpr int I_A = 16 * 168, I_B = 8 * 32, I_C = 8 * 32, I_D = 16 * 32, PER = I_A + I_B + I_C + I_D;
    const int l = it / PER; int r = it % PER;
    if (r < I_A) { t.W = a.in[I_WIN] + (size_t)l * 1024 * INW; t.N = INW; t.WT = (bf16_t*)(ws + WS_WIN) + (size_t)l * INW * 1024; t.dpitch = 1024; t.dcol0 = 0; t.mode = 1; }
    else if ((r -= I_A) < I_B) { t.W = a.in[I_WAO] + (size_t)l * 512 * 1024; t.N = 1024; t.WT = (bf16_t*)(ws + WS_WMERGE) + (size_t)l * 1024 * 1536; t.dpitch = 1536; t.dcol0 = 0; t.mode = 0; }
    else if ((r -= I_B) < I_C) { t.W = a.in[I_WCO] + (size_t)l * 512 * 1024; t.N = 1024; t.WT = (bf16_t*)(ws + WS_WMERGE) + (size_t)l * 1024 * 1536; t.dpitch = 1536; t.dcol0 = 512; t.mode = 0; }
    else { r -= I_C; t.W = a.in[I_WOUT] + (size_t)l * 1024 * 1024; t.N = 1024; t.WT = (bf16_t*)(ws + WS_WOUT) + (size_t)l * 1024 * 1024; t.dpitch = 1024; t.dcol0 = 0; t.mode = 0; }
    const int nblk = t.N / 32; t.kb = r / nblk; t.nb = r % nblk;
    const int n0 = 32 * t.nb; t.scale = (t.mode == 1 && ((n0 >= 1280 && n0 < 1792) || n0 >= 2304)) ? -LOG2E : 1.f;
    return t;
}
constexpr int N_SMALL_TILES = 2 * (16 * 168 + 8 * 32 + 8 * 32 + 16 * 32);
DI ConvTile expert_tile(const Args& a, int l, int it) {
    unsigned char* ws = a.ws; ConvTile t;
    const int m = it >> 9, r = it & 511, e = m / 3, kind = m % 3; const size_t wo = ((size_t)l * NE + e) * 1024 * 1024;
    t.N = 1024; t.dpitch = 1024; t.dcol0 = 0; t.kb = r >> 5; t.nb = r & 31;
    const long long d1 = (const char*)a.in[I_WEU] - (const char*)a.in[I_WEG], d2 = (const char*)a.in[I_WED] - (const char*)a.in[I_WEG];
    const long long dsel = kind == 0 ? 0ll : (kind == 1 ? d1 : d2);
    t.W = (const float*)((const char*)a.in[I_WEG] + dsel) + wo;
    t.WT = kind == 2 ? (bf16_t*)(ws + ws_wdn(l)) + (size_t)e * 1024 * 1024 : (bf16_t*)(ws + ws_wgu(l)) + (size_t)e * 2048 * 1024;
    t.mode = kind == 0 ? 2 : (kind == 1 ? 3 : 0);
    t.scale = kind == 0 ? -LOG2E : (kind == 1 ? -0.6931471805599453f : 1.f);
    return t;
}
constexpr int N_EXPERT_TILES = NE * 3 * 512;
constexpr int L1_E1 = 1024 * 4, L1_E2 = 512 * 2, L1_E3 = 1792 * 2, L1_EARLY = L1_E1 + L1_E2 + L1_E3;
template <class F> DI void convert_loop(int ntiles, int gw, int NGW, int lane, F&& get) {
    for (int it = gw; it < ntiles; it += 2 * NGW) {
        const ConvTile t0 = get(it); const bool two = it + NGW < ntiles; const ConvTile t1 = get(two ? it + NGW : it);
        f32x4 x0[8], x1[8];
        tile_load(t0, lane, x0); if (two) tile_load(t1, lane, x1);
        tile_store(t0, lane, x0); if (two) tile_store(t1, lane, x1);
    }
}
constexpr int CTR_WORD0 = 8192, CTR_STRIDE = 64;
DI void convert_pull(const Args& a, int l, int lane, const unsigned* done = nullptr, unsigned G = 0u) {
    unsigned* ctr = (unsigned*)(a.ws + WS_BAR) + CTR_WORD0 + l * CTR_STRIDE;
    for (;;) {
        if (done) { unsigned d = 0u; if (lane == 0) d = __hip_atomic_load(done, __ATOMIC_RELAXED, __HIP_MEMORY_SCOPE_AGENT); if ((unsigned)__builtin_amdgcn_readfirstlane((int)d) >= G) break; }
        unsigned itu = 0u; if (lane == 0) itu = __hip_atomic_fetch_add(ctr, 16u, __ATOMIC_RELAXED, __HIP_MEMORY_SCOPE_AGENT);
        const int it0 = __builtin_amdgcn_readfirstlane((int)itu);
        if (it0 >= N_EXPERT_TILES) break;
#pragma unroll 1
        for (int it = it0; it < it0 + 16; it += 2) {
            const ConvTile t0 = expert_tile(a, l, it), t1 = expert_tile(a, l, it + 1);
            f32x4 x0[8], x1[8];
            tile_load(t0, lane, x0); tile_load(t1, lane, x1);
            tile_store(t0, lane, x0); tile_store(t1, lane, x1);
        }
    }
}
DI void convert_small(const Args& a, int gw, int NGW, int lane) { convert_loop(N_SMALL_TILES, gw, NGW, lane, [&](int it) __attribute__((always_inline)) { return small_tile(a, it); }); }
DI void convert_experts(const Args& a, int l, int gw, int NGW, int lane) { convert_loop(N_EXPERT_TILES, gw, NGW, lane, [&](int it) __attribute__((always_inline)) { return expert_tile(a, l, it); }); }
DI void mod_item(const Args& a, LAS unsigned char* lds, int item) {
    const int tid = threadIdx.x, l = item / 96, cb = item % 96;
    LAS float* sc = (LAS float*)lds; LAS float* red = (LAS float*)(lds + 20480);
    for (int idx = tid; idx < 5120; idx += 512) { const int r = idx >> 10, k = idx & 1023; const float v = r < 4 ? a.in[I_C][r * 1024 + k] : a.in[I_CCTX][k]; sc[idx] = v / (1.f + expf(-v)); }
    __syncthreads();
    const int c4 = tid & 15, kg = tid >> 4; const float* w = a.in[I_WMOD] + (size_t)l * 1024 * 6144 + cb * 64 + c4 * 4 + (size_t)(kg * 32) * 6144;
    f32x4 acc[5];
#pragma unroll
    for (int r = 0; r < 5; ++r) acc[r] = (f32x4){0.f, 0.f, 0.f, 0.f};
#pragma unroll
    for (int k8 = 0; k8 < 32; k8 += 8) { f32x4 wv[8];
#pragma unroll
        for (int i = 0; i < 8; ++i) wv[i] = __builtin_nontemporal_load((const f32x4*)(w + (size_t)(k8 + i) * 6144));
#pragma unroll
        for (int i = 0; i < 8; ++i)
#pragma unroll
            for (int r = 0; r < 5; ++r) acc[r] = acc[r] + sc[r * 1024 + kg * 32 + k8 + i] * wv[i]; }
#pragma unroll
    for (int r = 0; r < 5; ++r) *(LAS f32x4*)(red + (kg * 5 + r) * 64 + c4 * 4) = acc[r];
    __syncthreads();
    if (tid < 320) { const int r = tid >> 6, col = tid & 63; float s = a.in[I_BMOD][l * 6144 + cb * 64 + col];
#pragma unroll 8
        for (int g = 0; g < 32; ++g) s += red[(g * 5 + r) * 64 + col];
        ((float*)(a.ws + WS_MOD))[(size_t)(l * 5 + r) * 6144 + cb * 64 + col] = s; }
    __syncthreads();
}
DI void rope_item(const Args& a) {
    float* rp = (float*)(a.ws + WS_ROPE);
    for (int idx = threadIdx.x; idx < 1024; idx += 512) { const int p = idx >> 4, i = idx & 15; const float fr = powf(10000.f, -(float)i / 16.f); const float ang = (float)p * fr; rp[idx] = cosf(ang); rp[1024 + idx] = sinf(ang); }
}
DI void fold_item(const Args& a, LAS unsigned char* lds, int item) {
    const int tid = threadIdx.x; const int nh = item & 1, kb = (item >> 1) & 15, gi = (item >> 5) & 3, l = item >> 7;
    LAS float* wp = (LAS float*)lds; LAS float* psv = (LAS float*)(lds + 4096);
    for (int idx = tid; idx < 1024; idx += 512) wp[idx] = a.in[I_WPOOL][(((size_t)l * 4 + gi) * 128 + kb * 8 + (idx >> 7)) * 128 + (idx & 127)];
    if (tid < 128) psv[tid] = a.in[I_PSCALE][l * 512 + gi * 128 + tid];
    __syncthreads();
    const int n = nh * 512 + tid; const float* wo = a.in[I_WPO] + ((size_t)l * 512 + gi * 128) * 1024 + n;
    float acc[8] = {0.f, 0.f, 0.f, 0.f, 0.f, 0.f, 0.f, 0.f};
#pragma unroll 16
    for (int j = 0; j < 128; ++j) { const float v = wo[(size_t)j * 1024] * psv[j];
#pragma unroll
        for (int kk = 0; kk < 8; ++kk) acc[kk] += wp[kk * 128 + j] * v; }
    u32x4 o; o.x = pk_bf16(acc[0], acc[1]); o.y = pk_bf16(acc[2], acc[3]); o.z = pk_bf16(acc[4], acc[5]); o.w = pk_bf16(acc[6], acc[7]);
    *(u32x4*)((bf16_t*)(a.ws + WS_WMERGE) + ((size_t)l * 1024 + n) * 1536 + 1024 + gi * 128 + kb * 8) = o;
    __syncthreads();
}
DI void phase_prep(const Args& a, LAS unsigned char* lds, int G, int c) {
    constexpr int NBI = 192 + 1 + 256;
    for (int it = c; it < NBI; it += G) { if (it < 192) mod_item(a, lds, it); else if (it == 192) rope_item(a); else fold_item(a, lds, it - 193); }
    __syncthreads();
    const int wid = __builtin_amdgcn_readfirstlane(threadIdx.x >> 6), lane = threadIdx.x & 63;
    convert_small(a, c * 8 + wid, G * 8, lane);
}

template <int MODE> DI void norm_phase(const Args& a, int l, LAS unsigned char* lds, int G, int c) {
    const int tid = threadIdx.x, wid = __builtin_amdgcn_readfirstlane(tid >> 6), lane = tid & 63;
    unsigned char* ws = a.ws;
    bf16_t* X = (bf16_t*)(ws + WS_X); bf16_t* H = (bf16_t*)(ws + WS_H); const float* MOD = (const float*)(ws + WS_MOD);
    float* AFF = (float*)(ws + WS_AFF); const int* SLOTOF = (const int*)(ws + WS_SLOTOF); const bf16_t* Y = (const bf16_t*)(ws + WS_Y);
    LAS float* wr_l = (LAS float*)lds;
    constexpr int WRP = 1028;
    if (MODE == 2) {
        const f32x4* wsrc = (const f32x4*)(a.in[I_WR] + (size_t)l * 16384); f32x4 wv[8];
#pragma unroll
        for (int i = 0; i < 8; ++i) wv[i] = wsrc[tid + 512 * i];
#pragma unroll
        for (int i = 0; i < 8; ++i) { const int q = tid + 512 * i, k = q >> 2, e0 = (q & 3) * 4;
            wr_l[(e0 + 0) * WRP + k] = wv[i].x; wr_l[(e0 + 1) * WRP + k] = wv[i].y; wr_l[(e0 + 2) * WRP + k] = wv[i].z; wr_l[(e0 + 3) * WRP + k] = wv[i].w; }
        __syncthreads(); }
    constexpr bool COMB = (MODE == 1 || MODE == 3);
    const int nrows = (MODE == 3) ? TL : TT; const int rpb = (nrows + G - 1) / G; const int r0 = c * rpb; const int r1 = (r0 + rpb) < nrows ? (r0 + rpb) : nrows;
    constexpr bool XIN = (MODE == 0 || MODE == 1);
    constexpr int NS = (MODE == 0) ? 3 : 1;
    f32x4 vn[NS][2][4]; u32x2 xbn[NS][2][4]; u32x2 dln[NS][2][4]; int son[NS][2]; float afn[NS][2];
    auto load_pair = [&](int base, int s) __attribute__((always_inline)) {
#pragma unroll
        for (int r = 0; r < 2; ++r) { const int row = (base + r < r1) ? base + r : base;
            if (XIN) { const float* src = row < TL ? a.in[I_X] + (size_t)row * DM : a.in[I_CTX] + (size_t)(row - TL) * DM;
#pragma unroll
                for (int j = 0; j < 4; ++j) vn[s][r][j] = *(const f32x4*)(src + 256 * j + 4 * lane);
            } else {
#pragma unroll
                for (int j = 0; j < 4; ++j) xbn[s][r][j] = *(const u32x2*)(X + (size_t)row * DM + 256 * j + 4 * lane); }
            if (COMB) {
#pragma unroll
                for (int j = 0; j < 4; ++j) dln[s][r][j] = *(const u32x2*)((const bf16_t*)(ws + WS_DELTA) + (size_t)row * DM + 256 * j + 4 * lane); }
            if (COMB) { son[s][r] = lane < 16 ? SLOTOF[(size_t)row * 16 + lane] : -1; afn[s][r] = lane < 16 ? AFF[(size_t)row * 16 + lane] : 0.f; } }
    };
    constexpr bool PREF = (MODE != 2);
    f32x4 gsc[4], shf[4], g2c[4], fng[4]; int mr_c = -1;
    if (MODE == 3) {
#pragma unroll
        for (int j = 0; j < 4; ++j) fng[j] = *(const f32x4*)(a.in[I_FNG] + 256 * j + 4 * lane); }
    if (PREF && r0 + 2 * wid < r1) load_pair(r0 + 2 * wid, 0);
    if (PREF && NS >= 2 && r0 + 2 * wid + 16 < r1) load_pair(r0 + 2 * wid + 16, NS >= 2 ? 1 : 0);
    if (PREF && NS >= 3 && r0 + 2 * wid + 32 < r1) load_pair(r0 + 2 * wid + 32, NS >= 3 ? 2 : 0);
    auto step = [&](int base, int s) __attribute__((always_inline)) {
        const bool two = base + 1 < r1;
        if (!PREF) load_pair(base, s);
        f32x4 v[2][4]; int so[2]; float af[2]; int mr[2];
#pragma unroll
        for (int r = 0; r < 2; ++r) { const int row = (r == 1 && !two) ? base : base + r; mr[r] = row < TL ? (row >> 12) : 4; so[r] = son[s][r]; af[r] = afn[s][r];
#pragma unroll
            for (int j = 0; j < 4; ++j) { v[r][j] = XIN ? vn[s][r][j] : (f32x4){bf_lo(xbn[s][r][j].x), bf_hi(xbn[s][r][j].x), bf_lo(xbn[s][r][j].y), bf_hi(xbn[s][r][j].y)}; if (COMB) v[r][j] = v[r][j] + (f32x4){bf_lo(dln[s][r][j].x), bf_hi(dln[s][r][j].x), bf_lo(dln[s][r][j].y), bf_hi(dln[s][r][j].y)}; } }
        if (PREF && base + 16 * NS < r1) load_pair(base + 16 * NS, s);
        if (mr[0] != mr_c) { mr_c = mr[0];
            if (MODE != 3) { const float* gvv = (MODE == 2 ? a.in[I_N2G] : a.in[I_N1G]) + (size_t)l * DM; const float* mb = MOD + (size_t)(l * 5 + mr_c) * 6144 + (MODE == 2 ? 3072 : 0);
#pragma unroll
                for (int j = 0; j < 4; ++j) { const int k = 256 * j + 4 * lane; gsc[j] = *(const f32x4*)(gvv + k) * (1.f + *(const f32x4*)(mb + 1024 + k)); shf[j] = *(const f32x4*)(mb + k); } }
            if (COMB) { const float* g2p = MOD + (size_t)(((MODE == 1) ? 0 : 1) * 5 + mr_c) * 6144 + 5120;
#pragma unroll
                for (int j = 0; j < 4; ++j) g2c[j] = *(const f32x4*)(g2p + 256 * j + 4 * lane); } }
        if (COMB) {
            const int lp = (MODE == 1) ? 0 : 1;
            f32x4 cacc[2][4]; unsigned mask[2];
            int s1[2], s2[2]; float w1[2], w2[2];
#pragma unroll
            for (int r = 0; r < 2; ++r) {
#pragma unroll
                for (int j = 0; j < 4; ++j) cacc[r][j] = (f32x4){0.f, 0.f, 0.f, 0.f};
                mask[r] = (r == 0 || two) ? ((unsigned)__ballot(so[r] >= 0) & 0xffffu) : 0u;
                const bool h1 = mask[r] != 0u; const int e1 = h1 ? __builtin_ctz(mask[r]) : 0; if (h1) mask[r] &= mask[r] - 1;
                const bool h2 = mask[r] != 0u; const int e2 = h2 ? __builtin_ctz(mask[r]) : e1; if (h2) mask[r] &= mask[r] - 1;
                const int t1 = __builtin_amdgcn_readlane(so[r], e1), t2 = __builtin_amdgcn_readlane(so[r], e2);
                s1[r] = h1 ? t1 : 0; s2[r] = h2 ? t2 : s1[r];
                w1[r] = h1 ? __uint_as_float(__builtin_amdgcn_readlane(__float_as_uint(af[r]), e1)) : 0.f;
                w2[r] = h2 ? __uint_as_float(__builtin_amdgcn_readlane(__float_as_uint(af[r]), e2)) : 0.f; }
            { u32x2 ya[2][4], yb[2][4];
#pragma unroll
              for (int r = 0; r < 2; ++r)
#pragma unroll
                for (int j = 0; j < 4; ++j) { ya[r][j] = *(const u32x2*)(Y + (size_t)s1[r] * 1024 + 4 * lane + 256 * j); yb[r][j] = *(const u32x2*)(Y + (size_t)s2[r] * 1024 + 4 * lane + 256 * j); }
#pragma unroll
              for (int r = 0; r < 2; ++r)
#pragma unroll
                for (int j = 0; j < 4; ++j) cacc[r][j] = cacc[r][j] + w1[r] * (f32x4){bf_lo(ya[r][j].x), bf_hi(ya[r][j].x), bf_lo(ya[r][j].y), bf_hi(ya[r][j].y)} + w2[r] * (f32x4){bf_lo(yb[r][j].x), bf_hi(yb[r][j].x), bf_lo(yb[r][j].y), bf_hi(yb[r][j].y)}; }
#pragma unroll
            for (int r = 0; r < 2; ++r) if (r == 0 || two) { const int row = base + r;
                unsigned mk = mask[r];
                while (mk) {
                    const int e1 = __builtin_ctz(mk); mk &= mk - 1;
                    const int t1 = __builtin_amdgcn_readlane(so[r], e1); const float ww = __uint_as_float(__builtin_amdgcn_readlane(__float_as_uint(af[r]), e1));
                    const bf16_t* y1 = Y + (size_t)t1 * 1024 + 4 * lane;
#pragma unroll
                    for (int j = 0; j < 4; ++j) { const u32x2 yv = *(const u32x2*)(y1 + 256 * j); cacc[r][j] = cacc[r][j] + ww * (f32x4){bf_lo(yv.x), bf_hi(yv.x), bf_lo(yv.y), bf_hi(yv.y)}; }
                }
                if (mr[r] == mr_c) {
#pragma unroll
                    for (int j = 0; j < 4; ++j) v[r][j] = v[r][j] + g2c[j] * cacc[r][j];
                } else { const float* g2 = MOD + (size_t)(lp * 5 + mr[r]) * 6144 + 5120;
#pragma unroll
                    for (int j = 0; j < 4; ++j) v[r][j] = v[r][j] + *(const f32x4*)(g2 + 256 * j + 4 * lane) * cacc[r][j]; }
                if (MODE == 1 && row < TL) {
#pragma unroll
                    for (int jp = 0; jp < 2; ++jp) {
                        const unsigned a0 = pk_bf16(v[r][2 * jp][0], v[r][2 * jp][1]), a1 = pk_bf16(v[r][2 * jp][2], v[r][2 * jp][3]), b0 = pk_bf16(v[r][2 * jp + 1][0], v[r][2 * jp + 1][1]), b1 = pk_bf16(v[r][2 * jp + 1][2], v[r][2 * jp + 1][3]);
                        const bool odd = lane & 1;
                        const unsigned s0 = odd ? a0 : b0, s1 = odd ? a1 : b1;
                        const unsigned q0 = (unsigned)__builtin_amdgcn_update_dpp((int)s0, (int)s0, 0xB1, 0xF, 0xF, false), q1 = (unsigned)__builtin_amdgcn_update_dpp((int)s1, (int)s1, 0xB1, 0xF, 0xF, false);
                        const u32x4 w = odd ? (u32x4){q0, q1, b0, b1} : (u32x4){a0, a1, q0, q1};
                        st16_wt(X + (size_t)row * DM + 256 * (2 * jp + (odd ? 1 : 0)) + 4 * (lane & ~1), w);
                    }
                }
            }
        }
        float rms[2];
#pragma unroll
        for (int r = 0; r < 2; ++r) { float ss = 0.f;
#pragma unroll
            for (int j = 0; j < 4; ++j) ss += (v[r][j].x * v[r][j].x + v[r][j].y * v[r][j].y) + (v[r][j].z * v[r][j].z + v[r][j].w * v[r][j].w);
            rms[r] = 1.0f / sqrtf(wave_sum(ss) * (1.f / DM) + 1e-6f); }
        if (MODE == 3) {
#pragma unroll
            for (int r = 0; r < 2; ++r) if (r == 0 || two) {
#pragma unroll
                for (int j = 0; j < 4; ++j) *(f32x4*)(a.out + (size_t)(base + r) * DM + 256 * j + 4 * lane) = v[r][j] * rms[r] * fng[j]; }
        } else {
            const float* gv = (MODE == 2 ? a.in[I_N2G] : a.in[I_N1G]) + (size_t)l * DM;
#pragma unroll
            for (int r = 0; r < 2; ++r) {
                if (mr[r] == mr_c) {
#pragma unroll
                    for (int j = 0; j < 4; ++j) v[r][j] = (v[r][j] * rms[r]) * gsc[j] + shf[j];
                } else { const float* mb = MOD + (size_t)(l * 5 + mr[r]) * 6144 + (MODE == 2 ? 3072 : 0);
#pragma unroll
                    for (int j = 0; j < 4; ++j) { const int k = 256 * j + 4 * lane; v[r][j] = (v[r][j] * rms[r] * *(const f32x4*)(gv + k)) * (1.f + *(const f32x4*)(mb + 1024 + k)) + *(const f32x4*)(mb + k); } }
#pragma unroll
                for (int j = 0; j < 4; ++j) if (r == 0 || two) st_bf4(H + (size_t)(base + r) * DM + 256 * j + 4 * lane, v[r][j]); }
            if (MODE == 2) {
                float lg[2][16];
#pragma unroll
                for (int e = 0; e < 16; ++e) { float s0 = 0.f, s1 = 0.f;
#pragma unroll
                    for (int j = 0; j < 4; ++j) { const f32x4 w4 = *(const LAS f32x4*)(wr_l + e * WRP + 256 * j + 4 * lane);
                        s0 += (v[0][j].x * w4.x + v[0][j].y * w4.y) + (v[0][j].z * w4.z + v[0][j].w * w4.w);
                        s1 += (v[1][j].x * w4.x + v[1][j].y * w4.y) + (v[1][j].z * w4.z + v[1][j].w * w4.w); }
                    if (e & 1) asm volatile("" : "+v"(s0), "+v"(s1) :: "memory");
                    lg[0][e] = s0; lg[1][e] = s1; }
#pragma unroll
                for (int r = 0; r < 2; ++r) {
                    float a8[8], a4[4], a2[2], a1;
                    const bool b0 = lane & 1, b1 = lane & 2, b2 = lane & 4, b3 = lane & 8;
#pragma unroll
                    for (int i = 0; i < 8; ++i) { const float snd = b0 ? lg[r][i] : lg[r][i + 8], kp = b0 ? lg[r][i + 8] : lg[r][i]; a8[i] = kp + __shfl_xor(snd, 1); }
#pragma unroll
                    for (int i = 0; i < 4; ++i) { const float snd = b1 ? a8[i] : a8[i + 4], kp = b1 ? a8[i + 4] : a8[i]; a4[i] = kp + __shfl_xor(snd, 2); }
#pragma unroll
                    for (int i = 0; i < 2; ++i) { const float snd = b2 ? a4[i] : a4[i + 2], kp = b2 ? a4[i + 2] : a4[i]; a2[i] = kp + __shfl_xor(snd, 4); }
                    { const float snd = b3 ? a2[0] : a2[1], kp = b3 ? a2[1] : a2[0]; a1 = kp + __shfl_xor(snd, 8); }
                    a1 += __shfl_xor(a1, 16); a1 += __shfl_xor(a1, 32);
                    float mx = a1;
#pragma unroll
                    for (int o = 1; o < 16; o <<= 1) mx = fmaxf(mx, __shfl_xor(mx, o));
                    const float ex = expf(a1 - mx); float sum = ex;
#pragma unroll
                    for (int o = 1; o < 16; o <<= 1) sum += __shfl_xor(sum, o);
                    const int e = (b0 ? 8 : 0) + (b1 ? 4 : 0) + (b2 ? 2 : 0) + (b3 ? 1 : 0);
                    if (lane < 16 && (r == 0 || two)) AFF[(size_t)(base + r) * 16 + e] = ex / sum;
                }
            }
        }
    };
    for (int base = r0 + 2 * wid; base < r1; base += 16 * NS) { step(base, 0); if (NS >= 2 && base + 16 < r1) step(base + 16, NS >= 2 ? 1 : 0); if (NS >= 3 && base + 32 < r1) step(base + 32, NS >= 3 ? 2 : 0); }
    __syncthreads();
}

DI void norm2_table(const Args& a, int l, LAS unsigned char* lds) {
    const int tid = threadIdx.x;
    LAS float* wr_l = (LAS float*)lds;
    constexpr int WRP = 1028;
    { const f32x4* wsrc = (const f32x4*)(a.in[I_WR] + (size_t)l * 16384); f32x4 wv[8];
#pragma unroll
      for (int i = 0; i < 8; ++i) wv[i] = wsrc[tid + 512 * i];
#pragma unroll
      for (int i = 0; i < 8; ++i) { const int q = tid + 512 * i, k = q >> 2, e0 = (q & 3) * 4;
          wr_l[(e0 + 0) * WRP + k] = wv[i].x; wr_l[(e0 + 1) * WRP + k] = wv[i].y; wr_l[(e0 + 2) * WRP + k] = wv[i].z; wr_l[(e0 + 3) * WRP + k] = wv[i].w; }
      __syncthreads(); }
}
DI void norm2_rows(const Args& a, int l, LAS unsigned char* lds, int r0, int r1) {
    const int tid = threadIdx.x, wid = __builtin_amdgcn_readfirstlane(tid >> 6), lane = tid & 63;
    unsigned char* ws = a.ws;
    const bf16_t* X = (const bf16_t*)(ws + WS_X); bf16_t* H = (bf16_t*)(ws + WS_H); const float* MOD = (const float*)(ws + WS_MOD); float* AFF = (float*)(ws + WS_AFF);
    const bf16_t* DL = (const bf16_t*)(ws + WS_DELTA);
    auto xrow = [&](int row) __attribute__((always_inline)) -> const float* { return row < TL ? a.in[I_X] + (size_t)row * DM : a.in[I_CTX] + (size_t)(row - TL) * DM; };
    LAS float* wr_l = (LAS float*)lds;
    constexpr int WRP = 1028;
    const float* gv = a.in[I_N2G] + (size_t)l * DM;
    f32x4 gsc[4], shf[4]; int mr_c = -1;
    f32x4 vn[4]; u32x2 xn[4]; u32x2 dn[4];
    auto load_row = [&](int row) __attribute__((always_inline)) {
        if (l == 0) { const float* xr = xrow(row);
#pragma unroll
            for (int j = 0; j < 4; ++j) vn[j] = *(const f32x4*)(xr + 256 * j + 4 * lane);
        } else {
#pragma unroll
            for (int j = 0; j < 4; ++j) xn[j] = *(const u32x2*)(X + (size_t)row * DM + 256 * j + 4 * lane); }
#pragma unroll
        for (int j = 0; j < 4; ++j) dn[j] = *(const u32x2*)(DL + (size_t)row * DM + 256 * j + 4 * lane);
    };
    if (r0 + wid < r1) load_row(r0 + wid);
    for (int row = r0 + wid; row < r1; row += 8) {
        f32x4 v[4];
#pragma unroll
        for (int j = 0; j < 4; ++j) v[j] = (l == 0 ? vn[j] : (f32x4){bf_lo(xn[j].x), bf_hi(xn[j].x), bf_lo(xn[j].y), bf_hi(xn[j].y)}) + (f32x4){bf_lo(dn[j].x), bf_hi(dn[j].x), bf_lo(dn[j].y), bf_hi(dn[j].y)};
        if (row + 8 < r1) load_row(row + 8);
        const int mr = row < TL ? (row >> 12) : 4;
        float ss = 0.f;
#pragma unroll
        for (int j = 0; j < 4; ++j) ss += (v[j].x * v[j].x + v[j].y * v[j].y) + (v[j].z * v[j].z + v[j].w * v[j].w);
        const float rms = 1.0f / sqrtf(wave_sum(ss) * (1.f / DM) + 1e-6f);
        if (mr != mr_c) { mr_c = mr; const float* mb = MOD + (size_t)(l * 5 + mr) * 6144 + 3072;
#pragma unroll
            for (int j = 0; j < 4; ++j) { const int k = 256 * j + 4 * lane; gsc[j] = *(const f32x4*)(gv + k) * (1.f + *(const f32x4*)(mb + 1024 + k)); shf[j] = *(const f32x4*)(mb + k); } }
#pragma unroll
        for (int j = 0; j < 4; ++j) { const int k = 256 * j + 4 * lane;
            v[j] = (v[j] * rms) * gsc[j] + shf[j];
            st_bf4(H + (size_t)row * DM + k, v[j]); }
        float lg[16];
#pragma unroll
        for (int e = 0; e < 16; ++e) { float s0 = 0.f;
#pragma unroll
            for (int j = 0; j < 4; ++j) { const f32x4 w4 = *(const LAS f32x4*)(wr_l + e * WRP + 256 * j + 4 * lane); s0 += (v[j].x * w4.x + v[j].y * w4.y) + (v[j].z * w4.z + v[j].w * w4.w); }
            if ((e & 3) == 3) asm volatile("" : "+v"(s0) :: "memory");
            lg[e] = s0; }
        float a8[8], a4[4], a2[2], a1;
        const bool b0 = lane & 1, b1 = lane & 2, b2 = lane & 4, b3 = lane & 8;
#pragma unroll
        for (int i = 0; i < 8; ++i) { const float snd = b0 ? lg[i] : lg[i + 8], kp = b0 ? lg[i + 8] : lg[i]; a8[i] = kp + lane_xor<1>(snd); }
#pragma unroll
        for (int i = 0; i < 4; ++i) { const float snd = b1 ? a8[i] : a8[i + 4], kp = b1 ? a8[i + 4] : a8[i]; a4[i] = kp + lane_xor<2>(snd); }
#pragma unroll
        for (int i = 0; i < 2; ++i) { const float snd = b2 ? a4[i] : a4[i + 2], kp = b2 ? a4[i + 2] : a4[i]; a2[i] = kp + lane_xor<4>(snd); }
        { const float snd = b3 ? a2[0] : a2[1], kp = b3 ? a2[1] : a2[0]; a1 = kp + lane_xor<8>(snd); }
        a1 = pair_sum32(pair_sum16(a1));
        float mx = a1;
        mx = fmaxf(mx, lane_xor<1>(mx)); mx = fmaxf(mx, lane_xor<2>(mx)); mx = fmaxf(mx, lane_xor<4>(mx)); mx = fmaxf(mx, lane_xor<8>(mx));
        const float ex = expf(a1 - mx); float sum = ex;
        sum += lane_xor<1>(sum); sum += lane_xor<2>(sum); sum += lane_xor<4>(sum); sum += lane_xor<8>(sum);
        const int e = (b0 ? 8 : 0) + (b1 ? 4 : 0) + (b2 ? 2 : 0) + (b3 ? 1 : 0);
        if (lane < 16) AFF[(size_t)row * 16 + e] = ex / sum;
    }
    __syncthreads();
}

DI void norm2_phase(const Args& a, int l, LAS unsigned char* lds, int G, int c) {
    norm2_table(a, l, lds);
    const int nrows = l == 0 ? TT : TL;
    const int rpb = (nrows + G - 1) / G; const int r0 = c * rpb; const int r1 = (r0 + rpb) < nrows ? (r0 + rpb) : nrows;
    norm2_rows(a, l, lds, r0, r1);
}

constexpr int KPITCH = 144, VPITCH = 272;
constexpr int ATT_K = 0, ATT_V = 128 * KPITCH, ATT_WS = ATT_V + 64 * VPITCH;

DI void attn_seg(int kind, int qb, int tq0, int ctx0, int i, int& tok0, int& mode) {
    mode = 0;
    if (kind == 1) { tok0 = ctx0 + i * 128; return; }
    if (i == 0) tok0 = tq0;
    else if (i < 3) tok0 = ctx0 + (i - 1) * 128;
    else if (i == 3 && qb > 0) { tok0 = tq0 - 128; mode = 1; }
    else { tok0 = tq0 + 128; mode = 2; }
}
DI void attn_unit(const Args& a, int l, LAS unsigned char* lds, int kind, int b, int qb, int kh, int hh) {
    const int tid = threadIdx.x, lane = tid & 63, r32 = lane & 31, hi = lane >> 5; const int wid = __builtin_amdgcn_readfirstlane(tid >> 6);
    unsigned char* ws = a.ws;
    const bf16_t* Q = (const bf16_t*)(ws + WS_Q); const bf16_t* Kb = (const bf16_t*)(ws + WS_K); const bf16_t* VT = (const bf16_t*)(ws + WS_VT); bf16_t* BR = (bf16_t*)(ws + WS_BR);
    const int tq0 = kind == 0 ? b * SEQ + qb * 128 : TL + b * CTXL + qb * 128;
    const int ctx0 = TL + b * CTXL;
    const int h = kh * 4 + hh * 2 + (wid >> 2), qs = (wid & 3) * 32;
    const int qi = qs + r32;
    LAS float* wsf = (LAS float*)(lds + ATT_WS) + wid * 64;
    const int nseg = kind == 0 ? 3 + (qb > 0 ? 1 : 0) + (qb < 31 ? 1 : 0) : 2;
    const int krow = tid >> 3, kch = tid & 7, vrow = tid >> 4, vch = tid & 15;
    u32x4 kreg[2], vreg[2];
    { int tok0, mode; attn_seg(kind, qb, tq0, ctx0, 0, tok0, mode);
#pragma unroll
      for (int i = 0; i < 2; ++i) { kreg[i] = *(const u32x4*)(Kb + (size_t)(tok0 + krow + 64 * i) * 128 + kh * 64 + kch * 8); vreg[i] = *(const u32x4*)(VT + (size_t)(kh * 64 + vrow + 32 * i) * TT + tok0 + vch * 8); } }
    bf16x8 qf[4];
#pragma unroll
    for (int s = 0; s < 4; ++s) qf[s] = *(const bf16x8*)(Q + (size_t)(tq0 + qi) * 512 + h * 64 + s * 16 + hi * 8);
    float mrun = -1e30f, lrun = 0.f;
    f32x16 o[2];
#pragma unroll
    for (int d0 = 0; d0 < 2; ++d0)
#pragma unroll
        for (int r = 0; r < 16; ++r) o[d0][r] = 0.f;
    for (int sg = 0; sg < nseg; ++sg) {
        int tok0, mode; attn_seg(kind, qb, tq0, ctx0, sg, tok0, mode);
        int lo_lim = mode == 1 ? qi : -100000, hi_lim = mode == 2 ? qi : 100000;
        asm volatile("" : "+v"(lo_lim), "+v"(hi_lim));
        __syncthreads();
#pragma unroll
        for (int i = 0; i < 2; ++i) { *(LAS u32x4*)(lds + ATT_K + (krow + 64 * i) * KPITCH + kch * 16) = kreg[i]; *(LAS u32x4*)(lds + ATT_V + (vrow + 32 * i) * VPITCH + vch * 16) = vreg[i]; }
        __syncthreads();
        if (sg + 1 < nseg) { int tn, mn; attn_seg(kind, qb, tq0, ctx0, sg + 1, tn, mn);
#pragma unroll
            for (int i = 0; i < 2; ++i) { kreg[i] = *(const u32x4*)(Kb + (size_t)(tn + krow + 64 * i) * 128 + kh * 64 + kch * 8); vreg[i] = *(const u32x4*)(VT + (size_t)(kh * 64 + vrow + 32 * i) * TT + tn + vch * 8); } }
#pragma unroll 1
        for (int tk = 0; tk < 2; ++tk) {
            if (mode == 1 && tk * 64 + 63 < qs) continue;
            if (mode == 2 && tk * 64 > qs + 31) continue;
            f32x16 s0, s1;
#pragma unroll
            for (int r = 0; r < 16; ++r) { s0[r] = 0.f; s1[r] = 0.f; }
            const LAS unsigned char* kp = lds + ATT_K + (tk * 64 + r32) * KPITCH + hi * 16;
#pragma unroll
            for (int s = 0; s < 4; ++s) {
                const bf16x8 k0 = *(const LAS bf16x8*)(kp + s * 32);
                const bf16x8 k1 = *(const LAS bf16x8*)(kp + 32 * KPITCH + s * 32);
                s0 = __builtin_amdgcn_mfma_f32_32x32x16_bf16(k0, qf[s], s0, 0, 0, 0);
                s1 = __builtin_amdgcn_mfma_f32_32x32x16_bf16(k1, qf[s], s1, 0, 0, 0);
            }
            asm volatile("s_nop 15\n\ts_nop 7" : "+v"(s0), "+v"(s1));
            if (mode != 0) {
                const int kb0 = tk * 64 + 4 * hi;
#pragma unroll
                for (int r = 0; r < 16; ++r) { const int kj = kb0 + (r & 3) + 8 * (r >> 2);
                    if (kj < lo_lim || kj > hi_lim) s0[r] = -1e30f;
                    if (kj + 32 < lo_lim || kj + 32 > hi_lim) s1[r] = -1e30f; }
            }
            float tm = mrun;
            float tm2 = s0[0];
#pragma unroll
            for (int r = 0; r < 16; r += 2) { tm = max3f(tm, s0[r], s1[r]); tm2 = max3f(tm2, s0[r + 1], s1[r + 1]); }
            { const float th = max3f(tm, tm2, tm2); const auto sw = __builtin_amdgcn_permlane32_swap(__float_as_uint(th), __float_as_uint(th), false, false);
              tm = max3f(th, __uint_as_float(sw[0]), __uint_as_float(sw[1])); }
            const float mnew = tm;
            float ls = 0.f, ls_b = 0.f;
#pragma unroll
            for (int r = 0; r < 16; ++r) { s0[r] = __builtin_amdgcn_exp2f(s0[r] - mnew); s1[r] = __builtin_amdgcn_exp2f(s1[r] - mnew); ls += s0[r]; ls_b += s1[r]; }
            ls += ls_b;
            if (__any(mnew > mrun)) {
                const float alpha = __builtin_amdgcn_exp2f(mrun - mnew);
                lrun *= alpha;
                if (hi == 0) wsf[r32] = alpha;
#pragma unroll
                for (int r = 0; r < 16; ++r) { const float f = wsf[crow(r, hi)]; o[0][r] *= f; o[1][r] *= f; }
            }
            mrun = mnew; lrun += ls;
            const LAS unsigned char* vp0 = lds + ATT_V + r32 * VPITCH + (tk * 64 + 4 * hi) * 2;
#pragma unroll
            for (int cc = 0; cc < 2; ++cc)
#pragma unroll
                for (int s = 0; s < 2; ++s) {
                    u32x4 pw;
                    if (cc == 0) { pw.x = pk_bf16(s0[8 * s], s0[8 * s + 1]); pw.y = pk_bf16(s0[8 * s + 2], s0[8 * s + 3]); pw.z = pk_bf16(s0[8 * s + 4], s0[8 * s + 5]); pw.w = pk_bf16(s0[8 * s + 6], s0[8 * s + 7]); }
                    else { pw.x = pk_bf16(s1[8 * s], s1[8 * s + 1]); pw.y = pk_bf16(s1[8 * s + 2], s1[8 * s + 3]); pw.z = pk_bf16(s1[8 * s + 4], s1[8 * s + 5]); pw.w = pk_bf16(s1[8 * s + 6], s1[8 * s + 7]); }
                    const bf16x8 pa = __builtin_bit_cast(bf16x8, pw);
#pragma unroll
                    for (int d0 = 0; d0 < 2; ++d0) {
                        const LAS unsigned char* vp = vp0 + d0 * 32 * VPITCH + (cc * 32 + s * 16) * 2;
                        const s16x4 lo = *(const LAS s16x4*)vp, hh2 = *(const LAS s16x4*)(vp + 16);
                        const bf16x8 vb = (bf16x8){lo[0], lo[1], lo[2], lo[3], hh2[0], hh2[1], hh2[2], hh2[3]};
                        o[d0] = __builtin_amdgcn_mfma_f32_32x32x16_bf16(pa, vb, o[d0], 0, 0, 0);
                    }
                }
        }
    }
    const float sk = a.in[I_SINK][l * 8 + h] * LOG2E;
    {
        const float lt = pair_sum32(lrun) + __builtin_amdgcn_exp2f(sk - mrun);
        if (hi == 0) wsf[r32] = 1.f / lt;
#pragma unroll
        for (int r = 0; r < 16; ++r) { const float f = wsf[crow(r, hi)]; bf16_t* op = BR + (size_t)(tq0 + qs + crow(r, hi)) * 1536 + h * 64 + r32;
            op[0] = f2bf(o[0][r] * f); op[32] = f2bf(o[1][r] * f); }
    }
    __syncthreads();
}

DI void seq_bounds(int t0, int& lo, int& hi) { if (t0 < TL) { lo = t0 & ~(SEQ - 1); hi = lo + SEQ; } else { lo = TL + ((t0 - TL) & ~(CTXL - 1)); hi = lo + CTXL; } }

DI void conv_unit(const Args& a, int l, LAS unsigned char* lds, int t0) {
    const int tid = threadIdx.x, lane = tid & 63; const int wid = __builtin_amdgcn_readfirstlane(tid >> 6);
    const bf16_t* U = (const bf16_t*)(a.ws + WS_U); bf16_t* BR = (bf16_t*)(a.ws + WS_BR);
    int slo, shi; seq_bounds(t0, slo, shi);
    const int c = tid; float w[31];
#pragma unroll
    for (int k = 0; k < 31; ++k) w[k] = a.in[I_CDW][((size_t)l * 31 + k) * 512 + c];
    const float bias = a.in[I_CDWB][l * 512 + c];
    { u32x4 tv[8];
#pragma unroll
      for (int i = 0; i < 8; ++i) { const int idx = tid + 512 * i; const int row = idx >> 6, ch = idx & 63; const int tok = t0 - 15 + row; tv[i] = (u32x4){0u, 0u, 0u, 0u};
          if (row < 62 && tok >= slo && tok < shi) tv[i] = *(const u32x4*)(U + (size_t)tok * 512 + ch * 8); }
#pragma unroll
      for (int i = 0; i < 8; ++i) { const int idx = tid + 512 * i; const int row = idx >> 6, ch = idx & 63; if (row < 62) *(LAS u32x4*)(lds + row * 1024 + ch * 16) = tv[i]; } }
    __syncthreads();
    float xin[62];
#pragma unroll
    for (int i = 0; i < 62; ++i) xin[i] = bf2f(((const LAS bf16_t*)lds)[i * 512 + c]);
    LAS float* cs = (LAS float*)(lds + 65536);
#pragma unroll
    for (int t = 0; t < 32; ++t) { float acc = bias;
#pragma unroll
        for (int k = 0; k < 31; ++k) acc = fmaf(xin[t + k], w[k], acc);
        cs[t * 512 + c] = acc; }
    __syncthreads();
    const float* lg = a.in[I_CLNG] + l * 512; const float* lb = a.in[I_CLNB] + l * 512;
#pragma unroll
    for (int tt = 0; tt < 4; ++tt) { const int t = 4 * wid + tt; float v[8]; float s = 0.f;
#pragma unroll
        for (int i = 0; i < 8; ++i) { v[i] = cs[t * 512 + lane + 64 * i]; s += v[i]; }
        const float mean = wave_sum(s) * (1.f / 512.f); float q = 0.f;
#pragma unroll
        for (int i = 0; i < 8; ++i) { v[i] -= mean; q += v[i] * v[i]; }
        const float rstd = 1.0f / sqrtf(wave_sum(q) * (1.f / 512.f) + 1e-6f);
#pragma unroll
        for (int i = 0; i < 8; ++i) { const int c2 = lane + 64 * i; const float y = v[i] * rstd * lg[c2] + lb[c2]; BR[(size_t)(t0 + t) * 1536 + 512 + c2] = f2bf(y * sigm(y)); } }
    __syncthreads();
}
template <int HALF> DI void pool_compute(const LAS bf16_t* zs, int c, int t0, int slo, int shi, bf16_t* BR) {
    float P[49];
    float zc[32];
    P[0] = 0.f;
#pragma unroll
    for (int r = 0; r < 48; ++r) { const float z = bf2f(zs[r * 512 + c]); P[r + 1] = P[r] + z; if (r >= 8 && r < 40) zc[r - 8] = z; }
#pragma unroll
    for (int t = 0; t < 32; ++t) { const int tt = t0 + t; const int lo = (tt - HALF) > slo ? (tt - HALF) : slo, hi = (tt + HALF) < shi ? (tt + HALF) : shi;
        const float d = (P[t + 8 + HALF] - P[t + 8 - HALF]) * __builtin_amdgcn_rcpf((float)(hi - lo)) - zc[t];
        BR[(size_t)tt * 1536 + 1024 + c] = f2bf(d); }
}
DI void pool_unit(const Args& a, LAS unsigned char* lds, int t0) {
    const int tid = threadIdx.x;
    const bf16_t* Z = (const bf16_t*)(a.ws + WS_Z); bf16_t* BR = (bf16_t*)(a.ws + WS_BR);
    int slo, shi; seq_bounds(t0, slo, shi);
    { u32x4 tv[6];
#pragma unroll
      for (int i = 0; i < 6; ++i) { const int idx = tid + 512 * i; const int row = idx >> 6, ch = idx & 63; const int tok = t0 - 8 + row; tv[i] = (u32x4){0u, 0u, 0u, 0u};
          if (tok >= slo && tok < shi) tv[i] = *(const u32x4*)(Z + (size_t)tok * 512 + ch * 8); }
#pragma unroll
      for (int i = 0; i < 6; ++i) { const int idx = tid + 512 * i; const int row = idx >> 6, ch = idx & 63; *(LAS u32x4*)(lds + row * 1024 + ch * 16) = tv[i]; } }
    __syncthreads();
    const int c = tid; const int gi = __builtin_amdgcn_readfirstlane(c >> 7); const LAS bf16_t* zs = (const LAS bf16_t*)lds;
    if (gi == 0) pool_compute<1>(zs, c, t0, slo, shi, BR); else if (gi == 1) pool_compute<2>(zs, c, t0, slo, shi, BR);
    else if (gi == 2) pool_compute<4>(zs, c, t0, slo, shi, BR); else pool_compute<8>(zs, c, t0, slo, shi, BR);
    __syncthreads();
}
DI void phase_mix(const Args& a, int l, LAS unsigned char* lds, int G, int c, const SchedInProj& SI, const EpiInProj& EI) {
    for (int u = c; u < 512; u += G) attn_unit(a, l, lds, 0, u >> 7, (u >> 2) & 31, (u >> 1) & 1, u & 1);
    const int ng = (SI.hi - SI.lo) < G ? (SI.hi - SI.lo) : G;
    const int nconv = l == 0 ? TT / 32 : TL / 32;
    const bool gblk = c < ng; const int nrest = G - ng;
    const int sg = nrest > 0 ? (l == 0 ? 130 : 25) : 256;
    const int ncg = ng > 0 ? (nconv * sg) >> 8 : 0;
    const int jb = gblk ? 0 : ncg, j1 = gblk ? ncg : nconv, js = gblk ? ng : nrest, ci = gblk ? c : c - ng;
    for (int j = jb + ci; j < j1; j += js) conv_unit(a, l, lds, j * 32);
    for (int j = jb + (js - 1 - ci); j < j1; j += js) pool_unit(a, lds, j * 32);
    if (l == 0) { const int x0 = nrest >= 32 ? c - ng : c;
        if (x0 >= 0) for (int x = x0; x < 32; x += (nrest >= 32 ? nrest : G)) attn_unit(a, l, lds, 1, x >> 3, (x >> 2) & 1, (x >> 1) & 1, x & 1); }
    if (ng > 0) pg8::gemm_phase(lds, SI, EI);
}

DI void topk_unit(const Args& a, LAS unsigned char* lds, int set, int e) {
    const int tid = threadIdx.x, lane = tid & 63, wid = tid >> 6; const bool lat = set < 4; const int b = set & 3;
    const int N = lat ? SEQ : CTXL, cap = N / 8, tok0 = lat ? b * SEQ : TL + b * CTXL, sbase = e * ESLOT + (lat ? b * 512 : 2048 + b * 32);
    const float* AFF = (const float*)(a.ws + WS_AFF); int* SLOTOF = (int*)(a.ws + WS_SLOTOF); int* TOKOF = (int*)(a.ws + WS_TOKOF);
    LAS unsigned* hist = (LAS unsigned*)lds; LAS unsigned* wtot = hist + 256; LAS unsigned* bc = hist + 272;
    int nvalid = N - tid * 8; nvalid = nvalid < 0 ? 0 : (nvalid > 8 ? 8 : nvalid);
    unsigned v[8];
#pragma unroll
    for (int j = 0; j < 8; ++j) v[j] = j < nvalid ? __float_as_uint(AFF[(size_t)(tok0 + tid * 8 + j) * 16 + e]) : 0u;
    unsigned prefix = 0u, pmask = 0u; unsigned need = (unsigned)cap;
#pragma unroll 1
    for (int r = 0; r < 4; ++r) {
        const int shift = 24 - 8 * r;
        if (tid < 256) hist[tid] = 0u;
        __syncthreads();
#pragma unroll
        for (int j = 0; j < 8; ++j) if (j < nvalid && (v[j] & pmask) == prefix) __hip_atomic_fetch_add(&hist[(v[j] >> shift) & 255u], 1u, __ATOMIC_RELAXED, __HIP_MEMORY_SCOPE_WORKGROUP);
        __syncthreads();
        unsigned hv = 0u, suf = 0u;
        if (tid < 256) { hv = hist[tid]; suf = hv;
#pragma unroll
            for (int o = 1; o < 64; o <<= 1) { const unsigned t = __shfl_down(suf, o); if (lane + o < 64) suf += t; }
            if (lane == 0) wtot[wid] = suf; }
        __syncthreads();
        if (tid < 256) { unsigned above = 0u; for (int w = wid + 1; w < 4; ++w) above += wtot[w];
            suf += above; const unsigned sn = suf - hv;
            if (suf >= need && sn < need) { bc[0] = (unsigned)tid; bc[1] = need - sn; } }
        __syncthreads();
        prefix |= bc[0] << shift; pmask |= 255u << shift; need = bc[1];
    }
    const unsigned T = prefix, need_eq = need, count_gt = (unsigned)cap - need_eq;
    unsigned cg = 0u, ce = 0u;
#pragma unroll
    for (int j = 0; j < 8; ++j) if (j < nvalid) { cg += v[j] > T ? 1u : 0u; ce += v[j] == T ? 1u : 0u; }
    const unsigned pk = cg | (ce << 16); unsigned inc = pk;
#pragma unroll
    for (int o = 1; o < 64; o <<= 1) { const unsigned t = __shfl_up(inc, o); if (lane >= o) inc += t; }
    if (lane == 63) wtot[wid] = inc;
    __syncthreads();
    unsigned basev = 0u; for (int w = 0; w < wid; ++w) basev += wtot[w];
    const unsigned ex = basev + inc - pk; unsigned rg = ex & 0xffffu, re = ex >> 16;
#pragma unroll
    for (int j = 0; j < 8; ++j) if (j < nvalid) { const int tok = tok0 + tid * 8 + j; int slot = -1;
        if (v[j] > T) { slot = sbase + (int)rg; ++rg; } else if (v[j] == T) { if (re < need_eq) slot = sbase + (int)(count_gt + re); ++re; }
        SLOTOF[(size_t)tok * 16 + e] = slot; if (slot >= 0) TOKOF[slot] = tok; }
    if (set == 4 && tid < 128) TOKOF[e * ESLOT + 2176 + tid] = 0;
    __syncthreads();
}

#define XB_TMO      128
#define XB_XCNT(j)  (256  + 64 * (j))
#define XB_XSUB(j)  (1280 + 64 * (j))
#define XB_XGEN(j)  (2304 + 64 * (j))
#define XB_TOP      3328
#define XB_TOPGEN   3392
#define XCD_BAR_WORDS 3456
#define XB_SPIN_CAP (1u << 22)
DI unsigned xb_ld(unsigned* p) { return __hip_atomic_load(p, __ATOMIC_RELAXED, __HIP_MEMORY_SCOPE_AGENT); }
DI unsigned xb_add(unsigned* p, unsigned v) { return __hip_atomic_fetch_add(p, v, __ATOMIC_RELAXED, __HIP_MEMORY_SCOPE_AGENT); }
DI unsigned xb_xcc_id() { return (unsigned)__builtin_amdgcn_s_getreg((3 << 11) | 20) & 0xFu; }
#define XB_SPIN(cond, bar) do { unsigned _sp = 0; while (cond) { __builtin_amdgcn_s_sleep(1); \
    if ((++_sp & 255u) == 0u) { if (xb_ld(&(bar)[XB_TMO])) break; if (_sp > XB_SPIN_CAP) { atomicAdd(&(bar)[XB_TMO], 1u); break; } } } } while (0)
struct XcdBarrier { unsigned* bar; unsigned x; volatile LAS unsigned* st; };
DI XcdBarrier xcd_barrier_post(unsigned* bar, volatile LAS unsigned* st) {
    XcdBarrier b; b.bar = bar; b.x = xb_xcc_id(); b.st = st;
    if (threadIdx.x == 0) (void)xb_add(&bar[XB_XCNT(b.x)], 1u);
    return b;
}
DI void xcd_barrier_complete(unsigned* bar, unsigned x, unsigned& nloc, unsigned& nx) {
    const unsigned G = gridDim.x * gridDim.y * gridDim.z;
    unsigned sum, cnt, mine, sp = 0u;
    for (;;) {
        sum = 0u; cnt = 0u; mine = 0u;
#pragma unroll
        for (unsigned j = 0; j < 16; ++j) { const unsigned c = xb_ld(&bar[XB_XCNT(j)]); sum += c; cnt += (c > 0u) ? 1u : 0u; mine = (j == x) ? c : mine; }
        if (sum == G) break;
        __builtin_amdgcn_s_sleep(1);
        if ((++sp & 255u) == 0u) { if (xb_ld(&bar[XB_TMO])) break; if (sp > XB_SPIN_CAP) { atomicAdd(&bar[XB_TMO], 1u); break; } }
    }
    nloc = mine > 0u ? mine : 1u; nx = cnt > 0u ? cnt : 1u;
}
DI void xcd_barrier(const XcdBarrier& b) {
    asm volatile("s_waitcnt vmcnt(0)" ::: "memory");
    __syncthreads();
    if (threadIdx.x == 0) {
        unsigned* bar = b.bar;
        __builtin_amdgcn_s_waitcnt(0);
        unsigned nloc = b.st[0], nx = b.st[1];
        if (nloc == 0u) { xcd_barrier_complete(bar, b.x, nloc, nx); b.st[0] = nloc; b.st[1] = nx; }
        const unsigned old = xb_add(&bar[XB_XSUB(b.x)], 1u);
        const unsigned gen = old / nloc;
        if (old + 1u == (gen + 1u) * nloc) {
            __builtin_amdgcn_fence(__ATOMIC_RELEASE, "agent");
            asm volatile("s_waitcnt vmcnt(0)" ::: "memory");
            const unsigned og = xb_add(&bar[XB_TOP], 1u);
            const unsigned tg = og / nx;
            if (og + 1u == (tg + 1u) * nx) xb_add(&bar[XB_TOPGEN], 1u);
            else XB_SPIN(xb_ld(&bar[XB_TOPGEN]) == tg, bar);
            __builtin_amdgcn_fence(__ATOMIC_ACQUIRE, "agent");
            xb_add(&bar[XB_XGEN(b.x)], 1u);
            asm volatile("s_waitcnt vmcnt(0)" ::: "memory");
        } else {
            XB_SPIN(xb_ld(&bar[XB_XGEN(b.x)]) == gen, bar);
            __builtin_amdgcn_fence(__ATOMIC_ACQUIRE, "agent");
            asm volatile("s_waitcnt vmcnt(0)" ::: "memory");
        }
    }
    __syncthreads();
}

#if !MK_PER_PHASE
#define GRID_BAR() xcd_barrier(bar)
#else
#define GRID_BAR() do {} while (0)
#endif
#ifndef PROBE_DUP
#define PROBE_DUP 0
#endif
#define REPS(bit) (1 + ((PROBE_DUP >> (bit)) & 1))
#define REP(bit) for (int _r = 0; _r < REPS(bit); ++_r)
#define REPU(bit) _Pragma("unroll") for (int _r = 0; _r < REPS(bit); ++_r)
#define REPBAR() do { if (_r) GRID_BAR(); } while (0)
#define IN(k) (lo <= (k) && (k) < hi)
#ifndef PROBE_SPIN
#define PROBE_SPIN (-1)
#endif
#ifndef PROBE_SPIN_END
#define PROBE_SPIN_END (PROBE_SPIN + 1)
#endif
#ifndef PROBE_MULT
#define PROBE_MULT 4
#endif
#define STAMP(k) do { if (PROBE_SPIN >= 0 && blockIdx.x == 0 && threadIdx.x == 0) ((volatile LAS unsigned long long*)(lds + LDS_MISC_OFF + 256))[k] = __builtin_amdgcn_s_memrealtime(); } while (0)
#define SEAM(k) do { if (lo < (k) && (k) < hi) GRID_BAR(); STAMP(k); } while (0)

DI void gu_run(const Args& a, int l, LAS unsigned char* lds, int G, int c, int lo, int hi, int c0) {
    unsigned char* ws = a.ws; const int tid = threadIdx.x;
    const int* TOKOF = (const int*)(ws + WS_TOKOF); LAS int* idx = (LAS int*)(lds + LDS_IDX_OFF);
    if (c0 < 0) return;
    for (int ibase = 0; lo + ibase * G + c0 < hi; ibase += 8) {
        __syncthreads();
        for (int q = tid; q < 8 * 256; q += 512) { const int i = q >> 8; const int Lu = lo + (ibase + i) * G + c0;
            if (Lu < hi) { int e, mt, n8; gu_decode(Lu, e, mt, n8); idx[q] = TOKOF[e * ESLOT + mt * 256 + (q & 255)]; } }
        __syncthreads();
        SchedGU S; S.nt = 16; S.ldb_b = 2048; S.lda_b = 2048; S.G = G; S.c = c; S.A = (const char*)(ws + WS_H); S.B = (const char*)(ws + ws_wgu(l)); S.lo = lo; S.hi = hi; S.c0 = c0; S.ibase = ibase; S.idx = idx;
        EpiGU E{(bf16_t*)(ws + WS_ACT)};
        pg8::gemm_phase(lds, S, E);
    }
}

template <int L> DI void run_layer(const Args& a, LAS unsigned char* lds, int G, int c, int lo, int hi, const XcdBarrier& bar) {
    unsigned char* ws = a.ws;
    constexpr int l = L, base = 1 + 9 * L, nM = L == 0 ? 68 : 64, nmt = L == 0 ? 9 : 8;
    const int tid = threadIdx.x;
    SEAM(base + 0);
    if (IN(base + 0)) { if (L == 0) { REP(0) { REPBAR(); norm_phase<0>(a, 0, lds, G, c); } } else norm_phase<1>(a, 1, lds, G, c); }
    SEAM(base + 1);
#define MK_INPROJ_SCHED(SI, EI) \
    SchedInProj SI; SI.nt = 16; SI.ldb_b = 2048; SI.lda_b = 2048; SI.G = G; SI.c = c; SI.A = (const char*)(ws + WS_H); SI.B = (const char*)(ws + WS_WIN) + (size_t)l * INW * 2048; \
    SI.init_counts(nM, l == 0 ? 0 : 4); \
    const int np2 = (SI.ntot / G) * G > 0 ? (SI.ntot / G) * G : SI.ntot;      \
    const EpiInProj EI{(bf16_t*)(ws + WS_Q), (bf16_t*)(ws + WS_K), (bf16_t*)(ws + WS_VT), (bf16_t*)(ws + WS_U), (bf16_t*)(ws + WS_Z), (bf16_t*)(ws + WS_G), (const float*)(ws + WS_ROPE)};
    if (IN(base + 1)) REPU(1) { REPBAR();
        MK_INPROJ_SCHED(SI, EI)
        SI.lo = 0; SI.hi = np2;
        pg8::gemm_phase(lds, SI, EI);
    }
    SEAM(base + 2);
    if (IN(base + 2)) REP(2) { REPBAR(); MK_INPROJ_SCHED(SI, EI) SI.lo = np2; SI.hi = SI.ntot; phase_mix(a, l, lds, G, c, SI, EI); }
    SEAM(base + 3);
    if (IN(base + 3)) REP(3) { REPBAR();
        SchedMerge S; S.nt = 24; S.ldb_b = 3072; S.lda_b = 3072; S.G = G; S.c = c; S.A = (const char*)(ws + WS_BR); S.B = (const char*)(ws + WS_WMERGE) + (size_t)l * 1024 * 3072; S.nM = nM;
        EpiMerge E{(const bf16_t*)(ws + WS_G), (bf16_t*)(ws + WS_MERGED)};
        pg8::gemm_phase(lds, S, E);
        if (L == 0) { if (__builtin_amdgcn_readfirstlane(tid >> 6) < PULLW) convert_pull(a, 0, tid & 63);
            if (G == 256 && c >= 32) { const int wid = __builtin_amdgcn_readfirstlane(tid >> 6);
                convert_loop(L1_E3, (c - 32) * 8 + wid, 1792, tid & 63, [&](int it) __attribute__((always_inline)) { return expert_tile(a, 1, L1_E1 + L1_E2 + it); }); } }
    }
    SEAM(base + 4);
    if (IN(base + 4)) for (int _r = 0; _r < (L == 0 ? REPS(4) : 1); ++_r) { REPBAR();
        if (L == 0) {
#define MK_OUT_SCHED(S, MODE_, C0_) SchedOut S; S.nt = 16; S.ldb_b = 2048; S.lda_b = 2048; S.G = G; S.c = c; S.A = (const char*)(ws + WS_MERGED); S.B = (const char*)(ws + WS_WOUT) + (size_t)l * 1024 * 2048; S.nM = nM; S.mode = MODE_; S.c0 = C0_;
#define MK_PUBLISH(PM) do { if (tid == 0) { __builtin_amdgcn_fence(__ATOMIC_RELEASE, "agent"); asm volatile("s_waitcnt vmcnt(0)" ::: "memory"); \
                __hip_atomic_fetch_add((unsigned*)(ws + WS_BAR) + CTR_WORD0 + (16 + (PM)) * CTR_STRIDE, 1u, __ATOMIC_RELAXED, __HIP_MEMORY_SCOPE_AGENT); } } while (0)
#define MK_AWAIT(PM) do { if (tid == 0) { unsigned sp = 0; while (__hip_atomic_load((unsigned*)(ws + WS_BAR) + CTR_WORD0 + (16 + (PM)) * CTR_STRIDE, __ATOMIC_RELAXED, __HIP_MEMORY_SCOPE_AGENT) < 4u) { __builtin_amdgcn_s_sleep(4); if (++sp > (1u << 22)) break; } \
                __builtin_amdgcn_fence(__ATOMIC_ACQUIRE, "agent"); asm volatile("s_waitcnt vmcnt(0)" ::: "memory"); } __syncthreads(); } while (0)
            { MK_OUT_SCHED(S, (G == 256 ? 1 : 0), -1)
              const EpiOut E{(bf16_t*)(ws + WS_DELTA), (const float*)(ws + WS_MOD), l};
              pg8::gemm_phase(lds, S, E); }
            if (G == 256) {
                { int pm, pn; pg8::tile_order(c, 64, 4, pm, pn); MK_PUBLISH(pm); }
                if (c < 16) {
                    { MK_OUT_SCHED(S, 2, c)
                      const EpiOut E{(bf16_t*)(ws + WS_DELTA), (const float*)(ws + WS_MOD), l};
                      pg8::gemm_phase(lds, S, E); }
                    MK_PUBLISH(64 + (c >> 2));
                } else {
                    norm2_table(a, l, lds);
                    { const int ci = c - 16; const int r0 = ci * 69, r1 = (r0 + 69) < TL ? (r0 + 69) : TL;
                      for (int ra = r0; ra < r1; ) { const int pm = ra >> 8; const int rb = ((pm + 1) << 8) < r1 ? ((pm + 1) << 8) : r1; MK_AWAIT(pm); norm2_rows(a, l, lds, ra, rb); ra = rb; } }
                    { const int ci = c - 16; const int q0 = TL + ci * 5, q1 = (q0 + 5) < TT ? (q0 + 5) : TT;
                      for (int ra = q0; ra < q1; ) { const int pm = ra >> 8; const int rb = ((pm + 1) << 8) < q1 ? ((pm + 1) << 8) : q1; MK_AWAIT(pm); norm2_rows(a, l, lds, ra, rb); ra = rb; } }
                }
            } else {
                GRID_BAR();
                norm2_phase(a, l, lds, G, c);
            }
            convert_pull(a, 0, tid & 63);
        } else {
            SchedOut S; S.nt = 16; S.ldb_b = 2048; S.lda_b = 2048; S.G = G; S.c = c; S.A = (const char*)(ws + WS_MERGED); S.B = (const char*)(ws + WS_WOUT) + (size_t)l * 1024 * 2048; S.nM = nM; S.mode = 0; S.c0 = -1;
            EpiOut E{(bf16_t*)(ws + WS_DELTA), (const float*)(ws + WS_MOD), l};
            pg8::gemm_phase(lds, S, E);
        }
    }
    if (L != 0) SEAM(base + 5);
    if (L != 0 && IN(base + 5)) REP(5) { REPBAR(); norm2_phase(a, l, lds, G, c); }
    SEAM(base + 6);
    if (IN(base + 6)) REP(6) { REPBAR();
        const int nu = l == 0 ? 128 : 64;
        for (int u = c; u < nu; u += G) topk_unit(a, lds, u >> 4, u & 15);
        if (l == 0 && G == 256 && c >= 64) {
            const int wid = __builtin_amdgcn_readfirstlane(tid >> 6);
            if (c >= 128) convert_loop(L1_E1, (c - 128) * 8 + wid, 1024, tid & 63, [&](int it) __attribute__((always_inline)) { return expert_tile(a, 1, it); });
            else convert_loop(L1_E2, (c - 64) * 8 + wid, 512, tid & 63, [&](int it) __attribute__((always_inline)) { return expert_tile(a, 1, L1_E1 + it); });
        }
        if (l == 1) {
            const int wid = __builtin_amdgcn_readfirstlane(tid >> 6);
            if (G == 256) {
                constexpr int NA = 2048 * 4, NB = 1536 * 5;
                static_assert(L1_EARLY + NA + NB == N_EXPERT_TILES, "tile shares");
                convert_loop(NA, c * 8 + wid, 2048, tid & 63, [&](int it) __attribute__((always_inline)) { return expert_tile(a, 1, L1_EARLY + it); });
                if (c >= 64) convert_loop(NB, (c - 64) * 8 + wid, 1536, tid & 63, [&](int it) __attribute__((always_inline)) { return expert_tile(a, 1, L1_EARLY + NA + it); });
            } else convert_experts(a, 1, c * 8 + wid, G * 8, tid & 63);
        }
    }
    SEAM(base + 7);
    if (IN(base + 7)) REP(7) { REPBAR();
        gu_run(a, l, lds, G, c, 0, NE * 64, c);
    }
    SEAM(base + 8);
    if (IN(base + 8)) REP(8) { REPBAR();
        unsigned* dep = (unsigned*)(ws + WS_BAR) + CTR_WORD0 + 4 * CTR_STRIDE;
        const int nctx = nmt > 8 ? NE * 8 : 0;
        if (nctx > 0) {
            gu_run(a, l, lds, G, c, NE * 64, NE * 64 + nctx, c < nctx ? c : -1);
            if (c < nctx && tid == 0) {
                __builtin_amdgcn_fence(__ATOMIC_RELEASE, "agent"); asm volatile("s_waitcnt vmcnt(0)" ::: "memory");
                __hip_atomic_fetch_add(dep, 1u, __ATOMIC_RELAXED, __HIP_MEMORY_SCOPE_AGENT); }
        }
        { SchedDown S; S.nt = 16; S.ldb_b = 2048; S.lda_b = 2048; S.G = G; S.c = c; S.A = (const char*)(ws + WS_ACT); S.B = (const char*)(ws + ws_wdn(l)); S.lo = 0; S.hi = NE * 32; S.c0 = c;
          EpiDown E{(bf16_t*)(ws + WS_Y)};
          pg8::gemm_phase(lds, S, E); }
        if (nctx > 0) {
            const int cd = (c >= nctx && G >= nctx + NE * 4) ? c - nctx : (G < nctx + NE * 4 ? c : -1);
            if (cd >= 0 && cd < NE * 4) {
                if (tid == 0) { unsigned sp = 0; while (__hip_atomic_load(dep, __ATOMIC_RELAXED, __HIP_MEMORY_SCOPE_AGENT) < (unsigned)nctx) { __builtin_amdgcn_s_sleep(8); if (++sp > (1u << 22)) break; }
                    __builtin_amdgcn_fence(__ATOMIC_ACQUIRE, "agent"); asm volatile("s_waitcnt vmcnt(0)" ::: "memory"); }
                __syncthreads();
            }
            SchedDown S; S.nt = 16; S.ldb_b = 2048; S.lda_b = 2048; S.G = G; S.c = c; S.A = (const char*)(ws + WS_ACT); S.B = (const char*)(ws + ws_wdn(l)); S.lo = NE * 32; S.hi = NE * 36; S.c0 = (cd >= 0 && cd < NE * 4) ? cd : -1;
            EpiDown E{(bf16_t*)(ws + WS_Y)};
            pg8::gemm_phase(lds, S, E);
        }
    }
}

__global__ void __launch_bounds__(512, 2) fwd_kernel(Args a) {
    extern __shared__ __attribute__((aligned(16))) unsigned char lds_raw[];
    LAS unsigned char* lds = (LAS unsigned char*)lds_raw;
    const int tid = threadIdx.x; const int G = gridDim.x, c = blockIdx.x;
    volatile LAS unsigned* MISC = (volatile LAS unsigned*)(lds + LDS_MISC_OFF);
    if (tid < 32) MISC[tid] = 0u;
    __syncthreads();
#if !MK_PER_PHASE
    XcdBarrier bar = xcd_barrier_post((unsigned*)(a.ws + WS_BAR), MISC + 8);
#else
    XcdBarrier bar; bar.bar = nullptr; bar.x = 0; bar.st = MISC + 8;
#endif
    const int lo = a.ph_lo, hi = a.ph_hi;
    STAMP(0);
#ifdef PROBE_KLOOP
    if (blockIdx.x == 0 && threadIdx.x == 0) ((volatile LAS unsigned long long*)(lds + LDS_MISC_OFF + 256))[40] = 0;
#endif
    if (IN(0)) REP(9) { REPBAR(); phase_prep(a, lds, G, c); }
    run_layer<0>(a, lds, G, c, lo, hi, bar);
    run_layer<1>(a, lds, G, c, lo, hi, bar);
    SEAM(NPHASE - 1);
    if (IN(NPHASE - 1)) REP(10) { REPBAR(); norm_phase<3>(a, 1, lds, G, c); }
#ifdef PROBE_KLOOP
    if (blockIdx.x == 0 && threadIdx.x == 0) { const unsigned long long dur = ((volatile LAS unsigned long long*)(lds + LDS_MISC_OFF + 256))[40] * PROBE_KLOOP, t0 = __builtin_amdgcn_s_memrealtime();
        while (__builtin_amdgcn_s_memrealtime() - t0 < dur) __builtin_amdgcn_s_sleep(8); }
#endif
    if (PROBE_SPIN >= 0) {
        GRID_BAR(); STAMP(NPHASE);
        if (blockIdx.x == 0 && threadIdx.x == 0) { volatile LAS unsigned long long* st = (volatile LAS unsigned long long*)(lds + LDS_MISC_OFF + 256);
            const unsigned long long dur = (st[PROBE_SPIN_END] - st[PROBE_SPIN]) * PROBE_MULT, t0 = __builtin_amdgcn_s_memrealtime();
            while (__builtin_amdgcn_s_memrealtime() - t0 < dur) __builtin_amdgcn_s_sleep(8); }
    }
}

extern "C" void kernel_launch(void* const* d_in, const int* in_sizes, int n_in, void* d_out, int out_size, void* d_ws, size_t ws_size, hipStream_t stream) {
    static int grid = 0;
    if (grid == 0) {
        if (n_in != 25 || out_size != TL * DM || ws_size < WS_END) { fprintf(stderr, "kernel_launch: unexpected shapes (n_in %d out %d ws %zu)\n", n_in, out_size, ws_size); grid = -1; return; }
        int dev = 0, cus = 0, per_cu = 0;
        if (hipGetDevice(&dev) != hipSuccess || hipDeviceGetAttribute(&cus, hipDeviceAttributeMultiprocessorCount, dev) != hipSuccess) { grid = -1; return; }
        if (hipFuncSetAttribute((const void*)fwd_kernel, hipFuncAttributeMaxDynamicSharedMemorySize, LDS_BYTES) != hipSuccess) { fprintf(stderr, "kernel_launch: hipFuncSetAttribute failed\n"); grid = -1; return; }
        if (hipOccupancyMaxActiveBlocksPerMultiprocessor(&per_cu, (const void*)fwd_kernel, 512, LDS_BYTES) != hipSuccess || per_cu < 1) { fprintf(stderr, "kernel_launch: occupancy query says %d blocks per CU\n", per_cu); (void)hipGetLastError(); grid = -1; return; }
        grid = cus;
    }
    if (grid < 0) return;
    (void)hipMemsetAsync((char*)d_ws + WS_BAR, 0, 65536, stream);
    Args a{};
    for (int i = 0; i < 25; ++i) a.in[i] = (const float*)d_in[i];
    a.out = (float*)d_out; a.ws = (unsigned char*)d_ws;
#if MK_PER_PHASE
    for (int ph = 0; ph < NPHASE; ++ph) { a.ph_lo = ph; a.ph_hi = ph + 1; hipLaunchKernelGGL(fwd_kernel, dim3(grid), dim3(512), LDS_BYTES, stream, a); }
#else
    a.ph_lo = 0; a.ph_hi = NPHASE;
    hipLaunchKernelGGL(fwd_kernel, dim3(grid), dim3(512), LDS_BYTES, stream, a);
#endif
}
```
